# Optimizing an MI355X kernel written in HIP

```python
import math
import jax, jax.numpy as jnp
from jax import lax
import numpy as np

D_MODEL = 2048
BATCH = 4
SEQ = 2048
DEPTH = 1
DEC_BATCH = 128
DEC_SEQ = 8
PAST_LEN = 16384
PAGE_SIZE = 128

D_MIX = D_MODEL
D_CONV = D_MIX // 2
CONV_W = 3
ML_HEADS = 4
ML_DV = (D_MIX // 2) // ML_HEADS
ML_DK = ML_DV // 2
ML_CHUNK = 64
D_FF = ((8 * D_MODEL + 3 * 256 - 1) // (3 * 256)) * 256
EPS = 1e-6

_SPLITS = (D_CONV, D_CONV, D_CONV,
           ML_HEADS * ML_DK, ML_HEADS * ML_DK, ML_HEADS * ML_DV, ML_HEADS * ML_DV,
           ML_HEADS, ML_HEADS)
N_IN = sum(_SPLITS)
_SPLIT_IDX = [sum(_SPLITS[: i + 1]) for i in range(len(_SPLITS) - 1)]

kernel_name = "hybrid_shortconv_mlstm_step"


def _rmsnorm(x, g):
    xf = x.astype(jnp.float32)
    xf = xf * lax.rsqrt(jnp.mean(xf * xf, axis=-1, keepdims=True) + EPS)
    return xf.astype(x.dtype) * g


def _mlstm_chunked(q, k, v, li, lf, C0, n0, m0):
    Bsz, S, H, DK = q.shape
    DV = v.shape[-1]
    L = math.gcd(S, ML_CHUNK)
    nc = S // L

    def to_chunks(a):
        a = a.reshape((Bsz, nc, L) + a.shape[2:])
        return jnp.moveaxis(a, (1, 2), (0, 3))

    causal = jnp.tril(jnp.ones((L, L), dtype=bool))

    def step(carry, inp):
        C, n, m = carry
        qc, kc, vc, lic, lfc = inp
        b = jnp.cumsum(lfc, axis=-1)
        dmat = b[..., :, None] - b[..., None, :] + lic[..., None, :]
        dmat = jnp.where(causal, dmat, -jnp.inf)
        inter = b + m[..., None]
        m_t = jnp.maximum(inter, jnp.max(dmat, axis=-1))
        w = jnp.exp(dmat - m_t[..., None])
        a_inter = jnp.exp(inter - m_t)
        s = jnp.einsum('bhtd,bhsd->bhts', qc, kc) * w
        num = a_inter[..., None] * jnp.einsum('bhtd,bhde->bhte', qc, C) + jnp.einsum('bhts,bhse->bhte', s, vc)
        den = a_inter * jnp.einsum('bhtd,bhd->bht', qc, n) + jnp.sum(s, axis=-1)
        h = num / jnp.maximum(jnp.abs(den), jnp.exp(-m_t))[..., None]
        bL = b[..., -1]
        g = bL[..., None] - b + lic
        m_new = jnp.maximum(bL + m, jnp.max(g, axis=-1))
        wk = jnp.exp(g - m_new[..., None])
        sc = jnp.exp(bL + m - m_new)
        C_new = sc[..., None, None] * C + jnp.einsum('bhsd,bhse->bhde', kc * wk[..., None], vc)
        n_new = sc[..., None] * n + jnp.einsum('bhs,bhsd->bhd', wk, kc)
        return (C_new, n_new, m_new), h

    xs = (to_chunks(q), to_chunks(k), to_chunks(v), to_chunks(li), to_chunks(lf))
    (C1, n1, m1), hs = lax.scan(step, (C0, n0, m0), xs)
    h = jnp.moveaxis(hs, (0, 3), (1, 2)).reshape(Bsz, S, H, DV)
    return h, C1, n1, m1


def _layer(x, conv_buf, C0, n0, m0, n1g, w_in, b_i, b_f, conv_w, conv_g, ml_g, w_out,
           n2g, wg, wu, wd):
    Bsz, S, _ = x.shape
    xn = _rmsnorm(x, n1g)
    z = xn @ w_in
    bg, cg, xt, q, k, v, o, ig, fg = jnp.split(z, _SPLIT_IDX, axis=-1)
    u = cg * xt
    pad = jnp.concatenate([conv_buf.astype(u.dtype), u], axis=1)
    conv = sum(pad[:, j:j + S] * conv_w[j] for j in range(CONV_W))
    new_buf = pad[:, -(CONV_W - 1):].astype(jnp.float32)
    y_conv = _rmsnorm(bg * conv, conv_g)
    f32 = jnp.float32
    qh = q.reshape(Bsz, S, ML_HEADS, ML_DK).astype(f32) * (ML_DK ** -0.5)
    kh = k.reshape(Bsz, S, ML_HEADS, ML_DK).astype(f32)
    vh = v.reshape(Bsz, S, ML_HEADS, ML_DV).astype(f32)
    li = (ig + b_i).astype(f32)
    lf = jax.nn.log_sigmoid((fg + b_f).astype(f32))
    h, C1, n1, m1 = _mlstm_chunked(qh, kh, vh, li, lf,
                                   C0.astype(f32), n0.astype(f32), m0.astype(f32))
    h = _rmsnorm(h.astype(x.dtype), ml_g.reshape(ML_HEADS, ML_DV)).reshape(Bsz, S, ML_HEADS * ML_DV)
    y_ml = jax.nn.sigmoid(o) * h
    x = x + jnp.concatenate([y_conv, y_ml], axis=-1) @ w_out
    hn = _rmsnorm(x, n2g)
    x = x + (jax.nn.silu(hn @ wg) * (hn @ wu)) @ wd
    return x, new_buf, C1, n1, m1


def setup_inputs(seed: int = 0) -> dict:
    key = jax.random.key(seed)
    ks = jax.random.split(key, 24)
    nrm = jax.random.normal
    f32 = jnp.float32
    return {
        "x_prompt": nrm(ks[0], (BATCH, SEQ, D_MODEL), f32),
        "x_sample": nrm(ks[1], (DEC_BATCH, DEC_SEQ, D_MODEL), f32),
        "state_conv": nrm(ks[2], (DEPTH, DEC_BATCH, CONV_W - 1, D_CONV), f32),
        "state_mlstm_C": 0.3 * nrm(ks[3], (DEPTH, DEC_BATCH, ML_HEADS, ML_DK, ML_DV), f32),
        "state_mlstm_n": 0.5 * nrm(ks[4], (DEPTH, DEC_BATCH, ML_HEADS, ML_DK), f32),
        "state_mlstm_m": 0.5 * nrm(ks[5], (DEPTH, DEC_BATCH, ML_HEADS), f32),
        "norm1_g": 1.0 + 0.02 * nrm(ks[6], (DEPTH, D_MODEL), f32),
        "w_in": nrm(ks[7], (DEPTH, D_MODEL, N_IN), f32) * D_MODEL ** -0.5,
        "b_igate": -2.0 + 0.1 * nrm(ks[8], (DEPTH, ML_HEADS), f32),
        "b_fgate": jnp.linspace(3.0, 6.0, ML_HEADS, dtype=f32)[None] + 0.1 * nrm(ks[9], (DEPTH, ML_HEADS), f32),
        "conv_w": nrm(ks[10], (DEPTH, CONV_W, D_CONV), f32) * CONV_W ** -0.5,
        "conv_out_g": 1.0 + 0.02 * nrm(ks[11], (DEPTH, D_CONV), f32),
        "mlstm_out_g": 1.0 + 0.02 * nrm(ks[12], (DEPTH, ML_HEADS * ML_DV), f32),
        "w_out": nrm(ks[13], (DEPTH, D_MIX, D_MODEL), f32) * D_MIX ** -0.5,
        "norm2_g": 1.0 + 0.02 * nrm(ks[14], (DEPTH, D_MODEL), f32),
        "w_ffn_gate": nrm(ks[15], (DEPTH, D_MODEL, D_FF), f32) * D_MODEL ** -0.5,
        "w_ffn_up": nrm(ks[16], (DEPTH, D_MODEL, D_FF), f32) * D_MODEL ** -0.5,
        "w_ffn_down": nrm(ks[17], (DEPTH, D_FF, D_MODEL), f32) * D_FF ** -0.5,
        "final_norm_g": 1.0 + 0.02 * nrm(ks[18], (D_MODEL,), f32),
    }


def reference(x_prompt, x_sample, state_conv, state_mlstm_C, state_mlstm_n, state_mlstm_m,
              norm1_g, w_in, b_igate, b_fgate, conv_w, conv_out_g, mlstm_out_g, w_out,
              norm2_g, w_ffn_gate, w_ffn_up, w_ffn_down, final_norm_g):
    hp, hs = x_prompt, x_sample
    bp = x_prompt.shape[0]
    p_conv, p_C, p_n, p_m = [], [], [], []
    s_conv, s_C, s_n, s_m = [], [], [], []
    for l in range(DEPTH):
        params = (norm1_g[l], w_in[l], b_igate[l], b_fgate[l], conv_w[l], conv_out_g[l],
                  mlstm_out_g[l], w_out[l], norm2_g[l], w_ffn_gate[l], w_ffn_up[l], w_ffn_down[l])
        zb = jnp.zeros((bp, CONV_W - 1, D_CONV), jnp.float32)
        zC = jnp.zeros((bp, ML_HEADS, ML_DK, ML_DV), jnp.float32)
        zn = jnp.zeros((bp, ML_HEADS, ML_DK), jnp.float32)
        zm = jnp.zeros((bp, ML_HEADS), jnp.float32)
        hp, cb, C1, n1, m1 = _layer(hp, zb, zC, zn, zm, *params)
        p_conv.append(cb); p_C.append(C1); p_n.append(n1); p_m.append(m1)
        hs, cb, C1, n1, m1 = _layer(hs, state_conv[l], state_mlstm_C[l], state_mlstm_n[l],
                                    state_mlstm_m[l], *params)
        s_conv.append(cb); s_C.append(C1); s_n.append(n1); s_m.append(m1)
    y_prompt = _rmsnorm(hp, final_norm_g)
    y_sample = _rmsnorm(hs, final_norm_g)
    return (y_prompt, y_sample,
            jnp.stack(p_conv), jnp.stack(p_C), jnp.stack(p_n), jnp.stack(p_m),
            jnp.stack(s_conv), jnp.stack(s_C), jnp.stack(s_n), jnp.stack(s_m))
```

```cpp
#include <hip/hip_runtime.h>
#include <cstdio>
#include <cstdint>

typedef unsigned short bf16_t;
typedef unsigned v4u __attribute__((ext_vector_type(4)));
typedef float f32x4 __attribute__((ext_vector_type(4)));

constexpr int D = 2048, SEQ = 2048, NB = 4, DB = 128, DS = 8;
constexpr int MP = NB * SEQ, MS = DB * DS, M = MP + MS;
constexpr int DC = 1024, NH = 4, DK = 128, DV = 256;
constexpr int NZ = 6144, NIN = 6152, FF = 5632;
constexpr float EPS = 1e-6f;
constexpr float QSCALE = 0.08838834764831845f;
constexpr int ZC_BG = 0, ZC_CG = 1024, ZC_XT = 2048, ZC_Q = 3072, ZC_K = 3584, ZC_V = 4096, ZC_O = 5120;

constexpr size_t O_Y = 0, O_PCONV = 18874368, O_PC = 18882560, O_PN = 19406848, O_PM = 19408896,
                 O_SCONV = 19408912, O_SC = 19671056, O_SN = 36448272, O_SM = 36513808, O_END = 36514320;

constexpr size_t MiB = 1u << 20;
constexpr size_t WS_CTL = 0;
constexpr size_t WS_W1 = 1 * MiB, WS_W2 = 25 * MiB, WS_W3 = 33 * MiB, WS_W4 = 77 * MiB;
constexpr size_t WS_A = 99 * MiB;
constexpr size_t WS_B = 135 * MiB;
constexpr size_t WS_C = 243 * MiB;
constexpr size_t WS_GATES = WS_C + 36 * MiB;
constexpr size_t WS_END = 283 * MiB;
constexpr int CW_SSQ1 = 65536, CW_SSQ2 = 65536 + 16384;

__device__ __forceinline__ unsigned f2bf(float f) { unsigned u = __builtin_bit_cast(unsigned, f); return (u + 0x7fffu + ((u >> 16) & 1u)) >> 16; }
__device__ __forceinline__ float bf2f(unsigned b) { return __builtin_bit_cast(float, b << 16); }
__device__ __forceinline__ float wave_sum(float v) {
#pragma unroll
    for (int o = 1; o < 64; o <<= 1) v += __shfl_xor(v, o);
    return v;
}
__device__ __forceinline__ float sigmoidf_(float x) { return 1.f / (1.f + __expf(-x)); }
__device__ __forceinline__ float log_sigmoid(float x) { return fminf(x, 0.f) - log1pf(__expf(-fabsf(x))); }

__global__ void k_wprep(const float* __restrict__ W, int K, int ldw, int N, bf16_t* __restrict__ WT, int mode, const float* __restrict__ kgain) {
    __shared__ float tile[64][33];
    const int nblk = N / 32, item = blockIdx.x, kb = item / nblk, nb = item % nblk, k0 = 64 * kb, n0 = 32 * nb;
    const int tx = threadIdx.x & 31, ty = threadIdx.x >> 5;
    for (int i = 0; i < 8; ++i) { const int kk = ty + 8 * i; float g = kgain ? kgain[k0 + kk] : 1.f; tile[kk][tx] = W[(size_t)(k0 + kk) * ldw + n0 + tx] * g; }
    __syncthreads();
    const int n = threadIdx.x >> 3, c = threadIdx.x & 7;
    const int j = n0 + n; int drow = j; if (mode == 1) drow = 256 * (j / 128) + (j % 128); if (mode == 2) drow = 256 * (j / 128) + 128 + (j % 128);
    v4u o;
    o.x = f2bf(tile[8 * c + 0][n]) | (f2bf(tile[8 * c + 1][n]) << 16); o.y = f2bf(tile[8 * c + 2][n]) | (f2bf(tile[8 * c + 3][n]) << 16);
    o.z = f2bf(tile[8 * c + 4][n]) | (f2bf(tile[8 * c + 5][n]) << 16); o.w = f2bf(tile[8 * c + 6][n]) | (f2bf(tile[8 * c + 7][n]) << 16);
    *(v4u*)(WT + (size_t)drow * K + k0 + 8 * c) = o;
}

__global__ void __launch_bounds__(256) k_xprep(const float* __restrict__ xp, const float* __restrict__ xs, const float* __restrict__ g1, const float* __restrict__ w_in,
                        const float* __restrict__ b_i, const float* __restrict__ b_f, bf16_t* __restrict__ XN, float* __restrict__ gates) {
    const int wave = threadIdx.x >> 6, lane = threadIdx.x & 63;
    const int m = blockIdx.x * 4 + wave; if (m >= M) return;
    const float* xr = m < MP ? xp + (size_t)m * D : xs + (size_t)(m - MP) * D;
    float v[32]; float s = 0.f;
#pragma unroll
    for (int j = 0; j < 8; ++j) { const f32x4 t = *(const f32x4*)(xr + 256 * j + 4 * lane); v[4 * j] = t.x; v[4 * j + 1] = t.y; v[4 * j + 2] = t.z; v[4 * j + 3] = t.w; s += t.x * t.x + t.y * t.y + t.z * t.z + t.w * t.w; }
    const float r = rsqrtf(wave_sum(s) * (1.f / D) + EPS);
    float ga[8] = {0, 0, 0, 0, 0, 0, 0, 0};
#pragma unroll
    for (int j = 0; j < 8; ++j) {
        const int k = 256 * j + 4 * lane;
        const f32x4 gg = *(const f32x4*)(g1 + k);
        float xn[4] = {v[4 * j] * r * gg.x, v[4 * j + 1] * r * gg.y, v[4 * j + 2] * r * gg.z, v[4 * j + 3] * r * gg.w};
        unsigned long long o = (unsigned long long)(f2bf(xn[0]) | (f2bf(xn[1]) << 16)) | ((unsigned long long)(f2bf(xn[2]) | (f2bf(xn[3]) << 16)) << 32);
        *(unsigned long long*)(XN + (size_t)m * D + k) = o;
#pragma unroll
        for (int i = 0; i < 4; ++i) { const float* wr = w_in + (size_t)(k + i) * NIN + NZ;
#pragma unroll
            for (int q = 0; q < 8; ++q) ga[q] += xn[i] * wr[q]; }
    }
#pragma unroll
    for (int q = 0; q < 8; ++q) ga[q] = wave_sum(ga[q]);
    if (lane == 0) {
#pragma unroll
        for (int h = 0; h < 4; ++h) { gates[(size_t)m * 8 + h] = ga[h] + b_i[h]; gates[(size_t)m * 8 + 4 + h] = log_sigmoid(ga[4 + h] + b_f[h]); }
    }
}

template <int MODE>
__global__ void __launch_bounds__(256) k_gemm_naive(const bf16_t* __restrict__ A, const bf16_t* __restrict__ Bt, int K, int N,
                             bf16_t* __restrict__ Ob, float* __restrict__ out, const float* __restrict__ xp, const float* __restrict__ xs, const float* __restrict__ ssq) {
    __shared__ float As[64][33], Bs[64][33], Bu[MODE == 2 ? 64 : 1][33];
    const int tid = threadIdx.x, tx = tid & 15, ty = tid >> 4;
    const int n0 = blockIdx.x * 64, m0 = blockIdx.y * 64;
    float acc[4][4], acu[4][4];
#pragma unroll
    for (int i = 0; i < 4; ++i)
#pragma unroll
        for (int j = 0; j < 4; ++j) { acc[i][j] = 0.f; acu[i][j] = 0.f; }
    const int lr = tid >> 2, lc = (tid & 3) * 8;
    for (int k0 = 0; k0 < K; k0 += 32) {
        { const v4u a = *(const v4u*)(A + (size_t)(m0 + lr) * K + k0 + lc); const unsigned w[4] = {a.x, a.y, a.z, a.w};
#pragma unroll
          for (int q = 0; q < 4; ++q) { As[lr][lc + 2 * q] = bf2f(w[q] & 0xffffu); As[lr][lc + 2 * q + 1] = bf2f(w[q] >> 16); } }
        { int nr = n0 + lr; if (MODE == 2) nr = 256 * (nr / 128) + (nr % 128);
          const v4u b = *(const v4u*)(Bt + (size_t)nr * K + k0 + lc); const unsigned w[4] = {b.x, b.y, b.z, b.w};
#pragma unroll
          for (int q = 0; q < 4; ++q) { Bs[lr][lc + 2 * q] = bf2f(w[q] & 0xffffu); Bs[lr][lc + 2 * q + 1] = bf2f(w[q] >> 16); }
          if (MODE == 2) { const v4u b2 = *(const v4u*)(Bt + (size_t)(nr + 128) * K + k0 + lc); const unsigned w2[4] = {b2.x, b2.y, b2.z, b2.w};
#pragma unroll
            for (int q = 0; q < 4; ++q) { Bu[lr][lc + 2 * q] = bf2f(w2[q] & 0xffffu); Bu[lr][lc + 2 * q + 1] = bf2f(w2[q] >> 16); } } }
        __syncthreads();
#pragma unroll 8
        for (int kk = 0; kk < 32; ++kk) {
            float a[4], b[4], u[4];
#pragma unroll
            for (int i = 0; i < 4; ++i) { a[i] = As[ty * 4 + i][kk]; b[i] = Bs[tx * 4 + i][kk]; u[i] = MODE == 2 ? Bu[tx * 4 + i][kk] : 0.f; }
#pragma unroll
            for (int i = 0; i < 4; ++i)
#pragma unroll
                for (int j = 0; j < 4; ++j) { acc[i][j] += a[i] * b[j]; if (MODE == 2) acu[i][j] += a[i] * u[j]; }
        }
        __syncthreads();
    }
#pragma unroll
    for (int i = 0; i < 4; ++i) {
        const int m = m0 + ty * 4 + i;
#pragma unroll
        for (int j = 0; j < 4; ++j) {
            const int n = n0 + tx * 4 + j; const float v = acc[i][j];
            if (MODE == 0) Ob[(size_t)m * N + n] = (bf16_t)f2bf(v);
            if (MODE == 1) { const float xin = m < MP ? xp[(size_t)m * D + n] : xs[(size_t)(m - MP) * D + n]; const float x1 = xin + v; out[(size_t)m * D + n] = x1; Ob[(size_t)m * D + n] = (bf16_t)f2bf(x1); }
            if (MODE == 2) { const float r = rsqrtf(ssq[m] * (1.f / D) + EPS); const float g = v * r, u = acu[i][j] * r; Ob[(size_t)m * FF + n] = (bf16_t)f2bf(g * sigmoidf_(g) * u); }
            if (MODE == 3) { out[(size_t)m * D + n] += v; }
        }
    }
}

__global__ void k_rowssq(const float* __restrict__ out, float* __restrict__ ssq) {
    const int wave = threadIdx.x >> 6, lane = threadIdx.x & 63; const int m = blockIdx.x * 4 + wave; if (m >= M) return;
    float s = 0.f;
    for (int j = 0; j < 8; ++j) { const f32x4 t = *(const f32x4*)(out + (size_t)m * D + 256 * j + 4 * lane); s += t.x * t.x + t.y * t.y + t.z * t.z + t.w * t.w; }
    s = wave_sum(s); if (lane == 0) ssq[m] = s;
}
__global__ void k_final(float* __restrict__ out, const float* __restrict__ ssq, const float* __restrict__ fg) {
    const int wave = threadIdx.x >> 6, lane = threadIdx.x & 63; const int m = blockIdx.x * 4 + wave; if (m >= M) return;
    const float r = rsqrtf(ssq[m] * (1.f / D) + EPS);
    for (int j = 0; j < 8; ++j) { float* p = out + (size_t)m * D + 256 * j + 4 * lane; f32x4 t = *(f32x4*)p; const f32x4 g = *(const f32x4*)(fg + 256 * j + 4 * lane);
        t.x *= r * g.x; t.y *= r * g.y; t.z *= r * g.z; t.w *= r * g.w; *(f32x4*)p = t; }
}

__global__ void k_conv(const bf16_t* __restrict__ Z, const float* __restrict__ state_conv, const float* __restrict__ conv_w, const float* __restrict__ conv_g,
                       bf16_t* __restrict__ YC, float* __restrict__ dout) {
    __shared__ float red[4];
    const int m = blockIdx.x, tid = threadIdx.x;
    int b, t, S; const bool prompt = m < MP;
    if (prompt) { b = m / SEQ; t = m % SEQ; S = SEQ; } else { b = (m - MP) / DS; t = (m - MP) % DS; S = DS; }
    float tt[4]; float ss = 0.f;
#pragma unroll
    for (int i = 0; i < 4; ++i) {
        const int c = tid * 4 + i;
        float u[3];
#pragma unroll
        for (int j = 0; j < 3; ++j) {
            const int tp = t - 2 + j;
            if (tp >= 0) { const bf16_t* zr = Z + (size_t)(m - 2 + j) * NZ; u[j] = bf2f(zr[ZC_CG + c]) * bf2f(zr[ZC_XT + c]); }
            else u[j] = prompt ? 0.f : state_conv[((size_t)b * 2 + (tp + 2)) * DC + c];
        }
        const float cv = u[0] * conv_w[c] + u[1] * conv_w[DC + c] + u[2] * conv_w[2 * DC + c];
        tt[i] = bf2f(Z[(size_t)m * NZ + ZC_BG + c]) * cv; ss += tt[i] * tt[i];
        if (t >= S - 2) { float* o = dout + (prompt ? O_PCONV : O_SCONV) + ((size_t)b * 2 + (t - (S - 2))) * DC + c; *o = u[2]; }
    }
    ss = wave_sum(ss); if ((tid & 63) == 0) red[tid >> 6] = ss; __syncthreads();
    const float r = rsqrtf((red[0] + red[1] + red[2] + red[3]) * (1.f / DC) + EPS);
#pragma unroll
    for (int i = 0; i < 4; ++i) { const int c = tid * 4 + i; YC[(size_t)m * D + c] = (bf16_t)f2bf(tt[i] * r * conv_g[c]); }
}

__global__ void __launch_bounds__(256) k_mlstm_naive(const bf16_t* __restrict__ Z, const float* __restrict__ gates, const float* __restrict__ C0, const float* __restrict__ n0, const float* __restrict__ m0,
                              const float* __restrict__ ml_g, bf16_t* __restrict__ YC, float* __restrict__ dout) {
    __shared__ float qs[DK], ks[DK], ns[DK], red[8];
    const int e = threadIdx.x, h = blockIdx.x & 3, sb = blockIdx.x >> 2;
    const bool prompt = sb < NB; const int b = prompt ? sb : sb - NB; const int S = prompt ? SEQ : DS; const int row0 = prompt ? b * SEQ : MP + b * DS;
    float C[DK]; float mm;
    if (prompt) {
#pragma unroll
        for (int d = 0; d < DK; ++d) C[d] = 0.f;
        if (e < DK) ns[e] = 0.f; mm = 0.f;
    } else {
        const float* c0 = C0 + ((size_t)(b * NH + h) * DK) * DV + e;
#pragma unroll
        for (int d = 0; d < DK; ++d) C[d] = c0[(size_t)d * DV];
        if (e < DK) ns[e] = n0[(size_t)(b * NH + h) * DK + e]; mm = m0[b * NH + h];
    }
    const float gml = ml_g[h * DV + e];
    __syncthreads();
    for (int t = 0; t < S; ++t) {
        const size_t row = row0 + t; const bf16_t* zr = Z + row * NZ;
        const float li = gates[row * 8 + h], lf = gates[row * 8 + 4 + h];
        const float mn = fmaxf(lf + mm, li), fp = __expf(lf + mm - mn), ip = __expf(li - mn); mm = mn;
        if (e < DK) { qs[e] = bf2f(zr[ZC_Q + h * DK + e]) * QSCALE; ks[e] = bf2f(zr[ZC_K + h * DK + e]); }
        const float ve = bf2f(zr[ZC_V + h * DV + e]);
        __syncthreads();
        float acc = 0.f;
#pragma unroll
        for (int d = 0; d < DK; ++d) { C[d] = fp * C[d] + (ip * ks[d]) * ve; acc += qs[d] * C[d]; }
        float dp = 0.f;
        if (e < DK) { const float nn = fp * ns[e] + ip * ks[e]; ns[e] = nn; dp = qs[e] * nn; }
        dp = wave_sum(dp); float hs2;
        if ((e & 63) == 0) red[e >> 6] = dp;
        __syncthreads();
        const float den = red[0] + red[1];
        const float hv = acc / fmaxf(fabsf(den), __expf(-mn));
        hs2 = wave_sum(hv * hv);
        if ((e & 63) == 0) red[4 + (e >> 6)] = hs2;
        __syncthreads();
        const float rr = rsqrtf((red[4] + red[5] + red[6] + red[7]) * (1.f / DV) + EPS);
        const float o = bf2f(zr[ZC_O + h * DV + e]);
        YC[row * D + DC + h * DV + e] = (bf16_t)f2bf(sigmoidf_(o) * hv * rr * gml);
        __syncthreads();
    }
    float* oc = dout + (prompt ? O_PC : O_SC) + ((size_t)(b * NH + h) * DK) * DV + e;
#pragma unroll
    for (int d = 0; d < DK; ++d) oc[(size_t)d * DV] = C[d];
    if (e < DK) dout[(prompt ? O_PN : O_SN) + (size_t)(b * NH + h) * DK + e] = ns[e];
    if (e == 0) dout[(prompt ? O_PM : O_SM) + b * NH + h] = mm;
}

extern "C" void kernel_launch(void* const* d_in, const int* in_sizes, int n_in, void* d_out, int out_size, void* d_ws, size_t ws_size, hipStream_t stream) {
    if (n_in != 19 || (size_t)out_size != O_END || ws_size < WS_END) { fprintf(stderr, "kernel_launch: unexpected shapes: n_in %d out %d ws %zu\n", n_in, out_size, ws_size); return; }
    const float* x_p = (const float*)d_in[0]; const float* x_s = (const float*)d_in[1]; const float* st_conv = (const float*)d_in[2];
    const float* st_C = (const float*)d_in[3]; const float* st_n = (const float*)d_in[4]; const float* st_m = (const float*)d_in[5];
    const float* g1 = (const float*)d_in[6]; const float* w_in = (const float*)d_in[7]; const float* b_i = (const float*)d_in[8]; const float* b_f = (const float*)d_in[9];
    const float* conv_w = (const float*)d_in[10]; const float* conv_g = (const float*)d_in[11]; const float* ml_g = (const float*)d_in[12]; const float* w_out = (const float*)d_in[13];
    const float* g2 = (const float*)d_in[14]; const float* wg = (const float*)d_in[15]; const float* wu = (const float*)d_in[16]; const float* wd = (const float*)d_in[17]; const float* fg = (const float*)d_in[18];
    unsigned char* ws = (unsigned char*)d_ws; float* out = (float*)d_out;
    bf16_t* W1 = (bf16_t*)(ws + WS_W1); bf16_t* W2 = (bf16_t*)(ws + WS_W2); bf16_t* W3 = (bf16_t*)(ws + WS_W3); bf16_t* W4 = (bf16_t*)(ws + WS_W4);
    bf16_t* XN = (bf16_t*)(ws + WS_A); bf16_t* YC = (bf16_t*)(ws + WS_A); bf16_t* Zb = (bf16_t*)(ws + WS_B); bf16_t* Hb = (bf16_t*)(ws + WS_B); bf16_t* X1b = (bf16_t*)(ws + WS_C);
    float* gates = (float*)(ws + WS_GATES); float* ssq1 = (float*)(ws + WS_CTL) + CW_SSQ1; float* ssq2 = (float*)(ws + WS_CTL) + CW_SSQ2;
    (void)hipMemsetAsync(ws + WS_CTL, 0, 1 * MiB, stream);
    k_wprep<<<(D / 64) * (NZ / 32), 256, 0, stream>>>(w_in, D, NIN, NZ, W1, 0, nullptr);
    k_wprep<<<(D / 64) * (D / 32), 256, 0, stream>>>(w_out, D, D, D, W2, 0, nullptr);
    k_wprep<<<(D / 64) * (FF / 32), 256, 0, stream>>>(wg, D, FF, FF, W3, 1, g2);
    k_wprep<<<(D / 64) * (FF / 32), 256, 0, stream>>>(wu, D, FF, FF, W3, 2, g2);
    k_wprep<<<(FF / 64) * (D / 32), 256, 0, stream>>>(wd, FF, D, D, W4, 0, nullptr);
    k_xprep<<<M / 4, 256, 0, stream>>>(x_p, x_s, g1, w_in, b_i, b_f, XN, gates);
    k_gemm_naive<0><<<dim3(NZ / 64, M / 64), 256, 0, stream>>>(XN, W1, D, NZ, Zb, nullptr, nullptr, nullptr, nullptr);
    k_conv<<<M, 256, 0, stream>>>(Zb, st_conv, conv_w, conv_g, YC, out);
    k_mlstm_naive<<<(NB + DB) * NH, 256, 0, stream>>>(Zb, gates, st_C, st_n, st_m, ml_g, YC, out);
    k_gemm_naive<1><<<dim3(D / 64, M / 64), 256, 0, stream>>>(YC, W2, D, D, X1b, out, x_p, x_s, nullptr);
    k_rowssq<<<M / 4, 256, 0, stream>>>(out, ssq1);
    k_gemm_naive<2><<<dim3(FF / 64, M / 64), 256, 0, stream>>>(X1b, W3, D, FF, Hb, nullptr, nullptr, nullptr, ssq1);
    k_gemm_naive<3><<<dim3(D / 64, M / 64), 256, 0, stream>>>(Hb, W4, FF, D, nullptr, out, nullptr, nullptr, nullptr);
    k_rowssq<<<M / 4, 256, 0, stream>>>(out, ssq2);
    k_final<<<M / 4, 256, 0, stream>>>(out, ssq2, fg);
}
```

```cpp
#include <hip/hip_runtime.h>
#include <cstdio>
#include <cstdint>

constexpr int D = 2048, SEQ = 2048, NB = 4, DB = 128, DS = 8;
constexpr int MP = NB * SEQ, MS = DB * DS, M = MP + MS;
constexpr int DC = 1024, NH = 4, DK = 128, DV = 256;
constexpr int NZ = 6144, NIN = 6152, FF = 5632, N3 = 2 * FF;
constexpr float EPS = 1e-6f;
constexpr float QSCALE = 0.08838834764831845f;
constexpr int ZC_BG = 0, ZC_CG = 1024, ZC_XT = 2048, ZC_Q = 3072, ZC_K = 3584, ZC_V = 4096, ZC_O = 5120;
constexpr size_t O_Y = 0, O_PCONV = 18874368, O_PC = 18882560, O_PN = 19406848, O_PM = 19408896,
                 O_SCONV = 19408912, O_SC = 19671056, O_SN = 36448272, O_SM = 36513808, O_END = 36514320;
constexpr size_t MiB = 1u << 20;
constexpr size_t WS_CTL = 0, CTL_ZERO_BYTES = 1 * MiB;
constexpr size_t WS_W1 = 1 * MiB, WS_W2 = 25 * MiB, WS_W3 = 33 * MiB, WS_W4 = 77 * MiB;
constexpr size_t WS_A = 99 * MiB;
constexpr size_t WS_B = 135 * MiB;
constexpr size_t WS_C = 243 * MiB;
constexpr size_t WS_GATES = WS_C + 36 * MiB;
constexpr size_t WS_END = 283 * MiB;
constexpr int CW_TMO = 0, CW_CODE = 1;
constexpr int CW_BAR = 4096;
constexpr int CW_SSQ1 = 65536, CW_SSQ2 = 65536 + 16384;
constexpr int NWAVES = 8;
constexpr int RING_OFF = 0, RING_BYTES = 131072;
constexpr int LDSCTL_OFF = RING_BYTES, MISC_OFF = LDSCTL_OFF + 320;
constexpr int LDS_BYTES = 147456;

namespace pg8 {
#define PG8_LAS __attribute__((address_space(3)))
typedef unsigned short bf16_t;
typedef short bf16x8 __attribute__((ext_vector_type(8)));
typedef float f32x4 __attribute__((ext_vector_type(4)));
typedef unsigned u32x4 __attribute__((ext_vector_type(4)));
constexpr int BM = 256, BK = 64, HALF = 128, HTB = HALF * BK * 2  , STAGE_BYTES = 8 * HTB, NXCD = 8, WGM = 8;

__host__ __device__ __forceinline__ int lds_byte(int r, int c) { const int st = (r >> 4) * 2 + (c >> 5), rr = r & 15, cc = c & 31, ob = rr * 64 + cc * 2; return st * 1024 + (ob ^ (((ob >> 9) & 1) << 5)); }
__host__ __device__ __forceinline__ void stage_rc(int b, int& R, int& C) { const int st = b / 1024, sb = b % 1024, swz = sb ^ (((sb >> 9) & 1) << 5); R = (st >> 1) * 16 + swz / 64; C = (st & 1) * 32 + (swz % 64) / 2; }
__host__ __device__ __forceinline__ int perm32(int rho) { const int n = rho >> 4, i = rho & 15; return 8 * (i >> 2) + 4 * n + (i & 3); }

struct Unit { int pm, pn; };
struct Gemm { const bf16_t* A; const bf16_t* Bt; int M, N, K; };

struct StaticOrder {
    int nM, nN, nwg, G, c;
    __host__ __device__ void init(int M, int N, int G_, int c_) { nM = M / BM; nN = N / BM; nwg = nM * nN; G = G_; c = c_; }
    __host__ __device__ bool next(int i, Unit& u) const {
        const long L = (long)i * G + c; if (L >= nwg) return false;
        int wgid = (int)L; { const int q = nwg / NXCD, r = nwg % NXCD, xcd = wgid % NXCD, off = wgid / NXCD; wgid = (xcd < r ? xcd * (q + 1) : r * (q + 1) + (xcd - r) * q) + off; }
        const int nig = WGM * nN, gid = wgid / nig, fm = gid * WGM, gsz = (nM - fm) < WGM ? (nM - fm) : WGM;
        u.pm = fm + ((wgid % nig) % gsz); u.pn = (wgid % nig) / gsz; return true;
    }
    __device__ __forceinline__ void a_ready(const Unit&) const {}
    __device__ __forceinline__ void done(const Unit&) const {}
};
__device__ __forceinline__ unsigned cvt_pk_bf16(float lo, float hi) { unsigned r; asm volatile("v_cvt_pk_bf16_f32 %0, %1, %2" : "=v"(r) : "v"(lo), "v"(hi)); return r; }
typedef float f32x2 __attribute__((ext_vector_type(2)));
struct EpiZ {
    static constexpr bool PERM = true, AFTER_DRAIN = false;
    bf16_t* O; int ldc;
    __device__ __forceinline__ void operator()(const f32x4 (&acc)[2][2][4][2], const Unit& u, int wr, int wc, int fr, int fq) const {
        const int row0 = u.pm * BM + wr * 64 + fr, col0 = u.pn * BM + wc * 32 + 8 * fq;
#pragma unroll
        for (int ai = 0; ai < 2; ++ai)
#pragma unroll
            for (int m = 0; m < 4; ++m) { bf16_t* rowp = O + (size_t)(row0 + ai * HALF + m * 16) * ldc + col0;
#pragma unroll
                for (int bj = 0; bj < 2; ++bj) { const f32x4 v0 = acc[ai][bj][m][0], v1 = acc[ai][bj][m][1];
                    u32x4 w; w.x = cvt_pk_bf16(v0[0], v0[1]); w.y = cvt_pk_bf16(v0[2], v0[3]); w.z = cvt_pk_bf16(v1[0], v1[1]); w.w = cvt_pk_bf16(v1[2], v1[3]);
                    *(u32x4*)(rowp + bj * HALF) = w; } }
    }
};
struct EpiRes {
    static constexpr bool PERM = true, AFTER_DRAIN = false;
    const float* xp; const float* xs; int rows_p; float* out; bf16_t* X1b; float* ssq;
    __device__ __forceinline__ void operator()(const f32x4 (&acc)[2][2][4][2], const Unit& u, int wr, int wc, int fr, int fq) const {
        const int row0 = u.pm * BM + wr * 64 + fr, col0 = u.pn * BM + wc * 32 + 8 * fq;
#pragma unroll
        for (int ai = 0; ai < 2; ++ai)
#pragma unroll
            for (int m = 0; m < 4; ++m) {
                const int row = row0 + ai * HALF + m * 16;
                const float* xr = (row < rows_p ? xp + (size_t)row * 2048 : xs + (size_t)(row - rows_p) * 2048) + col0;
                float* orow = out + (size_t)row * 2048 + col0; float s = 0.f;
#pragma unroll
                for (int bj = 0; bj < 2; ++bj) {
                    const f32x4 v0 = acc[ai][bj][m][0] + *(const f32x4*)(xr + bj * HALF), v1 = acc[ai][bj][m][1] + *(const f32x4*)(xr + bj * HALF + 4);
                    *(f32x4*)(orow + bj * HALF) = v0; *(f32x4*)(orow + bj * HALF + 4) = v1;
                    s += (v0[0] * v0[0] + v0[1] * v0[1]) + (v0[2] * v0[2] + v0[3] * v0[3]) + (v1[0] * v1[0] + v1[1] * v1[1]) + (v1[2] * v1[2] + v1[3] * v1[3]);
                    if (X1b) { u32x4 w; w.x = cvt_pk_bf16(v0[0], v0[1]); w.y = cvt_pk_bf16(v0[2], v0[3]); w.z = cvt_pk_bf16(v1[0], v1[1]); w.w = cvt_pk_bf16(v1[2], v1[3]);
                        *(u32x4*)(X1b + (size_t)row * 2048 + col0 + bj * HALF) = w; }
                }
                s += __shfl_xor(s, 16); s += __shfl_xor(s, 32);
                if (fq == 0) atomicAdd(ssq + row, s);
                asm volatile("" ::: "memory");
            }
    }
};
struct EpiH {
    static constexpr bool PERM = true, AFTER_DRAIN = false;
    bf16_t* H; const float* ssq;
    __device__ __forceinline__ void operator()(const f32x4 (&acc)[2][2][4][2], const Unit& u, int wr, int wc, int fr, int fq) const {
        const int row0 = u.pm * BM + wr * 64 + fr, col0 = u.pn * HALF + wc * 32 + 8 * fq;
#pragma unroll
        for (int ai = 0; ai < 2; ++ai)
#pragma unroll
            for (int m = 0; m < 4; ++m) {
                const int row = row0 + ai * HALF + m * 16;
                const float r = rsqrtf(ssq[row] * (1.0f / 2048.0f) + 1e-6f);
                float h[8];
#pragma unroll
                for (int n = 0; n < 2; ++n)
#pragma unroll
                    for (int j = 0; j < 4; ++j) { const float g = acc[ai][0][m][n][j] * r, up = acc[ai][1][m][n][j] * r;
                        h[4 * n + j] = g * __builtin_amdgcn_rcpf(1.0f + __expf(-g)) * up; }
                u32x4 w; w.x = cvt_pk_bf16(h[0], h[1]); w.y = cvt_pk_bf16(h[2], h[3]); w.z = cvt_pk_bf16(h[4], h[5]); w.w = cvt_pk_bf16(h[6], h[7]);
                *(u32x4*)(H + (size_t)row * 5632 + col0) = w;
            }
    }
};
template <class Epi, class Sched, bool ALIGN_EPI = false, bool SP2 = false>
__device__ __forceinline__ void gemm_phase(PG8_LAS unsigned char* lds, const Gemm g, const Sched& S, const Epi& E) {
    const int tid = threadIdx.x, wid = __builtin_amdgcn_readfirstlane(tid >> 6), lane = tid & 63, wr = wid >> 2, wc = wid & 3, fr = lane & 15, fq = lane >> 4;
    const int K = g.K, nt = K / BK;
    unsigned voffA[2], voffB[2];
#pragma unroll
    for (int i = 0; i < 2; ++i) { int R, C; stage_rc(tid * 16 + i * 8192, R, C); const int Rb = Epi::PERM ? ((R & ~31) + perm32(R & 31)) : R;
        voffA[i] = (unsigned)(R * K + C) * 2u; voffB[i] = (unsigned)(Rb * K + C) * 2u; }
    const size_t kstep = (size_t)(BK * 2);
    const size_t hstep = (size_t)HALF * K * 2;
    const size_t tstep = 2 * hstep;
    const unsigned ldsw = (unsigned)wid * 1024u;
    const int aoff = lds_byte(wr * 64 + fr, fq * 8), boff = lds_byte(wc * 32 + fr, fq * 8);
#define PG8_SA(b, h) (((b) * 2 + (h)) * HTB)
#define PG8_SB(b, h) ((4 + (b) * 2 + (h)) * HTB)
#define PG8_STAGE(bufoff, gbase, voff) do { _Pragma("unroll") for (int _i = 0; _i < 2; ++_i) \
        __builtin_amdgcn_global_load_lds((const unsigned*)((const char*)(gbase) + (voff)[_i]), (PG8_LAS unsigned*)(lds + (bufoff) + ldsw + _i * 8192), 16, 0, 0); } while (0)
#define PG8_LDA(dst, b, h) do { _Pragma("unroll") for (int m = 0; m < 4; ++m) _Pragma("unroll") for (int k = 0; k < 2; ++k) dst[m][k] = *(const PG8_LAS bf16x8*)(lds + PG8_SA(b, h) + aoff + m * 2048 + k * 1024); } while (0)
#define PG8_LDB(dst, b, h) do { _Pragma("unroll") for (int n = 0; n < 2; ++n) _Pragma("unroll") for (int k = 0; k < 2; ++k) dst[n][k] = *(const PG8_LAS bf16x8*)(lds + PG8_SB(b, h) + boff + n * 2048 + k * 1024); } while (0)
#define PG8_MMA(ai, bj, At, Bt) do { __builtin_amdgcn_s_setprio(1); _Pragma("unroll") for (int m = 0; m < 4; ++m) _Pragma("unroll") for (int n = 0; n < 2; ++n) _Pragma("unroll") for (int k = 0; k < 2; ++k) \
        acc[ai][bj][m][n] = __builtin_amdgcn_mfma_f32_16x16x32_bf16(Bt[n][k], At[m][k], acc[ai][bj][m][n], 0, 0, 0); __builtin_amdgcn_s_setprio(0); } while (0)
#define PG8_WAIT_V(n) asm volatile("s_waitcnt vmcnt(" #n ")" ::: "memory")
#define PG8_WAIT_L(n) asm volatile("s_waitcnt lgkmcnt(" #n ")" ::: "memory")
#define PG8_BAR __builtin_amdgcn_s_barrier()
#define PG8_SCHED __builtin_amdgcn_sched_barrier(0)
    Unit cur, nxt; int ui = 0;
    if (!S.next(0, cur)) return;
    f32x4 acc[2][2][4][2];
#pragma unroll
    for (int a = 0; a < 2; ++a)
#pragma unroll
        for (int b = 0; b < 2; ++b)
#pragma unroll
            for (int m = 0; m < 4; ++m)
#pragma unroll
                for (int n = 0; n < 2; ++n) acc[a][b][m][n] = (f32x4){0.f, 0.f, 0.f, 0.f};
    bf16x8 At[4][2], B0[2][2], B1[2][2];
    const char* cA = (const char*)g.A + (size_t)cur.pm * tstep; const char* cB = (const char*)g.Bt + (size_t)cur.pn * tstep;
    S.a_ready(cur);
    if constexpr (SP2) {
        PG8_STAGE(PG8_SB(0, 0), cB, voffB); PG8_STAGE(PG8_SB(0, 1), cB + hstep, voffB); PG8_STAGE(PG8_SA(0, 0), cA, voffA); PG8_STAGE(PG8_SA(0, 1), cA + hstep, voffA);
        if (wr == 1) PG8_BAR;
        PG8_WAIT_V(2); PG8_BAR;
        PG8_STAGE(PG8_SB(1, 0), cB + kstep, voffB); PG8_STAGE(PG8_SA(1, 0), cA + kstep, voffA); PG8_STAGE(PG8_SB(1, 1), cB + hstep + kstep, voffB);
        PG8_WAIT_V(6); PG8_BAR;
    } else {
        PG8_STAGE(PG8_SB(0, 0), cB, voffB); PG8_STAGE(PG8_SA(0, 0), cA, voffA); PG8_STAGE(PG8_SB(0, 1), cB + hstep, voffB); PG8_STAGE(PG8_SA(0, 1), cA + hstep, voffA);
        if (wr == 1) PG8_BAR;
        PG8_WAIT_V(4); PG8_BAR;
        PG8_STAGE(PG8_SB(1, 0), cB + kstep, voffB); PG8_STAGE(PG8_SA(1, 0), cA + kstep, voffA); PG8_STAGE(PG8_SB(1, 1), cB + hstep + kstep, voffB);
        PG8_WAIT_V(6); PG8_BAR;
    }
    for (;;) {
        const bool has_next = S.next(ui + 1, nxt);
        const char* nA = has_next ? (const char*)g.A + (size_t)nxt.pm * tstep : cA; const char* nB = has_next ? (const char*)g.Bt + (size_t)nxt.pn * tstep : cB;
        for (int t = 0; t < nt; t += 2) {
            const bool last = (t == nt - 2);
            const char* a1 = cA + (size_t)(t + 1) * kstep;
            const char* a2 = last ? nA : cA + (size_t)(t + 2) * kstep; const char* b2 = last ? nB : cB + (size_t)(t + 2) * kstep;
            const char* a3 = a2 + kstep; const char* b3 = b2 + kstep;
            if (last && has_next) S.a_ready(nxt);
            if constexpr (SP2) {
            PG8_LDB(B0, 0, 0); PG8_LDB(B1, 0, 1); PG8_SCHED; PG8_LDA(At, 0, 0); PG8_STAGE(PG8_SA(1, 1), a1 + hstep, voffA);
            PG8_WAIT_V(8); PG8_WAIT_L(0); PG8_BAR; PG8_MMA(0, 0, At, B0); PG8_MMA(0, 1, At, B1); PG8_BAR; PG8_SCHED;
            PG8_LDA(At, 0, 1); PG8_STAGE(PG8_SB(0, 0), b2, voffB); PG8_STAGE(PG8_SB(0, 1), b2 + hstep, voffB); PG8_STAGE(PG8_SA(0, 0), a2, voffA);
            PG8_WAIT_V(8); PG8_WAIT_L(0); PG8_BAR; PG8_MMA(1, 0, At, B0); PG8_MMA(1, 1, At, B1); PG8_BAR; PG8_SCHED;
            PG8_LDB(B0, 1, 0); PG8_LDB(B1, 1, 1); PG8_SCHED; PG8_LDA(At, 1, 0); PG8_STAGE(PG8_SA(0, 1), a2 + hstep, voffA);
            PG8_WAIT_V(8); PG8_WAIT_L(0); PG8_BAR; PG8_MMA(0, 0, At, B0); PG8_MMA(0, 1, At, B1); PG8_BAR; PG8_SCHED;
            PG8_LDA(At, 1, 1); PG8_STAGE(PG8_SB(1, 0), b3, voffB); PG8_STAGE(PG8_SB(1, 1), b3 + hstep, voffB); PG8_STAGE(PG8_SA(1, 0), a3, voffA);
            PG8_WAIT_V(8); PG8_WAIT_L(0); PG8_BAR; PG8_MMA(1, 0, At, B0); PG8_MMA(1, 1, At, B1); PG8_BAR; PG8_SCHED;
            } else {
            PG8_LDB(B0, 0, 0); PG8_SCHED; PG8_LDA(At, 0, 0); PG8_STAGE(PG8_SA(1, 1), a1 + hstep, voffA);
            PG8_WAIT_L(8); PG8_BAR; PG8_WAIT_L(0); PG8_MMA(0, 0, At, B0); PG8_BAR; PG8_SCHED;
            PG8_LDB(B1, 0, 1); PG8_STAGE(PG8_SB(0, 0), b2, voffB);
            PG8_BAR; PG8_WAIT_L(0); PG8_MMA(0, 1, At, B1); PG8_BAR;
            PG8_LDA(At, 0, 1); PG8_STAGE(PG8_SA(0, 0), a2, voffA);
            PG8_BAR; PG8_WAIT_L(0); PG8_MMA(1, 0, At, B0); PG8_BAR; PG8_SCHED;
            PG8_STAGE(PG8_SB(0, 1), b2 + hstep, voffB);
            PG8_WAIT_V(6); PG8_BAR; PG8_MMA(1, 1, At, B1); PG8_BAR;
            PG8_LDB(B0, 1, 0); PG8_SCHED; PG8_LDA(At, 1, 0); PG8_STAGE(PG8_SA(0, 1), a2 + hstep, voffA);
            PG8_WAIT_L(8); PG8_BAR; PG8_WAIT_L(0); PG8_MMA(0, 0, At, B0); PG8_BAR; PG8_SCHED;
            PG8_LDB(B1, 1, 1); PG8_STAGE(PG8_SB(1, 0), b3, voffB);
            PG8_BAR; PG8_WAIT_L(0); PG8_MMA(0, 1, At, B1); PG8_BAR;
            PG8_LDA(At, 1, 1); PG8_STAGE(PG8_SA(1, 0), a3, voffA);
            PG8_BAR; PG8_WAIT_L(0); PG8_MMA(1, 0, At, B0); PG8_BAR; PG8_SCHED;
            PG8_STAGE(PG8_SB(1, 1), b3 + hstep, voffB);
            PG8_WAIT_V(6); PG8_BAR; PG8_MMA(1, 1, At, B1); PG8_BAR;
            }
        }
        if constexpr (ALIGN_EPI) { if (wr == 0) PG8_BAR; }
        if constexpr (!Epi::AFTER_DRAIN) { E(acc, cur, wr, wc, fr, fq); S.done(cur); }
        if (!has_next) break;
#pragma unroll
        for (int a = 0; a < 2; ++a)
#pragma unroll
            for (int b = 0; b < 2; ++b)
#pragma unroll
                for (int m = 0; m < 4; ++m)
#pragma unroll
                    for (int n = 0; n < 2; ++n) acc[a][b][m][n] = (f32x4){0.f, 0.f, 0.f, 0.f};
        cur = nxt; cA = nA; cB = nB; ++ui;
        if constexpr (ALIGN_EPI) { if (wr == 1) PG8_BAR; }
    }
    PG8_WAIT_V(0);
    if constexpr (!ALIGN_EPI) { if (wr == 0) PG8_BAR; }
    PG8_BAR;
    if constexpr (Epi::AFTER_DRAIN) { E.fused(acc, cur, wr, wc, fr, fq, lds, wid, lane); S.done(cur); }
#undef PG8_SA
#undef PG8_SB
#undef PG8_STAGE
#undef PG8_LDA
#undef PG8_LDB
#undef PG8_MMA
#undef PG8_WAIT_V
#undef PG8_WAIT_L
#undef PG8_BAR
#undef PG8_SCHED
}
}
#ifndef PG8_SP2
#define PG8_SP2 true
#endif
#ifndef PG8_ALIGN
#define PG8_ALIGN true
#endif
#define GAS __attribute__((address_space(1)))
#define LAS __attribute__((address_space(3)))
typedef unsigned short bf16;
typedef unsigned v4u __attribute__((ext_vector_type(4)));
typedef float f32x4 __attribute__((ext_vector_type(4)));
typedef short bf16x8 __attribute__((ext_vector_type(8)));
typedef GAS unsigned gu32;
typedef GAS unsigned long long gu64;
#define RLX_AGENT __ATOMIC_RELAXED, __HIP_MEMORY_SCOPE_AGENT
#define LDS_WAIT() asm volatile("s_waitcnt lgkmcnt(0)" ::: "memory")
#define VM_WAIT() asm volatile("s_waitcnt vmcnt(0)" ::: "memory")
__device__ __forceinline__ unsigned f2bf(float f) { unsigned u = __builtin_bit_cast(unsigned, f); return (u + 0x7fffu + ((u >> 16) & 1u)) >> 16; }
__device__ __forceinline__ unsigned pk2(float lo, float hi) { return f2bf(lo) | (f2bf(hi) << 16); }
__device__ __forceinline__ float bf2f(unsigned b) { return __builtin_bit_cast(float, b << 16); }
__device__ __forceinline__ float wave_sum(float v) {
#pragma unroll
    for (int o = 1; o < 64; o <<= 1) v += __shfl_xor(v, o);
    return v;
}
__device__ __forceinline__ float sigmoidf_(float x) { return 1.f / (1.f + __expf(-x)); }
__device__ __forceinline__ float log_sigmoid(float x) { return fminf(x, 0.f) - log1pf(__expf(-fabsf(x))); }

#define XB_TMO      128
#define XB_XCNT(j)  (256  + 64 * (j))
#define XB_XSUB(j)  (1280 + 64 * (j))
#define XB_XGEN(j)  (2304 + 64 * (j))
#define XB_TOP      3328
#define XB_TOPGEN   3392
#define XCD_BAR_WORDS 3456
#define XB_SPIN_CAP (1u << 18)

__device__ __forceinline__ unsigned xb_ld(unsigned* p)              { return __hip_atomic_load(p, __ATOMIC_RELAXED, __HIP_MEMORY_SCOPE_AGENT); }
__device__ __forceinline__ unsigned xb_add(unsigned* p, unsigned v) { return __hip_atomic_fetch_add(p, v, __ATOMIC_RELAXED, __HIP_MEMORY_SCOPE_AGENT); }
__device__ __forceinline__ unsigned xb_xcc_id() { return (unsigned)__builtin_amdgcn_s_getreg((3 << 11) | 20) & 0xFu; }
#define XB_SPIN(cond, bar) do { unsigned _sp = 0; while (cond) { __builtin_amdgcn_s_sleep(1); \
    if ((++_sp & 255u) == 0u) { if (xb_ld(&(bar)[XB_TMO])) break; if (_sp > XB_SPIN_CAP) { atomicAdd(&(bar)[XB_TMO], 1u); break; } } } } while (0)

struct XcdBarrier {
    unsigned* bar; unsigned x;
    volatile LAS unsigned* st;
};

__device__ __forceinline__ XcdBarrier xcd_barrier_post(unsigned* bar, volatile LAS unsigned* st) {
    XcdBarrier b; b.bar = bar; b.x = xb_xcc_id(); b.st = st;
    if (threadIdx.x == 0) (void)xb_add(&bar[XB_XCNT(b.x)], 1u);
    return b;
}
__device__ __forceinline__ void xcd_barrier_complete(unsigned* bar, unsigned x, unsigned& nloc, unsigned& nx) {
    const unsigned G = gridDim.x * gridDim.y * gridDim.z;
    unsigned sum, cnt, mine, sp = 0u;
    for (;;) {
        sum = 0u; cnt = 0u; mine = 0u;
#pragma unroll
        for (unsigned j = 0; j < 16; ++j) { const unsigned c = xb_ld(&bar[XB_XCNT(j)]); sum += c; cnt += (c > 0u) ? 1u : 0u; mine = (j == x) ? c : mine; }
        if (sum == G) break;
        __builtin_amdgcn_s_sleep(1);
        if ((++sp & 255u) == 0u) { if (xb_ld(&bar[XB_TMO])) break; if (sp > XB_SPIN_CAP) { atomicAdd(&bar[XB_TMO], 1u); break; } }
    }
    nloc = mine > 0u ? mine : 1u; nx = cnt > 0u ? cnt : 1u;
}

__device__ __forceinline__ void xcd_barrier(const XcdBarrier& b) {
    asm volatile("s_waitcnt vmcnt(0)" ::: "memory");
    __syncthreads();
    if (threadIdx.x == 0) {
        unsigned* bar = b.bar;
        __builtin_amdgcn_s_waitcnt(0);
        unsigned nloc = b.st[0], nx = b.st[1];
        if (nloc == 0u) { xcd_barrier_complete(bar, b.x, nloc, nx); b.st[0] = nloc; b.st[1] = nx; }
        const unsigned old = xb_add(&bar[XB_XSUB(b.x)], 1u);
        const unsigned gen = old / nloc;
        if (old + 1u == (gen + 1u) * nloc) {
            __builtin_amdgcn_fence(__ATOMIC_RELEASE, "agent");
            asm volatile("s_waitcnt vmcnt(0)" ::: "memory");
            const unsigned og = xb_add(&bar[XB_TOP], 1u);
            const unsigned tg = og / nx;
            if (og + 1u == (tg + 1u) * nx) xb_add(&bar[XB_TOPGEN], 1u);
            else XB_SPIN(xb_ld(&bar[XB_TOPGEN]) == tg, bar);
            __builtin_amdgcn_fence(__ATOMIC_ACQUIRE, "agent");
            xb_add(&bar[XB_XGEN(b.x)], 1u);
            asm volatile("s_waitcnt vmcnt(0)" ::: "memory");
        } else {
            XB_SPIN(xb_ld(&bar[XB_XGEN(b.x)]) == gen, bar);
            __builtin_amdgcn_fence(__ATOMIC_ACQUIRE, "agent");
            asm volatile("s_waitcnt vmcnt(0)" ::: "memory");
        }
    }
    __syncthreads();
}
struct Frame {
    LAS unsigned char* lds;
    volatile LAS unsigned* MISC;
    gu32* ctl;
    int tid, lane, wave;
    int vcu, G;
    const float *x_p, *x_s, *st_conv, *st_C, *st_n, *st_m, *g1, *w_in, *b_i, *b_f, *conv_w, *conv_g, *ml_g, *w_out, *g2, *wg, *wu, *wd, *fg;
    float* out;
    bf16 *W1, *W2, *W3, *W4, *XN, *YC, *Z, *HB, *X1b;
    float *gates, *ssq1, *ssq2;
};

__device__ __forceinline__ void p0_transpose_item(const float* W, int ldw, int K, int nblk, bf16* WT, int mode, const float* kgain, LAS float* scr, int item, int lane) {
    const int kb = item / nblk, nb = item % nblk, k0 = 64 * kb, n0 = 32 * nb;
#pragma unroll 8
    for (int i = 0; i < 32; ++i) { const int kk = 2 * i + (lane >> 5); const float g = kgain ? kgain[k0 + kk] : 1.f; scr[kk * 33 + (lane & 31)] = W[(size_t)(k0 + kk) * ldw + n0 + (lane & 31)] * g; }
    LDS_WAIT(); asm volatile("" ::: "memory");
    const int c = lane & 7;
#pragma unroll
    for (int j = 0; j < 4; ++j) { const int n = (lane >> 3) + 8 * j; const LAS float* s = scr + (8 * c) * 33 + n;
        v4u o; o.x = pk2(s[0 * 33], s[1 * 33]); o.y = pk2(s[2 * 33], s[3 * 33]); o.z = pk2(s[4 * 33], s[5 * 33]); o.w = pk2(s[6 * 33], s[7 * 33]);
        const int jn = n0 + n; int drow = jn; if (mode == 1) drow = 256 * (jn >> 7) + (jn & 127); if (mode == 2) drow = 256 * (jn >> 7) + 128 + (jn & 127);
        *(GAS v4u*)(WT + (size_t)drow * K + k0 + 8 * c) = o; }
    LDS_WAIT(); asm volatile("" ::: "memory");
}
__device__ __forceinline__ void p0_xrow(Frame& F, int m, const LAS float* gwl) {
    const float* xr = m < MP ? F.x_p + (size_t)m * D : F.x_s + (size_t)(m - MP) * D;
    const int lane = F.lane;
    f32x4 v[8]; float s = 0.f;
#pragma unroll
    for (int j = 0; j < 8; ++j) { v[j] = *(const GAS f32x4*)(xr + 256 * j + 4 * lane); s += (v[j].x * v[j].x + v[j].y * v[j].y) + (v[j].z * v[j].z + v[j].w * v[j].w); }
    const float r = rsqrtf(wave_sum(s) * (1.f / D) + EPS);
    float ga[8] = {0.f, 0.f, 0.f, 0.f, 0.f, 0.f, 0.f, 0.f};
#pragma unroll
    for (int j = 0; j < 8; ++j) {
        const int k = 256 * j + 4 * lane;
        const f32x4 gg = *(const GAS f32x4*)(F.g1 + k);
        const f32x4 xn = v[j] * r * gg;
        *(GAS unsigned long long*)(F.XN + (size_t)m * D + k) = (unsigned long long)pk2(xn.x, xn.y) | ((unsigned long long)pk2(xn.z, xn.w) << 32);
#pragma unroll
        for (int q = 0; q < 8; ++q) { const f32x4 w = *(const LAS f32x4*)(gwl + q * D + k); ga[q] += (xn.x * w.x + xn.y * w.y) + (xn.z * w.z + xn.w * w.w); }
    }
#pragma unroll
    for (int q = 0; q < 8; ++q) ga[q] = wave_sum(ga[q]);
    if (lane == 0) {
#pragma unroll
        for (int h = 0; h < 4; ++h) { F.gates[(size_t)m * 8 + h] = ga[h] + F.b_i[h]; F.gates[(size_t)m * 8 + 4 + h] = log_sigmoid(ga[4 + h] + F.b_f[h]); }
    }
}
__device__ __forceinline__ void p0_prologue(Frame& F) {
    LAS float* scr = (LAS float*)(F.lds + RING_OFF + F.wave * 16384);
    const int gw = F.vcu * NWAVES + F.wave, NGW = F.G * NWAVES;
    constexpr int I_1 = (D / 64) * (NZ / 32), I_2 = (D / 64) * (D / 32), I_3 = (D / 64) * (FF / 32), I_4 = (FF / 64) * (D / 32);
    constexpr int NITEMS = I_1 + I_2 + 2 * I_3 + I_4;
    for (int it = gw; it < NITEMS; it += NGW) {
        int r = it;
        if (r < I_1) { p0_transpose_item(F.w_in, NIN, D, NZ / 32, F.W1, 0, nullptr, scr, r, F.lane); continue; } r -= I_1;
        if (r < I_2) { p0_transpose_item(F.w_out, D, D, D / 32, F.W2, 0, nullptr, scr, r, F.lane); continue; } r -= I_2;
        if (r < I_3) { p0_transpose_item(F.wg, FF, D, FF / 32, F.W3, 1, F.g2, scr, r, F.lane); continue; } r -= I_3;
        if (r < I_3) { p0_transpose_item(F.wu, FF, D, FF / 32, F.W3, 2, F.g2, scr, r, F.lane); continue; } r -= I_3;
        p0_transpose_item(F.wd, D, FF, D / 32, F.W4, 0, nullptr, scr, r, F.lane);
    }
    __syncthreads();
    LAS float* gwl = (LAS float*)(F.lds + RING_OFF);
    for (int k = F.tid; k < D; k += NWAVES * 64) {
        const f32x4 a = *(const GAS f32x4*)(F.w_in + (size_t)k * NIN + NZ), b = *(const GAS f32x4*)(F.w_in + (size_t)k * NIN + NZ + 4);
        gwl[0 * D + k] = a.x; gwl[1 * D + k] = a.y; gwl[2 * D + k] = a.z; gwl[3 * D + k] = a.w; gwl[4 * D + k] = b.x; gwl[5 * D + k] = b.y; gwl[6 * D + k] = b.z; gwl[7 * D + k] = b.w;
    }
    __syncthreads();
    for (int m = gw; m < M; m += NGW) { asm volatile("" ::: "memory"); p0_xrow(F, m, gwl); }
    __syncthreads();
}
__device__ __forceinline__ void final_norm_phase(Frame& F) {
    const int gw = F.vcu * NWAVES + F.wave, NGW = F.G * NWAVES;
    for (int m = gw; m < M; m += NGW) {
        const float r = rsqrtf(F.ssq2[m] * (1.f / D) + EPS);
#pragma unroll
        for (int j = 0; j < 8; ++j) { GAS f32x4* p = (GAS f32x4*)(F.out + (size_t)m * D + 256 * j + 4 * F.lane); const f32x4 g = *(const GAS f32x4*)(F.fg + 256 * j + 4 * F.lane); *p = *p * r * g; }
    }
}
typedef unsigned short bf16_t;
__global__ void k_conv(const bf16_t* __restrict__ Z, const float* __restrict__ state_conv, const float* __restrict__ conv_w, const float* __restrict__ conv_g,
                       bf16_t* __restrict__ YC, float* __restrict__ dout) {
    __shared__ float red[4];
    const int m = blockIdx.x, tid = threadIdx.x;
    int b, t, S; const bool prompt = m < MP;
    if (prompt) { b = m / SEQ; t = m % SEQ; S = SEQ; } else { b = (m - MP) / DS; t = (m - MP) % DS; S = DS; }
    float tt[4]; float ss = 0.f;
#pragma unroll
    for (int i = 0; i < 4; ++i) {
        const int c = tid * 4 + i;
        float u[3];
#pragma unroll
        for (int j = 0; j < 3; ++j) {
            const int tp = t - 2 + j;
            if (tp >= 0) { const bf16_t* zr = Z + (size_t)(m - 2 + j) * NZ; u[j] = bf2f(zr[ZC_CG + c]) * bf2f(zr[ZC_XT + c]); }
            else u[j] = prompt ? 0.f : state_conv[((size_t)b * 2 + (tp + 2)) * DC + c];
        }
        const float cv = u[0] * conv_w[c] + u[1] * conv_w[DC + c] + u[2] * conv_w[2 * DC + c];
        tt[i] = bf2f(Z[(size_t)m * NZ + ZC_BG + c]) * cv; ss += tt[i] * tt[i];
        if (t >= S - 2) { float* o = dout + (prompt ? O_PCONV : O_SCONV) + ((size_t)b * 2 + (t - (S - 2))) * DC + c; *o = u[2]; }
    }
    ss = wave_sum(ss); if ((tid & 63) == 0) red[tid >> 6] = ss; __syncthreads();
    const float r = rsqrtf((red[0] + red[1] + red[2] + red[3]) * (1.f / DC) + EPS);
#pragma unroll
    for (int i = 0; i < 4; ++i) { const int c = tid * 4 + i; YC[(size_t)m * D + c] = (bf16_t)f2bf(tt[i] * r * conv_g[c]); }
}

__global__ void __launch_bounds__(256) k_mlstm_naive(const bf16_t* __restrict__ Z, const float* __restrict__ gates, const float* __restrict__ C0, const float* __restrict__ n0, const float* __restrict__ m0,
                              const float* __restrict__ ml_g, bf16_t* __restrict__ YC, float* __restrict__ dout) {
    __shared__ float qs[DK], ks[DK], ns[DK], red[8];
    const int e = threadIdx.x, h = blockIdx.x & 3, sb = blockIdx.x >> 2;
    const bool prompt = sb < NB; const int b = prompt ? sb : sb - NB; const int S = prompt ? SEQ : DS; const int row0 = prompt ? b * SEQ : MP + b * DS;
    float C[DK]; float mm;
    if (prompt) {
#pragma unroll
        for (int d = 0; d < DK; ++d) C[d] = 0.f;
        if (e < DK) ns[e] = 0.f; mm = 0.f;
    } else {
        const float* c0 = C0 + ((size_t)(b * NH + h) * DK) * DV + e;
#pragma unroll
        for (int d = 0; d < DK; ++d) C[d] = c0[(size_t)d * DV];
        if (e < DK) ns[e] = n0[(size_t)(b * NH + h) * DK + e]; mm = m0[b * NH + h];
    }
    const float gml = ml_g[h * DV + e];
    __syncthreads();
    for (int t = 0; t < S; ++t) {
        const size_t row = row0 + t; const bf16_t* zr = Z + row * NZ;
        const float li = gates[row * 8 + h], lf = gates[row * 8 + 4 + h];
        const float mn = fmaxf(lf + mm, li), fp = __expf(lf + mm - mn), ip = __expf(li - mn); mm = mn;
        if (e < DK) { qs[e] = bf2f(zr[ZC_Q + h * DK + e]) * QSCALE; ks[e] = bf2f(zr[ZC_K + h * DK + e]); }
        const float ve = bf2f(zr[ZC_V + h * DV + e]);
        __syncthreads();
        float acc = 0.f;
#pragma unroll
        for (int d = 0; d < DK; ++d) { C[d] = fp * C[d] + (ip * ks[d]) * ve; acc += qs[d] * C[d]; }
        float dp = 0.f;
        if (e < DK) { const float nn = fp * ns[e] + ip * ks[e]; ns[e] = nn; dp = qs[e] * nn; }
        dp = wave_sum(dp); float hs2;
        if ((e & 63) == 0) red[e >> 6] = dp;
        __syncthreads();
        const float den = red[0] + red[1];
        const float hv = acc / fmaxf(fabsf(den), __expf(-mn));
        hs2 = wave_sum(hv * hv);
        if ((e & 63) == 0) red[4 + (e >> 6)] = hs2;
        __syncthreads();
        const float rr = rsqrtf((red[4] + red[5] + red[6] + red[7]) * (1.f / DV) + EPS);
        const float o = bf2f(zr[ZC_O + h * DV + e]);
        YC[row * D + DC + h * DV + e] = (bf16_t)f2bf(sigmoidf_(o) * hv * rr * gml);
        __syncthreads();
    }
    float* oc = dout + (prompt ? O_PC : O_SC) + ((size_t)(b * NH + h) * DK) * DV + e;
#pragma unroll
    for (int d = 0; d < DK; ++d) oc[(size_t)d * DV] = C[d];
    if (e < DK) dout[(prompt ? O_PN : O_SN) + (size_t)(b * NH + h) * DK + e] = ns[e];
    if (e == 0) dout[(prompt ? O_PM : O_SM) + b * NH + h] = mm;
}

struct Args { const float* in[19]; float* out; unsigned char* ws; int ph_lo, ph_hi, li, pad; };
__global__ void __launch_bounds__(NWAVES * 64, 2) mk_fwd(Args args) {
    extern __shared__ __attribute__((aligned(16))) unsigned char lds[];
    Frame F;
    F.lds = (LAS unsigned char*)lds;
    F.MISC = (volatile LAS unsigned*)(F.lds + MISC_OFF);
    F.tid = threadIdx.x; F.lane = F.tid & 63; F.wave = __builtin_amdgcn_readfirstlane(F.tid >> 6);
    F.G = gridDim.x; { const int bx = blockIdx.x; F.vcu = (F.G % 8 == 0) ? (bx % 8) * (F.G / 8) + bx / 8 : bx; }
    unsigned char* ws = args.ws;
    F.ctl = (gu32*)(ws + WS_CTL);
    F.x_p = args.in[0]; F.x_s = args.in[1]; F.st_conv = args.in[2]; F.st_C = args.in[3]; F.st_n = args.in[4]; F.st_m = args.in[5];
    F.g1 = args.in[6]; F.w_in = args.in[7]; F.b_i = args.in[8]; F.b_f = args.in[9]; F.conv_w = args.in[10]; F.conv_g = args.in[11]; F.ml_g = args.in[12];
    F.w_out = args.in[13]; F.g2 = args.in[14]; F.wg = args.in[15]; F.wu = args.in[16]; F.wd = args.in[17]; F.fg = args.in[18]; F.out = args.out;
    F.W1 = (bf16*)(ws + WS_W1); F.W2 = (bf16*)(ws + WS_W2); F.W3 = (bf16*)(ws + WS_W3); F.W4 = (bf16*)(ws + WS_W4);
    F.XN = (bf16*)(ws + WS_A); F.YC = (bf16*)(ws + WS_A); F.Z = (bf16*)(ws + WS_B); F.HB = (bf16*)(ws + WS_B); F.X1b = (bf16*)(ws + WS_C);
    F.gates = (float*)(ws + WS_GATES); F.ssq1 = (float*)(ws + WS_CTL) + CW_SSQ1; F.ssq2 = (float*)(ws + WS_CTL) + CW_SSQ2;
    for (int u = F.tid; u < (LDS_BYTES - LDSCTL_OFF) / 4; u += NWAVES * 64) ((LAS unsigned*)(F.lds + LDSCTL_OFF))[u] = 0u;
    __syncthreads();
    XcdBarrier bar = xcd_barrier_post((unsigned*)(F.ctl + CW_BAR) + args.li * XCD_BAR_WORDS, F.MISC + 8);
    const int lo = args.ph_lo, hi = args.ph_hi;
#define IN(k) (lo <= (k) && (k) < hi)
#define SEAM(k) do { if (IN(k) && IN((k) + 1)) xcd_barrier(bar); } while (0)

    if (IN(0)) { p0_prologue(F); } SEAM(0);
    if (IN(1)) {
        pg8::Gemm g{F.XN, F.W1, M, NZ, D}; pg8::StaticOrder S; S.init(M, NZ, F.G, (int)blockIdx.x);
        pg8::EpiZ E{F.Z, NZ};
        pg8::gemm_phase<pg8::EpiZ, pg8::StaticOrder, PG8_ALIGN, PG8_SP2>(F.lds + RING_OFF, g, S, E);
    } SEAM(1);
    if (IN(4)) {
        pg8::Gemm g{F.YC, F.W2, M, D, D}; pg8::StaticOrder S; S.init(M, D, F.G, (int)blockIdx.x);
        pg8::EpiRes E{F.x_p, F.x_s, MP, F.out, F.X1b, F.ssq1};
        pg8::gemm_phase<pg8::EpiRes, pg8::StaticOrder, PG8_ALIGN, PG8_SP2>(F.lds + RING_OFF, g, S, E);
    } SEAM(4);
    if (IN(5)) {
        pg8::Gemm g{F.X1b, F.W3, M, N3, D}; pg8::StaticOrder S; S.init(M, N3, F.G, (int)blockIdx.x);
        pg8::EpiH E{F.HB, F.ssq1};
        pg8::gemm_phase<pg8::EpiH, pg8::StaticOrder, PG8_ALIGN, PG8_SP2>(F.lds + RING_OFF, g, S, E);
    } SEAM(5);
    if (IN(6)) {
        pg8::Gemm g{F.HB, F.W4, M, D, FF}; pg8::StaticOrder S; S.init(M, D, F.G, (int)blockIdx.x);
        pg8::EpiRes E{F.out, F.out, M, F.out, nullptr, F.ssq2};
        pg8::gemm_phase<pg8::EpiRes, pg8::StaticOrder, PG8_ALIGN, PG8_SP2>(F.lds + RING_OFF, g, S, E);
    } SEAM(6);
    if (IN(7)) { final_norm_phase(F); }
#undef IN
#undef SEAM
}

extern "C" void kernel_launch(void* const* d_in, const int* in_sizes, int n_in, void* d_out, int out_size, void* d_ws, size_t ws_size, hipStream_t stream) {
    static int grid = 0;
    if (grid == 0) {
        if (n_in != 19 || (size_t)out_size != O_END || ws_size < WS_END) { fprintf(stderr, "kernel_launch: unexpected shapes: n_in %d out %d ws %zu; nothing launched\n", n_in, out_size, ws_size); grid = -1; return; }
        int dev = 0, cus = 0;
        if (hipGetDevice(&dev) != hipSuccess || hipDeviceGetAttribute(&cus, hipDeviceAttributeMultiprocessorCount, dev) != hipSuccess) { grid = -1; return; }
        if (hipFuncSetAttribute((const void*)mk_fwd, hipFuncAttributeMaxDynamicSharedMemorySize, LDS_BYTES) != hipSuccess) { fprintf(stderr, "kernel_launch: hipFuncSetAttribute failed\n"); grid = -1; return; }
        grid = cus;
    }
    if (grid < 0) return;
    unsigned char* ws = (unsigned char*)d_ws; float* out = (float*)d_out;
    (void)hipMemsetAsync(ws + WS_CTL, 0, CTL_ZERO_BYTES, stream);
    Args a{};
    for (int i = 0; i < 19; ++i) a.in[i] = (const float*)d_in[i];
    a.out = out; a.ws = ws;
    a.ph_lo = 0; a.ph_hi = 2; a.li = 0;
    hipLaunchKernelGGL(mk_fwd, dim3(grid), dim3(NWAVES * 64), LDS_BYTES, stream, a);
    k_conv<<<M, 256, 0, stream>>>((const bf16_t*)(ws + WS_B), (const float*)d_in[2], (const float*)d_in[10], (const float*)d_in[11], (bf16_t*)(ws + WS_A), out);
    k_mlstm_naive<<<(NB + DB) * NH, 256, 0, stream>>>((const bf16_t*)(ws + WS_B), (const float*)(ws + WS_GATES), (const float*)d_in[3], (const float*)d_in[4], (const float*)d_in[5], (const float*)d_in[12], (bf16_t*)(ws + WS_A), out);
    a.ph_lo = 4; a.ph_hi = 8; a.li = 1;
    hipLaunchKernelGGL(mk_fwd, dim3(grid), dim3(NWAVES * 64), LDS_BYTES, stream, a);
}
```

```cpp
#include <hip/hip_runtime.h>
#include <cstdio>
#include <cstdint>

constexpr int D = 2048, SEQ = 2048, NB = 4, DB = 128, DS = 8;
constexpr int MP = NB * SEQ, MS = DB * DS, M = MP + MS;
constexpr int DC = 1024, NH = 4, DK = 128, DV = 256;
constexpr int NZ = 6144, NIN = 6152, FF = 5632, N3 = 2 * FF;
constexpr float EPS = 1e-6f;
constexpr float QSCALE = 0.08838834764831845f;
constexpr int ZC_BG = 0, ZC_CG = 1024, ZC_XT = 2048, ZC_Q = 3072, ZC_K = 3584, ZC_V = 4096, ZC_O = 5120;
constexpr size_t O_Y = 0, O_PCONV = 18874368, O_PC = 18882560, O_PN = 19406848, O_PM = 19408896,
                 O_SCONV = 19408912, O_SC = 19671056, O_SN = 36448272, O_SM = 36513808, O_END = 36514320;
constexpr size_t MiB = 1u << 20;
constexpr size_t WS_CTL = 0, CTL_ZERO_BYTES = 1 * MiB;
constexpr size_t WS_W1 = 1 * MiB, WS_W2 = 25 * MiB, WS_W3 = 33 * MiB, WS_W4 = 77 * MiB;
constexpr size_t WS_A = 99 * MiB;
constexpr size_t WS_B = 135 * MiB;
constexpr size_t WS_C = 243 * MiB;
constexpr size_t WS_GATES = WS_C + 36 * MiB;
constexpr size_t WS_END = 283 * MiB;
constexpr int CW_TMO = 0, CW_CODE = 1;
constexpr int CW_BAR = 4096;
constexpr int CW_SSQ1 = 65536, CW_SSQ2 = 65536 + 16384;
constexpr int NWAVES = 8;
constexpr int RING_OFF = 0, RING_BYTES = 131072;
constexpr int LDSCTL_OFF = RING_BYTES, MISC_OFF = LDSCTL_OFF + 320;
constexpr int LDS_BYTES = 147456;

namespace pg8 {
#define PG8_LAS __attribute__((address_space(3)))
typedef unsigned short bf16_t;
typedef short bf16x8 __attribute__((ext_vector_type(8)));
typedef float f32x4 __attribute__((ext_vector_type(4)));
typedef unsigned u32x4 __attribute__((ext_vector_type(4)));
constexpr int BM = 256, BK = 64, HALF = 128, HTB = HALF * BK * 2  , STAGE_BYTES = 8 * HTB, NXCD = 8, WGM = 8;

__host__ __device__ __forceinline__ int lds_byte(int r, int c) { const int st = (r >> 4) * 2 + (c >> 5), rr = r & 15, cc = c & 31, ob = rr * 64 + cc * 2; return st * 1024 + (ob ^ (((ob >> 9) & 1) << 5)); }
__host__ __device__ __forceinline__ void stage_rc(int b, int& R, int& C) { const int st = b / 1024, sb = b % 1024, swz = sb ^ (((sb >> 9) & 1) << 5); R = (st >> 1) * 16 + swz / 64; C = (st & 1) * 32 + (swz % 64) / 2; }
__host__ __device__ __forceinline__ int perm32(int rho) { const int n = rho >> 4, i = rho & 15; return 8 * (i >> 2) + 4 * n + (i & 3); }

struct Unit { int pm, pn; };
struct Gemm { const bf16_t* A; const bf16_t* Bt; int M, N, K; };

struct StaticOrder {
    int nM, nN, nwg, G, c;
    __host__ __device__ void init(int M, int N, int G_, int c_) { nM = M / BM; nN = N / BM; nwg = nM * nN; G = G_; c = c_; }
    __host__ __device__ bool next(int i, Unit& u) const {
        const long L = (long)i * G + c; if (L >= nwg) return false;
        int wgid = (int)L; { const int q = nwg / NXCD, r = nwg % NXCD, xcd = wgid % NXCD, off = wgid / NXCD; wgid = (xcd < r ? xcd * (q + 1) : r * (q + 1) + (xcd - r) * q) + off; }
        const int nig = WGM * nN, gid = wgid / nig, fm = gid * WGM, gsz = (nM - fm) < WGM ? (nM - fm) : WGM;
        u.pm = fm + ((wgid % nig) % gsz); u.pn = (wgid % nig) / gsz; return true;
    }
    __device__ __forceinline__ void a_ready(const Unit&) const {}
    __device__ __forceinline__ void done(const Unit&) const {}
};
__device__ __forceinline__ unsigned cvt_pk_bf16(float lo, float hi) { unsigned r; asm volatile("v_cvt_pk_bf16_f32 %0, %1, %2" : "=v"(r) : "v"(lo), "v"(hi)); return r; }
typedef float f32x2 __attribute__((ext_vector_type(2)));
struct EpiZ {
    static constexpr bool PERM = true, AFTER_DRAIN = false;
    bf16_t* O; int ldc;
    __device__ __forceinline__ void operator()(const f32x4 (&acc)[2][2][4][2], const Unit& u, int wr, int wc, int fr, int fq) const {
        const int row0 = u.pm * BM + wr * 64 + fr, col0 = u.pn * BM + wc * 32 + 8 * fq;
#pragma unroll
        for (int ai = 0; ai < 2; ++ai)
#pragma unroll
            for (int m = 0; m < 4; ++m) { bf16_t* rowp = O + (size_t)(row0 + ai * HALF + m * 16) * ldc + col0;
#pragma unroll
                for (int bj = 0; bj < 2; ++bj) { const f32x4 v0 = acc[ai][bj][m][0], v1 = acc[ai][bj][m][1];
                    u32x4 w; w.x = cvt_pk_bf16(v0[0], v0[1]); w.y = cvt_pk_bf16(v0[2], v0[3]); w.z = cvt_pk_bf16(v1[0], v1[1]); w.w = cvt_pk_bf16(v1[2], v1[3]);
                    *(u32x4*)(rowp + bj * HALF) = w; } }
    }
};
struct EpiRes {
    static constexpr bool PERM = true, AFTER_DRAIN = false;
    const float* xp; const float* xs; int rows_p; float* out; bf16_t* X1b; float* ssq;
    __device__ __forceinline__ void operator()(const f32x4 (&acc)[2][2][4][2], const Unit& u, int wr, int wc, int fr, int fq) const {
        const int row0 = u.pm * BM + wr * 64 + fr, col0 = u.pn * BM + wc * 32 + 8 * fq;
#pragma unroll
        for (int ai = 0; ai < 2; ++ai)
#pragma unroll
            for (int m = 0; m < 4; ++m) {
                const int row = row0 + ai * HALF + m * 16;
                const float* xr = (row < rows_p ? xp + (size_t)row * 2048 : xs + (size_t)(row - rows_p) * 2048) + col0;
                float* orow = out + (size_t)row * 2048 + col0; float s = 0.f;
#pragma unroll
                for (int bj = 0; bj < 2; ++bj) {
                    const f32x4 v0 = acc[ai][bj][m][0] + *(const f32x4*)(xr + bj * HALF), v1 = acc[ai][bj][m][1] + *(const f32x4*)(xr + bj * HALF + 4);
                    *(f32x4*)(orow + bj * HALF) = v0; *(f32x4*)(orow + bj * HALF + 4) = v1;
                    s += (v0[0] * v0[0] + v0[1] * v0[1]) + (v0[2] * v0[2] + v0[3] * v0[3]) + (v1[0] * v1[0] + v1[1] * v1[1]) + (v1[2] * v1[2] + v1[3] * v1[3]);
                    if (X1b) { u32x4 w; w.x = cvt_pk_bf16(v0[0], v0[1]); w.y = cvt_pk_bf16(v0[2], v0[3]); w.z = cvt_pk_bf16(v1[0], v1[1]); w.w = cvt_pk_bf16(v1[2], v1[3]);
                        *(u32x4*)(X1b + (size_t)row * 2048 + col0 + bj * HALF) = w; }
                }
                s += __shfl_xor(s, 16); s += __shfl_xor(s, 32);
                if (fq == 0) atomicAdd(ssq + row, s);
                asm volatile("" ::: "memory");
            }
    }
};
struct EpiH {
    static constexpr bool PERM = true, AFTER_DRAIN = false;
    bf16_t* H; const float* ssq;
    __device__ __forceinline__ void operator()(const f32x4 (&acc)[2][2][4][2], const Unit& u, int wr, int wc, int fr, int fq) const {
        const int row0 = u.pm * BM + wr * 64 + fr, col0 = u.pn * HALF + wc * 32 + 8 * fq;
#pragma unroll
        for (int ai = 0; ai < 2; ++ai)
#pragma unroll
            for (int m = 0; m < 4; ++m) {
                const int row = row0 + ai * HALF + m * 16;
                const float r = rsqrtf(ssq[row] * (1.0f / 2048.0f) + 1e-6f);
                float h[8];
#pragma unroll
                for (int n = 0; n < 2; ++n)
#pragma unroll
                    for (int j = 0; j < 4; ++j) { const float g = acc[ai][0][m][n][j] * r, up = acc[ai][1][m][n][j] * r;
                        h[4 * n + j] = g * __builtin_amdgcn_rcpf(1.0f + __expf(-g)) * up; }
                u32x4 w; w.x = cvt_pk_bf16(h[0], h[1]); w.y = cvt_pk_bf16(h[2], h[3]); w.z = cvt_pk_bf16(h[4], h[5]); w.w = cvt_pk_bf16(h[6], h[7]);
                *(u32x4*)(H + (size_t)row * 5632 + col0) = w;
            }
    }
};
template <class Epi, class Sched, bool ALIGN_EPI = false, bool SP2 = false>
__device__ __forceinline__ void gemm_phase(PG8_LAS unsigned char* lds, const Gemm g, const Sched& S, const Epi& E) {
    const int tid = threadIdx.x, wid = __builtin_amdgcn_readfirstlane(tid >> 6), lane = tid & 63, wr = wid >> 2, wc = wid & 3, fr = lane & 15, fq = lane >> 4;
    const int K = g.K, nt = K / BK;
    unsigned voffA[2], voffB[2];
#pragma unroll
    for (int i = 0; i < 2; ++i) { int R, C; stage_rc(tid * 16 + i * 8192, R, C); const int Rb = Epi::PERM ? ((R & ~31) + perm32(R & 31)) : R;
        voffA[i] = (unsigned)(R * K + C) * 2u; voffB[i] = (unsigned)(Rb * K + C) * 2u; }
    const size_t kstep = (size_t)(BK * 2);
    const size_t hstep = (size_t)HALF * K * 2;
    const size_t tstep = 2 * hstep;
    const unsigned ldsw = (unsigned)wid * 1024u;
    const int aoff = lds_byte(wr * 64 + fr, fq * 8), boff = lds_byte(wc * 32 + fr, fq * 8);
#define PG8_SA(b, h) (((b) * 2 + (h)) * HTB)
#define PG8_SB(b, h) ((4 + (b) * 2 + (h)) * HTB)
#define PG8_STAGE(bufoff, gbase, voff) do { _Pragma("unroll") for (int _i = 0; _i < 2; ++_i) \
        __builtin_amdgcn_global_load_lds((const unsigned*)((const char*)(gbase) + (voff)[_i]), (PG8_LAS unsigned*)(lds + (bufoff) + ldsw + _i * 8192), 16, 0, 0); } while (0)
#define PG8_LDA(dst, b, h) do { _Pragma("unroll") for (int m = 0; m < 4; ++m) _Pragma("unroll") for (int k = 0; k < 2; ++k) dst[m][k] = *(const PG8_LAS bf16x8*)(lds + PG8_SA(b, h) + aoff + m * 2048 + k * 1024); } while (0)
#define PG8_LDB(dst, b, h) do { _Pragma("unroll") for (int n = 0; n < 2; ++n) _Pragma("unroll") for (int k = 0; k < 2; ++k) dst[n][k] = *(const PG8_LAS bf16x8*)(lds + PG8_SB(b, h) + boff + n * 2048 + k * 1024); } while (0)
#define PG8_MMA(ai, bj, At, Bt) do { __builtin_amdgcn_s_setprio(1); _Pragma("unroll") for (int m = 0; m < 4; ++m) _Pragma("unroll") for (int n = 0; n < 2; ++n) _Pragma("unroll") for (int k = 0; k < 2; ++k) \
        acc[ai][bj][m][n] = __builtin_amdgcn_mfma_f32_16x16x32_bf16(Bt[n][k], At[m][k], acc[ai][bj][m][n], 0, 0, 0); __builtin_amdgcn_s_setprio(0); } while (0)
#define PG8_WAIT_V(n) asm volatile("s_waitcnt vmcnt(" #n ")" ::: "memory")
#define PG8_WAIT_L(n) asm volatile("s_waitcnt lgkmcnt(" #n ")" ::: "memory")
#define PG8_BAR __builtin_amdgcn_s_barrier()
#define PG8_SCHED __builtin_amdgcn_sched_barrier(0)
    Unit cur, nxt; int ui = 0;
    if (!S.next(0, cur)) return;
    f32x4 acc[2][2][4][2];
#pragma unroll
    for (int a = 0; a < 2; ++a)
#pragma unroll
        for (int b = 0; b < 2; ++b)
#pragma unroll
            for (int m = 0; m < 4; ++m)
#pragma unroll
                for (int n = 0; n < 2; ++n) acc[a][b][m][n] = (f32x4){0.f, 0.f, 0.f, 0.f};
    bf16x8 At[4][2], B0[2][2], B1[2][2];
    const char* cA = (const char*)g.A + (size_t)cur.pm * tstep; const char* cB = (const char*)g.Bt + (size_t)cur.pn * tstep;
    S.a_ready(cur);
    if constexpr (SP2) {
        PG8_STAGE(PG8_SB(0, 0), cB, voffB); PG8_STAGE(PG8_SB(0, 1), cB + hstep, voffB); PG8_STAGE(PG8_SA(0, 0), cA, voffA); PG8_STAGE(PG8_SA(0, 1), cA + hstep, voffA);
        if (wr == 1) PG8_BAR;
        PG8_WAIT_V(2); PG8_BAR;
        PG8_STAGE(PG8_SB(1, 0), cB + kstep, voffB); PG8_STAGE(PG8_SA(1, 0), cA + kstep, voffA); PG8_STAGE(PG8_SB(1, 1), cB + hstep + kstep, voffB);
        PG8_WAIT_V(6); PG8_BAR;
    } else {
        PG8_STAGE(PG8_SB(0, 0), cB, voffB); PG8_STAGE(PG8_SA(0, 0), cA, voffA); PG8_STAGE(PG8_SB(0, 1), cB + hstep, voffB); PG8_STAGE(PG8_SA(0, 1), cA + hstep, voffA);
        if (wr == 1) PG8_BAR;
        PG8_WAIT_V(4); PG8_BAR;
        PG8_STAGE(PG8_SB(1, 0), cB + kstep, voffB); PG8_STAGE(PG8_SA(1, 0), cA + kstep, voffA); PG8_STAGE(PG8_SB(1, 1), cB + hstep + kstep, voffB);
        PG8_WAIT_V(6); PG8_BAR;
    }
    for (;;) {
        const bool has_next = S.next(ui + 1, nxt);
        const char* nA = has_next ? (const char*)g.A + (size_t)nxt.pm * tstep : cA; const char* nB = has_next ? (const char*)g.Bt + (size_t)nxt.pn * tstep : cB;
        for (int t = 0; t < nt; t += 2) {
            const bool last = (t == nt - 2);
            const char* a1 = cA + (size_t)(t + 1) * kstep;
            const char* a2 = last ? nA : cA + (size_t)(t + 2) * kstep; const char* b2 = last ? nB : cB + (size_t)(t + 2) * kstep;
            const char* a3 = a2 + kstep; const char* b3 = b2 + kstep;
            if (last && has_next) S.a_ready(nxt);
            if constexpr (SP2) {
            PG8_LDB(B0, 0, 0); PG8_LDB(B1, 0, 1); PG8_SCHED; PG8_LDA(At, 0, 0); PG8_STAGE(PG8_SA(1, 1), a1 + hstep, voffA);
            PG8_WAIT_V(8); PG8_WAIT_L(0); PG8_BAR; PG8_MMA(0, 0, At, B0); PG8_MMA(0, 1, At, B1); PG8_BAR; PG8_SCHED;
            PG8_LDA(At, 0, 1); PG8_STAGE(PG8_SB(0, 0), b2, voffB); PG8_STAGE(PG8_SB(0, 1), b2 + hstep, voffB); PG8_STAGE(PG8_SA(0, 0), a2, voffA);
            PG8_WAIT_V(8); PG8_WAIT_L(0); PG8_BAR; PG8_MMA(1, 0, At, B0); PG8_MMA(1, 1, At, B1); PG8_BAR; PG8_SCHED;
            PG8_LDB(B0, 1, 0); PG8_LDB(B1, 1, 1); PG8_SCHED; PG8_LDA(At, 1, 0); PG8_STAGE(PG8_SA(0, 1), a2 + hstep, voffA);
            PG8_WAIT_V(8); PG8_WAIT_L(0); PG8_BAR; PG8_MMA(0, 0, At, B0); PG8_MMA(0, 1, At, B1); PG8_BAR; PG8_SCHED;
            PG8_LDA(At, 1, 1); PG8_STAGE(PG8_SB(1, 0), b3, voffB); PG8_STAGE(PG8_SB(1, 1), b3 + hstep, voffB); PG8_STAGE(PG8_SA(1, 0), a3, voffA);
            PG8_WAIT_V(8); PG8_WAIT_L(0); PG8_BAR; PG8_MMA(1, 0, At, B0); PG8_MMA(1, 1, At, B1); PG8_BAR; PG8_SCHED;
            } else {
            PG8_LDB(B0, 0, 0); PG8_SCHED; PG8_LDA(At, 0, 0); PG8_STAGE(PG8_SA(1, 1), a1 + hstep, voffA);
            PG8_WAIT_L(8); PG8_BAR; PG8_WAIT_L(0); PG8_MMA(0, 0, At, B0); PG8_BAR; PG8_SCHED;
            PG8_LDB(B1, 0, 1); PG8_STAGE(PG8_SB(0, 0), b2, voffB);
            PG8_BAR; PG8_WAIT_L(0); PG8_MMA(0, 1, At, B1); PG8_BAR;
            PG8_LDA(At, 0, 1); PG8_STAGE(PG8_SA(0, 0), a2, voffA);
            PG8_BAR; PG8_WAIT_L(0); PG8_MMA(1, 0, At, B0); PG8_BAR; PG8_SCHED;
            PG8_STAGE(PG8_SB(0, 1), b2 + hstep, voffB);
            PG8_WAIT_V(6); PG8_BAR; PG8_MMA(1, 1, At, B1); PG8_BAR;
            PG8_LDB(B0, 1, 0); PG8_SCHED; PG8_LDA(At, 1, 0); PG8_STAGE(PG8_SA(0, 1), a2 + hstep, voffA);
            PG8_WAIT_L(8); PG8_BAR; PG8_WAIT_L(0); PG8_MMA(0, 0, At, B0); PG8_BAR; PG8_SCHED;
            PG8_LDB(B1, 1, 1); PG8_STAGE(PG8_SB(1, 0), b3, voffB);
            PG8_BAR; PG8_WAIT_L(0); PG8_MMA(0, 1, At, B1); PG8_BAR;
            PG8_LDA(At, 1, 1); PG8_STAGE(PG8_SA(1, 0), a3, voffA);
            PG8_BAR; PG8_WAIT_L(0); PG8_MMA(1, 0, At, B0); PG8_BAR; PG8_SCHED;
            PG8_STAGE(PG8_SB(1, 1), b3 + hstep, voffB);
            PG8_WAIT_V(6); PG8_BAR; PG8_MMA(1, 1, At, B1); PG8_BAR;
            }
        }
        if constexpr (ALIGN_EPI) { if (wr == 0) PG8_BAR; }
        if constexpr (!Epi::AFTER_DRAIN) { E(acc, cur, wr, wc, fr, fq); S.done(cur); }
        if (!has_next) break;
#pragma unroll
        for (int a = 0; a < 2; ++a)
#pragma unroll
            for (int b = 0; b < 2; ++b)
#pragma unroll
                for (int m = 0; m < 4; ++m)
#pragma unroll
                    for (int n = 0; n < 2; ++n) acc[a][b][m][n] = (f32x4){0.f, 0.f, 0.f, 0.f};
        cur = nxt; cA = nA; cB = nB; ++ui;
        if constexpr (ALIGN_EPI) { if (wr == 1) PG8_BAR; }
    }
    PG8_WAIT_V(0);
    if constexpr (!ALIGN_EPI) { if (wr == 0) PG8_BAR; }
    PG8_BAR;
    if constexpr (Epi::AFTER_DRAIN) { E.fused(acc, cur, wr, wc, fr, fq, lds, wid, lane); S.done(cur); }
#undef PG8_SA
#undef PG8_SB
#undef PG8_STAGE
#undef PG8_LDA
#undef PG8_LDB
#undef PG8_MMA
#undef PG8_WAIT_V
#undef PG8_WAIT_L
#undef PG8_BAR
#undef PG8_SCHED
}
}
#ifndef PG8_SP2
#define PG8_SP2 true
#endif
#ifndef PG8_ALIGN
#define PG8_ALIGN true
#endif
#define GAS __attribute__((address_space(1)))
#define LAS __attribute__((address_space(3)))
typedef unsigned short bf16;
typedef unsigned v4u __attribute__((ext_vector_type(4)));
typedef float f32x4 __attribute__((ext_vector_type(4)));
typedef short bf16x8 __attribute__((ext_vector_type(8)));
typedef GAS unsigned gu32;
typedef GAS unsigned long long gu64;
#define RLX_AGENT __ATOMIC_RELAXED, __HIP_MEMORY_SCOPE_AGENT
#define LDS_WAIT() asm volatile("s_waitcnt lgkmcnt(0)" ::: "memory")
#define VM_WAIT() asm volatile("s_waitcnt vmcnt(0)" ::: "memory")
__device__ __forceinline__ unsigned f2bf(float f) { unsigned u = __builtin_bit_cast(unsigned, f); return (u + 0x7fffu + ((u >> 16) & 1u)) >> 16; }
__device__ __forceinline__ unsigned pk2(float lo, float hi) { return f2bf(lo) | (f2bf(hi) << 16); }
__device__ __forceinline__ float bf2f(unsigned b) { return __builtin_bit_cast(float, b << 16); }
__device__ __forceinline__ float wave_sum(float v) {
#pragma unroll
    for (int o = 1; o < 64; o <<= 1) v += __shfl_xor(v, o);
    return v;
}
__device__ __forceinline__ float sigmoidf_(float x) { return 1.f / (1.f + __expf(-x)); }
__device__ __forceinline__ float log_sigmoid(float x) { return fminf(x, 0.f) - log1pf(__expf(-fabsf(x))); }

#define XB_TMO      128
#define XB_XCNT(j)  (256  + 64 * (j))
#define XB_XSUB(j)  (1280 + 64 * (j))
#define XB_XGEN(j)  (2304 + 64 * (j))
#define XB_TOP      3328
#define XB_TOPGEN   3392
#define XCD_BAR_WORDS 3456
#define XB_SPIN_CAP (1u << 18)

__device__ __forceinline__ unsigned xb_ld(unsigned* p)              { return __hip_atomic_load(p, __ATOMIC_RELAXED, __HIP_MEMORY_SCOPE_AGENT); }
__device__ __forceinline__ unsigned xb_add(unsigned* p, unsigned v) { return __hip_atomic_fetch_add(p, v, __ATOMIC_RELAXED, __HIP_MEMORY_SCOPE_AGENT); }
__device__ __forceinline__ unsigned xb_xcc_id() { return (unsigned)__builtin_amdgcn_s_getreg((3 << 11) | 20) & 0xFu; }
#define XB_SPIN(cond, bar) do { unsigned _sp = 0; while (cond) { __builtin_amdgcn_s_sleep(1); \
    if ((++_sp & 255u) == 0u) { if (xb_ld(&(bar)[XB_TMO])) break; if (_sp > XB_SPIN_CAP) { atomicAdd(&(bar)[XB_TMO], 1u); break; } } } } while (0)

struct XcdBarrier {
    unsigned* bar; unsigned x;
    volatile LAS unsigned* st;
};

__device__ __forceinline__ XcdBarrier xcd_barrier_post(unsigned* bar, volatile LAS unsigned* st) {
    XcdBarrier b; b.bar = bar; b.x = xb_xcc_id(); b.st = st;
    if (threadIdx.x == 0) (void)xb_add(&bar[XB_XCNT(b.x)], 1u);
    return b;
}
__device__ __forceinline__ void xcd_barrier_complete(unsigned* bar, unsigned x, unsigned& nloc, unsigned& nx) {
    const unsigned G = gridDim.x * gridDim.y * gridDim.z;
    unsigned sum, cnt, mine, sp = 0u;
    for (;;) {
        sum = 0u; cnt = 0u; mine = 0u;
#pragma unroll
        for (unsigned j = 0; j < 16; ++j) { const unsigned c = xb_ld(&bar[XB_XCNT(j)]); sum += c; cnt += (c > 0u) ? 1u : 0u; mine = (j == x) ? c : mine; }
        if (sum == G) break;
        __builtin_amdgcn_s_sleep(1);
        if ((++sp & 255u) == 0u) { if (xb_ld(&bar[XB_TMO])) break; if (sp > XB_SPIN_CAP) { atomicAdd(&bar[XB_TMO], 1u); break; } }
    }
    nloc = mine > 0u ? mine : 1u; nx = cnt > 0u ? cnt : 1u;
}

__device__ __forceinline__ void xcd_barrier(const XcdBarrier& b) {
    asm volatile("s_waitcnt vmcnt(0)" ::: "memory");
    __syncthreads();
    if (threadIdx.x == 0) {
        unsigned* bar = b.bar;
        __builtin_amdgcn_s_waitcnt(0);
        unsigned nloc = b.st[0], nx = b.st[1];
        if (nloc == 0u) { xcd_barrier_complete(bar, b.x, nloc, nx); b.st[0] = nloc; b.st[1] = nx; }
        const unsigned old = xb_add(&bar[XB_XSUB(b.x)], 1u);
        const unsigned gen = old / nloc;
        if (old + 1u == (gen + 1u) * nloc) {
            __builtin_amdgcn_fence(__ATOMIC_RELEASE, "agent");
            asm volatile("s_waitcnt vmcnt(0)" ::: "memory");
            const unsigned og = xb_add(&bar[XB_TOP], 1u);
            const unsigned tg = og / nx;
            if (og + 1u == (tg + 1u) * nx) xb_add(&bar[XB_TOPGEN], 1u);
            else XB_SPIN(xb_ld(&bar[XB_TOPGEN]) == tg, bar);
            __builtin_amdgcn_fence(__ATOMIC_ACQUIRE, "agent");
            xb_add(&bar[XB_XGEN(b.x)], 1u);
            asm volatile("s_waitcnt vmcnt(0)" ::: "memory");
        } else {
            XB_SPIN(xb_ld(&bar[XB_XGEN(b.x)]) == gen, bar);
            __builtin_amdgcn_fence(__ATOMIC_ACQUIRE, "agent");
            asm volatile("s_waitcnt vmcnt(0)" ::: "memory");
        }
    }
    __syncthreads();
}
struct Frame {
    LAS unsigned char* lds;
    volatile LAS unsigned* MISC;
    gu32* ctl;
    int tid, lane, wave;
    int vcu, G;
    const float *x_p, *x_s, *st_conv, *st_C, *st_n, *st_m, *g1, *w_in, *b_i, *b_f, *conv_w, *conv_g, *ml_g, *w_out, *g2, *wg, *wu, *wd, *fg;
    float* out;
    bf16 *W1, *W2, *W3, *W4, *XN, *YC, *Z, *HB, *X1b;
    float *gates, *ssq1, *ssq2;
};

__device__ __forceinline__ void p0_transpose_item(const float* W, int ldw, int K, int nblk, bf16* WT, int mode, const float* kgain, LAS float* scr, int item, int lane) {
    const int kb = item / nblk, nb = item % nblk, k0 = 64 * kb, n0 = 32 * nb;
#pragma unroll 8
    for (int i = 0; i < 32; ++i) { const int kk = 2 * i + (lane >> 5); const float g = kgain ? kgain[k0 + kk] : 1.f; scr[kk * 33 + (lane & 31)] = W[(size_t)(k0 + kk) * ldw + n0 + (lane & 31)] * g; }
    LDS_WAIT(); asm volatile("" ::: "memory");
    const int c = lane & 7;
#pragma unroll
    for (int j = 0; j < 4; ++j) { const int n = (lane >> 3) + 8 * j; const LAS float* s = scr + (8 * c) * 33 + n;
        v4u o; o.x = pk2(s[0 * 33], s[1 * 33]); o.y = pk2(s[2 * 33], s[3 * 33]); o.z = pk2(s[4 * 33], s[5 * 33]); o.w = pk2(s[6 * 33], s[7 * 33]);
        const int jn = n0 + n; int drow = jn; if (mode == 1) drow = 256 * (jn >> 7) + (jn & 127); if (mode == 2) drow = 256 * (jn >> 7) + 128 + (jn & 127);
        *(GAS v4u*)(WT + (size_t)drow * K + k0 + 8 * c) = o; }
    LDS_WAIT(); asm volatile("" ::: "memory");
}
__device__ __forceinline__ void p0_xrow(Frame& F, int m, const LAS float* gwl) {
    const float* xr = m < MP ? F.x_p + (size_t)m * D : F.x_s + (size_t)(m - MP) * D;
    const int lane = F.lane;
    f32x4 v[8]; float s = 0.f;
#pragma unroll
    for (int j = 0; j < 8; ++j) { v[j] = *(const GAS f32x4*)(xr + 256 * j + 4 * lane); s += (v[j].x * v[j].x + v[j].y * v[j].y) + (v[j].z * v[j].z + v[j].w * v[j].w); }
    const float r = rsqrtf(wave_sum(s) * (1.f / D) + EPS);
    float ga[8] = {0.f, 0.f, 0.f, 0.f, 0.f, 0.f, 0.f, 0.f};
#pragma unroll
    for (int j = 0; j < 8; ++j) {
        const int k = 256 * j + 4 * lane;
        const f32x4 gg = *(const GAS f32x4*)(F.g1 + k);
        const f32x4 xn = v[j] * r * gg;
        *(GAS unsigned long long*)(F.XN + (size_t)m * D + k) = (unsigned long long)pk2(xn.x, xn.y) | ((unsigned long long)pk2(xn.z, xn.w) << 32);
#pragma unroll
        for (int q = 0; q < 8; ++q) { const f32x4 w = *(const LAS f32x4*)(gwl + q * D + k); ga[q] += (xn.x * w.x + xn.y * w.y) + (xn.z * w.z + xn.w * w.w); }
    }
#pragma unroll
    for (int q = 0; q < 8; ++q) ga[q] = wave_sum(ga[q]);
    if (lane == 0) {
#pragma unroll
        for (int h = 0; h < 4; ++h) { F.gates[(size_t)m * 8 + h] = ga[h] + F.b_i[h]; F.gates[(size_t)m * 8 + 4 + h] = log_sigmoid(ga[4 + h] + F.b_f[h]); }
    }
}
__device__ __forceinline__ void p0_prologue(Frame& F) {
    LAS float* scr = (LAS float*)(F.lds + RING_OFF + F.wave * 16384);
    const int gw = F.vcu * NWAVES + F.wave, NGW = F.G * NWAVES;
    constexpr int I_1 = (D / 64) * (NZ / 32), I_2 = (D / 64) * (D / 32), I_3 = (D / 64) * (FF / 32), I_4 = (FF / 64) * (D / 32);
    constexpr int NITEMS = I_1 + I_2 + 2 * I_3 + I_4;
    for (int it = gw; it < NITEMS; it += NGW) {
        int r = it;
        if (r < I_1) { p0_transpose_item(F.w_in, NIN, D, NZ / 32, F.W1, 0, nullptr, scr, r, F.lane); continue; } r -= I_1;
        if (r < I_2) { p0_transpose_item(F.w_out, D, D, D / 32, F.W2, 0, nullptr, scr, r, F.lane); continue; } r -= I_2;
        if (r < I_3) { p0_transpose_item(F.wg, FF, D, FF / 32, F.W3, 1, F.g2, scr, r, F.lane); continue; } r -= I_3;
        if (r < I_3) { p0_transpose_item(F.wu, FF, D, FF / 32, F.W3, 2, F.g2, scr, r, F.lane); continue; } r -= I_3;
        p0_transpose_item(F.wd, D, FF, D / 32, F.W4, 0, nullptr, scr, r, F.lane);
    }
    __syncthreads();
    LAS float* gwl = (LAS float*)(F.lds + RING_OFF);
    for (int k = F.tid; k < D; k += NWAVES * 64) {
        const f32x4 a = *(const GAS f32x4*)(F.w_in + (size_t)k * NIN + NZ), b = *(const GAS f32x4*)(F.w_in + (size_t)k * NIN + NZ + 4);
        gwl[0 * D + k] = a.x; gwl[1 * D + k] = a.y; gwl[2 * D + k] = a.z; gwl[3 * D + k] = a.w; gwl[4 * D + k] = b.x; gwl[5 * D + k] = b.y; gwl[6 * D + k] = b.z; gwl[7 * D + k] = b.w;
    }
    __syncthreads();
    for (int m = gw; m < M; m += NGW) { asm volatile("" ::: "memory"); p0_xrow(F, m, gwl); }
    __syncthreads();
}
__device__ __forceinline__ void final_norm_phase(Frame& F) {
    const int gw = F.vcu * NWAVES + F.wave, NGW = F.G * NWAVES;
    for (int m = gw; m < M; m += NGW) {
        const float r = rsqrtf(F.ssq2[m] * (1.f / D) + EPS);
#pragma unroll
        for (int j = 0; j < 8; ++j) { GAS f32x4* p = (GAS f32x4*)(F.out + (size_t)m * D + 256 * j + 4 * F.lane); const f32x4 g = *(const GAS f32x4*)(F.fg + 256 * j + 4 * F.lane); *p = *p * r * g; }
    }
}
__device__ __forceinline__ void unpack8(const v4u w, float (&f)[8]) {
    f[0] = bf2f(w.x & 0xffffu); f[1] = bf2f(w.x >> 16); f[2] = bf2f(w.y & 0xffffu); f[3] = bf2f(w.y >> 16);
    f[4] = bf2f(w.z & 0xffffu); f[5] = bf2f(w.z >> 16); f[6] = bf2f(w.w & 0xffffu); f[7] = bf2f(w.w >> 16);
}
__device__ __forceinline__ void conv_item(Frame& F, int item) {
    const bool prompt = item < 1024;
    const int b = prompt ? (item >> 8) : (item - 1024);
    const int row0 = prompt ? 8 * item : MP + 8 * (item - 1024);
    const int t0 = prompt ? 8 * (item & 255) : 0;
    const bool last_item = prompt ? ((item & 255) == 255) : true;
    const int lane = F.lane;
    float w0[16], w1[16], w2[16], cg_[16], up2[16], up1[16];
#pragma unroll
    for (int p = 0; p < 2; ++p) {
        const int c0 = 8 * lane + 512 * p;
#pragma unroll
        for (int q = 0; q < 2; ++q) {
            const f32x4 a = *(const GAS f32x4*)(F.conv_w + c0 + 4 * q), bb = *(const GAS f32x4*)(F.conv_w + DC + c0 + 4 * q), c = *(const GAS f32x4*)(F.conv_w + 2 * DC + c0 + 4 * q), g = *(const GAS f32x4*)(F.conv_g + c0 + 4 * q);
#pragma unroll
            for (int i = 0; i < 4; ++i) { w0[8 * p + 4 * q + i] = a[i]; w1[8 * p + 4 * q + i] = bb[i]; w2[8 * p + 4 * q + i] = c[i]; cg_[8 * p + 4 * q + i] = g[i]; }
        }
    }
    if (prompt) {
        if (t0 == 0) {
#pragma unroll
            for (int i = 0; i < 16; ++i) { up2[i] = 0.f; up1[i] = 0.f; }
        } else {
#pragma unroll
            for (int p = 0; p < 2; ++p) {
                const int c0 = 8 * lane + 512 * p; float a[8], x[8];
                const bf16* z2 = F.Z + (size_t)(row0 - 2) * NZ; const bf16* z1 = F.Z + (size_t)(row0 - 1) * NZ;
                unpack8(*(const GAS v4u*)(z2 + ZC_CG + c0), a); unpack8(*(const GAS v4u*)(z2 + ZC_XT + c0), x);
#pragma unroll
                for (int i = 0; i < 8; ++i) up2[8 * p + i] = a[i] * x[i];
                unpack8(*(const GAS v4u*)(z1 + ZC_CG + c0), a); unpack8(*(const GAS v4u*)(z1 + ZC_XT + c0), x);
#pragma unroll
                for (int i = 0; i < 8; ++i) up1[8 * p + i] = a[i] * x[i];
            }
        }
    } else {
#pragma unroll
        for (int p = 0; p < 2; ++p) {
            const int c0 = 8 * lane + 512 * p;
#pragma unroll
            for (int q = 0; q < 2; ++q) {
                const f32x4 a = *(const GAS f32x4*)(F.st_conv + ((size_t)b * 2 + 0) * DC + c0 + 4 * q), bb = *(const GAS f32x4*)(F.st_conv + ((size_t)b * 2 + 1) * DC + c0 + 4 * q);
#pragma unroll
                for (int i = 0; i < 4; ++i) { up2[8 * p + 4 * q + i] = a[i]; up1[8 * p + 4 * q + i] = bb[i]; }
            }
        }
    }
#pragma unroll 1
    for (int r = 0; r < 8; ++r) {
        const int row = row0 + r; const bf16* zr = F.Z + (size_t)row * NZ;
        float tt[16]; float ss = 0.f;
#pragma unroll
        for (int p = 0; p < 2; ++p) {
            const int c0 = 8 * lane + 512 * p; float a[8], x[8], g[8];
            unpack8(*(const GAS v4u*)(zr + ZC_CG + c0), a); unpack8(*(const GAS v4u*)(zr + ZC_XT + c0), x); unpack8(*(const GAS v4u*)(zr + ZC_BG + c0), g);
#pragma unroll
            for (int i = 0; i < 8; ++i) { const int ci = 8 * p + i; const float u = a[i] * x[i];
                const float cv = w0[ci] * up2[ci] + w1[ci] * up1[ci] + w2[ci] * u; tt[ci] = g[i] * cv; ss += tt[ci] * tt[ci]; up2[ci] = up1[ci]; up1[ci] = u; }
        }
        const float rr = rsqrtf(wave_sum(ss) * (1.f / DC) + EPS);
#pragma unroll
        for (int p = 0; p < 2; ++p) {
            const int c0 = 8 * lane + 512 * p; v4u o;
            o.x = pk2(tt[8 * p + 0] * rr * cg_[8 * p + 0], tt[8 * p + 1] * rr * cg_[8 * p + 1]); o.y = pk2(tt[8 * p + 2] * rr * cg_[8 * p + 2], tt[8 * p + 3] * rr * cg_[8 * p + 3]);
            o.z = pk2(tt[8 * p + 4] * rr * cg_[8 * p + 4], tt[8 * p + 5] * rr * cg_[8 * p + 5]); o.w = pk2(tt[8 * p + 6] * rr * cg_[8 * p + 6], tt[8 * p + 7] * rr * cg_[8 * p + 7]);
            *(GAS v4u*)(F.YC + (size_t)row * D + c0) = o;
        }
        if (last_item && r >= 6) {
            float* o = F.out + (prompt ? O_PCONV : O_SCONV) + ((size_t)b * 2 + (r - 6)) * DC;
#pragma unroll
            for (int p = 0; p < 2; ++p) { const int c0 = 8 * lane + 512 * p;
                *(GAS f32x4*)(o + c0) = (f32x4){up1[8 * p + 0], up1[8 * p + 1], up1[8 * p + 2], up1[8 * p + 3]}; *(GAS f32x4*)(o + c0 + 4) = (f32x4){up1[8 * p + 4], up1[8 * p + 5], up1[8 * p + 6], up1[8 * p + 7]}; }
        }
    }
}

__device__ __forceinline__ void sample_item(Frame& F, int item) {
    LAS float* L = (LAS float*)(F.lds + RING_OFF);
    LAS float* qT = L; LAS float* kT = L + 1024; LAS float* kwT = L + 2048; LAS float* vS = L + 3072; LAS float* accx = L + 5120; LAS float* Sm = L + 7168;
    LAS float* ai = L + 7232; LAS float* dd = L + 7240; LAS float* wk = L + 7248; LAS float* misc = L + 7256; LAS float* n0s = L + 7264; LAS float* red = L + 7392; LAS float* lis = L + 7424; LAS float* lfs = L + 7432;
    const int tid = F.tid, b = item >> 2, h = item & 3, row0 = MP + 8 * b;
    __syncthreads();
    for (int i = tid; i < 1024; i += NWAVES * 64) { const int t = i >> 7, d = i & 127; const bf16* zr = F.Z + (size_t)(row0 + t) * NZ;
        qT[d * 8 + t] = bf2f(zr[ZC_Q + h * DK + d]) * QSCALE; kT[d * 8 + t] = bf2f(zr[ZC_K + h * DK + d]); }
    for (int i = tid; i < 2048; i += NWAVES * 64) { const int t = i >> 8, e = i & 255; vS[t * 256 + e] = bf2f(F.Z[(size_t)(row0 + t) * NZ + ZC_V + h * DV + e]); }
    if (tid < 8) { lis[tid] = F.gates[(size_t)(row0 + tid) * 8 + h]; lfs[tid] = F.gates[(size_t)(row0 + tid) * 8 + 4 + h]; }
    if (tid < DK) n0s[tid] = F.st_n[(size_t)(b * NH + h) * DK + tid];
    __syncthreads();
    if (F.wave == 0) {
        const int lane = F.lane, t = lane >> 3, s = lane & 7;
        const float m0 = F.st_m[b * NH + h];
        float bc[8]; { float run = 0.f;
#pragma unroll
            for (int i = 0; i < 8; ++i) { run += lfs[i]; bc[i] = run; } }
        float bt = 0.f, bs = 0.f;
#pragma unroll
        for (int i = 0; i < 8; ++i) { bt = (i == t) ? bc[i] : bt; bs = (i == s) ? bc[i] : bs; }
        const float lis_s = lis[s];
        const float dm = (s <= t) ? (bt - bs + lis_s) : -INFINITY;
        float mx = dm; mx = fmaxf(mx, __shfl_xor(mx, 1)); mx = fmaxf(mx, __shfl_xor(mx, 2)); mx = fmaxf(mx, __shfl_xor(mx, 4));
        const float mt = fmaxf(bt + m0, mx);
        const float w = (s <= t) ? __expf(dm - mt) : 0.f;
        const float a_i = __expf(bt + m0 - mt);
        float dot = 0.f, qn = 0.f;
        for (int d = 0; d < DK; ++d) { const float qv = qT[d * 8 + t]; dot += qv * kT[d * 8 + s]; qn += qv * n0s[d]; }
        const float sv = dot * w;
        float rs = sv; rs += __shfl_xor(rs, 1); rs += __shfl_xor(rs, 2); rs += __shfl_xor(rs, 4);
        const float den = a_i * qn + rs;
        Sm[t * 8 + s] = sv;
        const float bL = bc[7];
        const float gs = bL - bs + lis_s;
        float gm = gs; gm = fmaxf(gm, __shfl_xor(gm, 1)); gm = fmaxf(gm, __shfl_xor(gm, 2)); gm = fmaxf(gm, __shfl_xor(gm, 4));
        const float mnew = fmaxf(bL + m0, gm);
        if (s == 0) { ai[t] = a_i; dd[t] = 1.f / fmaxf(fabsf(den), __expf(-mt)); }
        if (t == 0) wk[s] = __expf(gs - mnew);
        if (lane == 0) { misc[0] = __expf(bL + m0 - mnew); misc[1] = mnew; }
    }
    __syncthreads();
    const float sc = misc[0];
    for (int i = tid; i < 1024; i += NWAVES * 64) kwT[i] = kT[i] * wk[i & 7];
    __syncthreads();
    if (tid < DK) { float nn = sc * n0s[tid];
#pragma unroll
        for (int s = 0; s < 8; ++s) nn += kwT[tid * 8 + s];
        F.out[O_SN + (size_t)(b * NH + h) * DK + tid] = nn; }
    if (tid == 0) F.out[O_SM + b * NH + h] = misc[1];
    const int e = tid & 255, half = tid >> 8;
    float vv[8], acc[8];
#pragma unroll
    for (int s = 0; s < 8; ++s) { vv[s] = vS[s * 256 + e]; acc[s] = 0.f; }
    const float* c0p = F.st_C + ((size_t)(b * NH + h) * DK + 64 * half) * DV + e;
    float* c1p = F.out + O_SC + ((size_t)(b * NH + h) * DK + 64 * half) * DV + e;
#pragma unroll 1
    for (int d0 = 0; d0 < 64; d0 += 8) {
        float c[8];
#pragma unroll
        for (int j = 0; j < 8; ++j) c[j] = *(const GAS float*)(c0p + (size_t)(d0 + j) * DV);
#pragma unroll
        for (int j = 0; j < 8; ++j) {
            const int d = 64 * half + d0 + j;
            const f32x4 q0 = *(const LAS f32x4*)(qT + d * 8), q1 = *(const LAS f32x4*)(qT + d * 8 + 4), k0 = *(const LAS f32x4*)(kwT + d * 8), k1 = *(const LAS f32x4*)(kwT + d * 8 + 4);
            float cn = sc * c[j];
#pragma unroll
            for (int s = 0; s < 4; ++s) { acc[s] += q0[s] * c[j]; acc[4 + s] += q1[s] * c[j]; cn += k0[s] * vv[s]; cn += k1[s] * vv[4 + s]; }
            *(GAS float*)(c1p + (size_t)(d0 + j) * DV) = cn;
        }
    }
    if (half == 1) {
#pragma unroll
        for (int t = 0; t < 8; ++t) accx[t * 256 + e] = acc[t]; }
    __syncthreads();
    float hv[8];
    if (half == 0) {
#pragma unroll
        for (int t = 0; t < 8; ++t) { float num = ai[t] * (acc[t] + accx[t * 256 + e]);
#pragma unroll
            for (int s = 0; s < 8; ++s) num += Sm[t * 8 + s] * vv[s];
            hv[t] = num * dd[t]; const float p = wave_sum(hv[t] * hv[t]); if (F.lane == 0) red[F.wave * 8 + t] = p; }
    }
    __syncthreads();
    if (half == 0) {
        const float gml = F.ml_g[h * DV + e];
#pragma unroll
        for (int t = 0; t < 8; ++t) { const float rr = rsqrtf((red[t] + red[8 + t] + red[16 + t] + red[24 + t]) * (1.f / DV) + EPS);
            const float o = bf2f(F.Z[(size_t)(row0 + t) * NZ + ZC_O + h * DV + e]);
            F.YC[(size_t)(row0 + t) * D + DC + h * DV + e] = (bf16)f2bf(sigmoidf_(o) * hv[t] * rr * gml); }
    }
}

typedef short s16x4 __attribute__((ext_vector_type(4)));
typedef float f32x16 __attribute__((ext_vector_type(16)));
#define MFMA32(a, b, c) __builtin_amdgcn_mfma_f32_32x32x16_bf16((a), (b), (c), 0, 0, 0)
__device__ __forceinline__ unsigned tr_addr(unsigned base, int P, int rbase, int C0, int lane) {
    const int h = lane >> 5, blk = (lane >> 4) & 1, q = (lane & 15) >> 2, p = lane & 3;
    return base + (unsigned)((rbase + 8 * h + q) * P + (C0 + 16 * blk + 4 * p) * 2);
}
__device__ __forceinline__ void tr_frag_pair(unsigned a0, unsigned a1, unsigned b0, unsigned b1, bf16x8& A, bf16x8& B) {
    s16x4 x0, x1, y0, y1;
    asm volatile("ds_read_b64_tr_b16 %0, %4\n\tds_read_b64_tr_b16 %1, %5\n\tds_read_b64_tr_b16 %2, %6\n\tds_read_b64_tr_b16 %3, %7\n\ts_waitcnt lgkmcnt(0)"
                 : "=&v"(x0), "=&v"(x1), "=&v"(y0), "=&v"(y1) : "v"(a0), "v"(a1), "v"(b0), "v"(b1) : "memory");
    A = __builtin_shufflevector(x0, x1, 0, 1, 2, 3, 4, 5, 6, 7); B = __builtin_shufflevector(y0, y1, 0, 1, 2, 3, 4, 5, 6, 7);
}
__device__ __forceinline__ bf16x8 tr_frag(unsigned a0, unsigned a1) {
    s16x4 x0, x1;
    asm volatile("ds_read_b64_tr_b16 %0, %2\n\tds_read_b64_tr_b16 %1, %3\n\ts_waitcnt lgkmcnt(0)" : "=&v"(x0), "=&v"(x1) : "v"(a0), "v"(a1) : "memory");
    return __builtin_shufflevector(x0, x1, 0, 1, 2, 3, 4, 5, 6, 7);
}
__device__ __forceinline__ int crow(int reg, int h) { return (reg & 3) + 8 * (reg >> 2) + 4 * h; }

constexpr int SC_PK = 320, SC_PV = 192;
constexpr int SC_KIMG = 0, SC_VIMG = 2 * 64 * SC_PK, SC_WK = SC_VIMG + 2 * 64 * SC_PV, SC_SC = SC_WK + 2048 * 4, SC_BL = SC_SC + 32 * 4, SC_GM = SC_BL + 32 * 4, SC_MST = SC_GM + 32 * 4, SC_NV = SC_MST + 36 * 4, SC_END = SC_NV + 128 * 4;
constexpr size_t WS_CST = WS_C;
constexpr size_t WS_BCUM = WS_GATES + 1 * MiB;
constexpr size_t WS_MST = WS_BCUM + 256 * 1024;
constexpr size_t WS_NST = WS_MST + 64 * 1024;
__device__ __forceinline__ void scan_unit(Frame& F, int unit, unsigned char* ws) {
    const int bh = unit >> 2, es = unit & 3, b = bh >> 2, h = bh & 3, tid = F.tid, lane = F.lane, wave = F.wave;
    LAS unsigned char* L = F.lds + RING_OFF;
    LAS float* wkS = (LAS float*)(L + SC_WK); LAS float* scS = (LAS float*)(L + SC_SC); LAS float* bLS = (LAS float*)(L + SC_BL); LAS float* gmS = (LAS float*)(L + SC_GM); LAS float* mstS = (LAS float*)(L + SC_MST); LAS float* nvS = (LAS float*)(L + SC_NV);
    float* bcumG = (float*)(ws + WS_BCUM) + (size_t)bh * 2048; float* mstG = (float*)(ws + WS_MST) + (size_t)bh * 64; float* nstG = (float*)(ws + WS_NST) + (size_t)bh * 32 * 128;
    bf16* cstG = (bf16*)(ws + WS_CST) + (size_t)bh * 32 * 256 * 128;
    const size_t rowb = (size_t)b * SEQ;
    __syncthreads();
    for (int cc = 0; cc < 4; ++cc) {
        const int c = 4 * wave + cc; const size_t row = rowb + 64 * c + lane;
        const float li = F.gates[row * 8 + h], lf = F.gates[row * 8 + 4 + h];
        float bsum = lf;
#pragma unroll
        for (int o = 1; o < 64; o <<= 1) { const float t = __shfl_up(bsum, o); if (lane >= o) bsum += t; }
        const float bL = __shfl(bsum, 63);
        const float g = bL - bsum + li;
        float gm = g;
#pragma unroll
        for (int o = 1; o < 64; o <<= 1) gm = fmaxf(gm, __shfl_xor(gm, o));
        wkS[64 * c + lane] = g;
        if (es == 0) bcumG[64 * c + lane] = bsum;
        if (lane == 0) { bLS[c] = bL; gmS[c] = gm; }
    }
    __syncthreads();
    if (tid == 0) { float m = 0.f; mstS[0] = 0.f;
        for (int c = 0; c < 32; ++c) { const float mn = fmaxf(bLS[c] + m, gmS[c]); scS[c] = __expf(bLS[c] + m - mn); m = mn; mstS[c + 1] = mn; } }
    __syncthreads();
    for (int i = tid; i < 2048; i += NWAVES * 64) wkS[i] = __expf(wkS[i] - mstS[(i >> 6) + 1]);
    if (es == 0 && tid < 33) mstG[tid] = mstS[tid];
    if (tid < 128) nvS[tid] = 0.f;
    const int dt = wave & 3, et = wave >> 2, hh = lane >> 5;
    f32x16 acc;
#pragma unroll
    for (int i = 0; i < 16; ++i) acc[i] = 0.f;
    const int kr0 = tid >> 4, kc0 = tid & 15;
    const int vr = tid >> 3, vc = tid & 7;
    const bf16* zk = F.Z + rowb * NZ + ZC_K + h * DK; const bf16* zv = F.Z + rowb * NZ + ZC_V + h * DV + 64 * es;
    v4u rk0, rk1, rv;
#define SC_LOAD(c) do { rk0 = *(const GAS v4u*)(zk + (size_t)(64 * (c) + kr0) * NZ + 8 * kc0); rk1 = *(const GAS v4u*)(zk + (size_t)(64 * (c) + kr0 + 32) * NZ + 8 * kc0); \
                        rv = *(const GAS v4u*)(zv + (size_t)(64 * (c) + vr) * NZ + 8 * vc); } while (0)
#define SC_WRITE(c) do { LAS unsigned char* kb = L + SC_KIMG + ((c) & 1) * 64 * SC_PK; LAS unsigned char* vb = L + SC_VIMG + ((c) & 1) * 64 * SC_PV; \
                         *(LAS v4u*)(kb + kr0 * SC_PK + 16 * kc0) = rk0; *(LAS v4u*)(kb + (kr0 + 32) * SC_PK + 16 * kc0) = rk1; \
                         float vf[8]; unpack8(rv, vf); const float w_ = wkS[64 * (c) + vr]; v4u o_; o_.x = pk2(vf[0] * w_, vf[1] * w_); o_.y = pk2(vf[2] * w_, vf[3] * w_); o_.z = pk2(vf[4] * w_, vf[5] * w_); o_.w = pk2(vf[6] * w_, vf[7] * w_); \
                         *(LAS v4u*)(vb + vr * SC_PV + 16 * vc) = o_; } while (0)
    SC_LOAD(0);
    __syncthreads();
    SC_WRITE(0);
    const unsigned lbase = (unsigned)(size_t)L;
#pragma unroll 1
    for (int c = 0; c < 32; ++c) {
        if (c + 1 < 32) SC_LOAD(c + 1);
        __syncthreads();
        { bf16* dst = cstG + ((size_t)c * 256 + 64 * es + 32 * et + (lane & 31)) * 128 + 32 * dt + 4 * hh;
#pragma unroll
          for (int g = 0; g < 4; ++g) *(GAS unsigned long long*)(dst + 8 * g) = (unsigned long long)pk2(acc[4 * g], acc[4 * g + 1]) | ((unsigned long long)pk2(acc[4 * g + 2], acc[4 * g + 3]) << 32); }
        const float sc = scS[c];
#pragma unroll
        for (int i = 0; i < 16; ++i) acc[i] *= sc;
        const unsigned kimg = lbase + SC_KIMG + (c & 1) * 64 * SC_PK, vimg = lbase + SC_VIMG + (c & 1) * 64 * SC_PV;
#pragma unroll
        for (int ks = 0; ks < 4; ++ks) {
            bf16x8 A, B;
            tr_frag_pair(tr_addr(kimg, SC_PK, 16 * ks, 32 * dt, lane), tr_addr(kimg, SC_PK, 16 * ks + 4, 32 * dt, lane),
                         tr_addr(vimg, SC_PV, 16 * ks, 32 * et, lane), tr_addr(vimg, SC_PV, 16 * ks + 4, 32 * et, lane), A, B);
            acc = MFMA32(A, B, acc);
        }
        if (es == 0 && tid < 128) {
            float nn = nvS[tid]; nstG[c * 128 + tid] = nn; nn *= sc;
            const LAS unsigned short* kcol = (const LAS unsigned short*)(L + SC_KIMG + (c & 1) * 64 * SC_PK) + tid;
#pragma unroll 8
            for (int s = 0; s < 64; ++s) nn += wkS[64 * c + s] * bf2f(kcol[s * (SC_PK / 2)]);
            nvS[tid] = nn;
        }
        if (c + 1 < 32) SC_WRITE(c + 1);
    }
#undef SC_LOAD
#undef SC_WRITE
    { float* dst = F.out + O_PC + ((size_t)bh * 128 + 32 * dt) * 256 + 64 * es + 32 * et + (lane & 31);
#pragma unroll
      for (int i = 0; i < 16; ++i) dst[(size_t)crow(i, hh) * 256] = acc[i]; }
    if (es == 0 && tid < 128) F.out[O_PN + (size_t)bh * 128 + tid] = nvS[tid];
    if (es == 0 && tid == 0) F.out[O_PM + bh] = mstS[32];
    __syncthreads();
}
constexpr int P3_PQ = 272, P3_PKK = 272, P3_PV = 576, P3_PP = 144, P3_PH = 1040;
constexpr int P3_Q = 0, P3_K = P3_Q + 64 * P3_PQ, P3_V = P3_K + 64 * P3_PKK, P3_P = P3_V + 64 * P3_PV, P3_H = 0;
constexpr int P3_SM = 81920;
static_assert(P3_P + 64 * P3_PP <= P3_SM && 64 * P3_PH <= P3_SM, "P3 LDS map");
__device__ __forceinline__ void p3_item(Frame& F, int item, unsigned char* ws) {
    const int bh = item >> 5, c = item & 31, b = bh >> 2, h = bh & 3, tid = F.tid, lane = F.lane, wave = F.wave, hh = lane >> 5, l31 = lane & 31;
    LAS unsigned char* L = F.lds + RING_OFF;
    LAS float* sm = (LAS float*)(L + P3_SM); LAS float* bmS = sm; LAS float* aS = sm + 64; LAS float* aiS = sm + 128; LAS float* ddS = sm + 192; LAS float* rsS = sm + 256; LAS float* qnS = sm + 320; LAS float* mtS = sm + 384; LAS float* nvS = sm + 448;
    const size_t row0 = (size_t)b * SEQ + 64 * c;
    const bf16* cst = (const bf16*)(ws + WS_CST) + ((size_t)bh * 32 + c) * 256 * 128;
    __syncthreads();
    { const bf16* zq = F.Z + row0 * NZ + ZC_Q + h * DK; const bf16* zk = F.Z + row0 * NZ + ZC_K + h * DK; const bf16* zv = F.Z + row0 * NZ + ZC_V + h * DV;
#pragma unroll
      for (int i = 0; i < 2; ++i) { const int r = (tid >> 4) + 32 * i, cc = tid & 15;
          *(LAS v4u*)(L + P3_Q + r * P3_PQ + 16 * cc) = *(const GAS v4u*)(zq + (size_t)r * NZ + 8 * cc); *(LAS v4u*)(L + P3_K + r * P3_PKK + 16 * cc) = *(const GAS v4u*)(zk + (size_t)r * NZ + 8 * cc); }
#pragma unroll
      for (int i = 0; i < 4; ++i) { const int r = (tid >> 5) + 16 * i, cc = tid & 31; *(LAS v4u*)(L + P3_V + r * P3_PV + 16 * cc) = *(const GAS v4u*)(zv + (size_t)r * NZ + 8 * cc); } }
    if (wave == 0) {
        const float mc = ((const float*)(ws + WS_MST))[(size_t)bh * 64 + c];
        const float bt = ((const float*)(ws + WS_BCUM))[(size_t)bh * 2048 + 64 * c + lane];
        const float li = F.gates[(row0 + lane) * 8 + h];
        const float a = li - bt; float pm = a;
#pragma unroll
        for (int o = 1; o < 64; o <<= 1) { const float t = __shfl_up(pm, o); if (lane >= o) pm = fmaxf(pm, t); }
        const float mt = bt + fmaxf(mc, pm);
        bmS[lane] = bt - mt; aS[lane] = a; aiS[lane] = __expf(bt + mc - mt); mtS[lane] = mt; rsS[lane] = 0.f;
    }
    if (wave == 1) { const float* np = (const float*)(ws + WS_NST) + ((size_t)bh * 32 + c) * 128; nvS[lane] = np[lane]; nvS[64 + lane] = np[64 + lane]; }
    bf16x8 Cf[8];
    { const bf16* cp = cst + (size_t)(32 * wave + l31) * 128 + 8 * hh;
#pragma unroll
      for (int kd = 0; kd < 8; ++kd) Cf[kd] = *(const GAS bf16x8*)(cp + 16 * kd); }
    __syncthreads();
    { const int t = tid >> 3, part = tid & 7; float s = 0.f;
      const LAS unsigned short* qr = (const LAS unsigned short*)(L + P3_Q + t * P3_PQ) + 16 * part;
#pragma unroll
      for (int j = 0; j < 16; ++j) s += bf2f(qr[j]) * nvS[16 * part + j];
      s += __shfl_xor(s, 1); s += __shfl_xor(s, 2); s += __shfl_xor(s, 4);
      if (part == 0) qnS[t] = s * QSCALE; }
    if (wave < 3) {
        const int si = wave == 2 ? 1 : 0, ti = wave == 0 ? 0 : 1;
        f32x16 x;
#pragma unroll
        for (int i = 0; i < 16; ++i) x[i] = 0.f;
#pragma unroll
        for (int kd = 0; kd < 8; ++kd) {
            const bf16x8 A = *(const LAS bf16x8*)(L + P3_K + (32 * si + l31) * P3_PKK + (16 * kd + 8 * hh) * 2);
            const bf16x8 B = *(const LAS bf16x8*)(L + P3_Q + (32 * ti + l31) * P3_PQ + (16 * kd + 8 * hh) * 2);
            x = MFMA32(A, B, x);
        }
        const int t = 32 * ti + l31; const float bm = bmS[t]; float rsum = 0.f;
#pragma unroll
        for (int g = 0; g < 4; ++g) {
            float p[4];
#pragma unroll
            for (int j = 0; j < 4; ++j) { const int s = 32 * si + 8 * g + 4 * hh + j; const float w = (s <= t) ? __expf(bm + aS[s]) : 0.f; p[j] = x[4 * g + j] * QSCALE * w; rsum += p[j]; }
            *(LAS unsigned long long*)(L + P3_P + t * P3_PP + (32 * si + 8 * g + 4 * hh) * 2) = (unsigned long long)pk2(p[0], p[1]) | ((unsigned long long)pk2(p[2], p[3]) << 32);
        }
        rsum += __shfl_xor(rsum, 32);
        if (hh == 0) atomicAdd((float*)(rsS + t), rsum);
    }
    __syncthreads();
    if (tid < 64) { const float den = aiS[tid] * qnS[tid] + rsS[tid]; ddS[tid] = 1.f / fmaxf(fabsf(den), __expf(-mtS[tid])); }
    bf16x8 Vf[4];
    { const unsigned vimg = (unsigned)(size_t)(L + P3_V);
#pragma unroll
      for (int ks = 0; ks < 4; ++ks) Vf[ks] = tr_frag(tr_addr(vimg, P3_PV, 16 * ks, 32 * wave, lane), tr_addr(vimg, P3_PV, 16 * ks + 4, 32 * wave, lane)); }
    f32x16 n1[2], n2[2];
#pragma unroll
    for (int ti = 0; ti < 2; ++ti) {
#pragma unroll
        for (int i = 0; i < 16; ++i) { n1[ti][i] = 0.f; n2[ti][i] = 0.f; }
#pragma unroll
        for (int kd = 0; kd < 8; ++kd) { const bf16x8 A = *(const LAS bf16x8*)(L + P3_Q + (32 * ti + l31) * P3_PQ + (16 * kd + 8 * hh) * 2); n1[ti] = MFMA32(A, Cf[kd], n1[ti]); }
#pragma unroll
        for (int ks = 0; ks < 2 * (ti + 1); ++ks) { const bf16x8 A = *(const LAS bf16x8*)(L + P3_P + (32 * ti + l31) * P3_PP + (16 * ks + 8 * hh) * 2); n2[ti] = MFMA32(A, Vf[ks], n2[ti]); }
    }
    __syncthreads();
#pragma unroll
    for (int ti = 0; ti < 2; ++ti)
#pragma unroll
        for (int i = 0; i < 16; ++i) { const int t = 32 * ti + crow(i, hh);
            *(LAS float*)(L + P3_H + t * P3_PH + (32 * wave + l31) * 4) = (aiS[t] * QSCALE * n1[ti][i] + n2[ti][i]) * ddS[t]; }
    __syncthreads();
    { const int t = tid >> 3, j = tid & 7; f32x4 hv4[8]; float s = 0.f;
#pragma unroll
      for (int q = 0; q < 8; ++q) { hv4[q] = *(const LAS f32x4*)(L + P3_H + t * P3_PH + (32 * j + 4 * q) * 4); s += (hv4[q].x * hv4[q].x + hv4[q].y * hv4[q].y) + (hv4[q].z * hv4[q].z + hv4[q].w * hv4[q].w); }
      s += __shfl_xor(s, 1); s += __shfl_xor(s, 2); s += __shfl_xor(s, 4);
      const float rr = rsqrtf(s * (1.f / DV) + EPS);
      const bf16* zo = F.Z + (row0 + t) * NZ + ZC_O + h * DV + 32 * j; const float* gp = F.ml_g + h * DV + 32 * j; bf16* yo = F.YC + (row0 + t) * D + DC + h * DV + 32 * j;
#pragma unroll
      for (int q = 0; q < 4; ++q) { float o[8]; unpack8(*(const GAS v4u*)(zo + 8 * q), o);
          const f32x4 g0 = *(const GAS f32x4*)(gp + 8 * q), g1 = *(const GAS f32x4*)(gp + 8 * q + 4); const f32x4 a = hv4[2 * q], bq = hv4[2 * q + 1];
          v4u w; w.x = pk2(sigmoidf_(o[0]) * a.x * rr * g0.x, sigmoidf_(o[1]) * a.y * rr * g0.y); w.y = pk2(sigmoidf_(o[2]) * a.z * rr * g0.z, sigmoidf_(o[3]) * a.w * rr * g0.w);
          w.z = pk2(sigmoidf_(o[4]) * bq.x * rr * g1.x, sigmoidf_(o[5]) * bq.y * rr * g1.y); w.w = pk2(sigmoidf_(o[6]) * bq.z * rr * g1.z, sigmoidf_(o[7]) * bq.w * rr * g1.w);
          *(GAS v4u*)(yo + 8 * q) = w; } }
}
__device__ __forceinline__ void p2_phase(Frame& F, unsigned char* ws) {
    if (F.vcu < 64) scan_unit(F, F.vcu, ws);
    for (int it = F.vcu; it < DB * NH; it += F.G) sample_item(F, it);
    const int gw = F.vcu * NWAVES + F.wave, NGW = F.G * NWAVES;
    for (int it = gw; it < 1152; it += NGW) conv_item(F, it);
    __syncthreads();
}
__device__ __forceinline__ void p3_phase(Frame& F, unsigned char* ws) {
    for (int it = F.vcu; it < 512; it += F.G) p3_item(F, it, ws);
    __syncthreads();
}
typedef unsigned short bf16_t;
__global__ void k_conv(const bf16_t* __restrict__ Z, const float* __restrict__ state_conv, const float* __restrict__ conv_w, const float* __restrict__ conv_g,
                       bf16_t* __restrict__ YC, float* __restrict__ dout) {
    __shared__ float red[4];
    const int m = blockIdx.x, tid = threadIdx.x;
    int b, t, S; const bool prompt = m < MP;
    if (prompt) { b = m / SEQ; t = m % SEQ; S = SEQ; } else { b = (m - MP) / DS; t = (m - MP) % DS; S = DS; }
    float tt[4]; float ss = 0.f;
#pragma unroll
    for (int i = 0; i < 4; ++i) {
        const int c = tid * 4 + i;
        float u[3];
#pragma unroll
        for (int j = 0; j < 3; ++j) {
            const int tp = t - 2 + j;
            if (tp >= 0) { const bf16_t* zr = Z + (size_t)(m - 2 + j) * NZ; u[j] = bf2f(zr[ZC_CG + c]) * bf2f(zr[ZC_XT + c]); }
            else u[j] = prompt ? 0.f : state_conv[((size_t)b * 2 + (tp + 2)) * DC + c];
        }
        const float cv = u[0] * conv_w[c] + u[1] * conv_w[DC + c] + u[2] * conv_w[2 * DC + c];
        tt[i] = bf2f(Z[(size_t)m * NZ + ZC_BG + c]) * cv; ss += tt[i] * tt[i];
        if (t >= S - 2) { float* o = dout + (prompt ? O_PCONV : O_SCONV) + ((size_t)b * 2 + (t - (S - 2))) * DC + c; *o = u[2]; }
    }
    ss = wave_sum(ss); if ((tid & 63) == 0) red[tid >> 6] = ss; __syncthreads();
    const float r = rsqrtf((red[0] + red[1] + red[2] + red[3]) * (1.f / DC) + EPS);
#pragma unroll
    for (int i = 0; i < 4; ++i) { const int c = tid * 4 + i; YC[(size_t)m * D + c] = (bf16_t)f2bf(tt[i] * r * conv_g[c]); }
}

__global__ void __launch_bounds__(256) k_mlstm_naive(const bf16_t* __restrict__ Z, const float* __restrict__ gates, const float* __restrict__ C0, const float* __restrict__ n0, const float* __restrict__ m0,
                              const float* __restrict__ ml_g, bf16_t* __restrict__ YC, float* __restrict__ dout) {
    __shared__ float qs[DK], ks[DK], ns[DK], red[8];
    const int e = threadIdx.x, h = blockIdx.x & 3, sb = blockIdx.x >> 2;
    const bool prompt = sb < NB; const int b = prompt ? sb : sb - NB; const int S = prompt ? SEQ : DS; const int row0 = prompt ? b * SEQ : MP + b * DS;
    float C[DK]; float mm;
    if (prompt) {
#pragma unroll
        for (int d = 0; d < DK; ++d) C[d] = 0.f;
        if (e < DK) ns[e] = 0.f; mm = 0.f;
    } else {
        const float* c0 = C0 + ((size_t)(b * NH + h) * DK) * DV + e;
#pragma unroll
        for (int d = 0; d < DK; ++d) C[d] = c0[(size_t)d * DV];
        if (e < DK) ns[e] = n0[(size_t)(b * NH + h) * DK + e]; mm = m0[b * NH + h];
    }
    const float gml = ml_g[h * DV + e];
    __syncthreads();
    for (int t = 0; t < S; ++t) {
        const size_t row = row0 + t; const bf16_t* zr = Z + row * NZ;
        const float li = gates[row * 8 + h], lf = gates[row * 8 + 4 + h];
        const float mn = fmaxf(lf + mm, li), fp = __expf(lf + mm - mn), ip = __expf(li - mn); mm = mn;
        if (e < DK) { qs[e] = bf2f(zr[ZC_Q + h * DK + e]) * QSCALE; ks[e] = bf2f(zr[ZC_K + h * DK + e]); }
        const float ve = bf2f(zr[ZC_V + h * DV + e]);
        __syncthreads();
        float acc = 0.f;
#pragma unroll
        for (int d = 0; d < DK; ++d) { C[d] = fp * C[d] + (ip * ks[d]) * ve; acc += qs[d] * C[d]; }
        float dp = 0.f;
        if (e < DK) { const float nn = fp * ns[e] + ip * ks[e]; ns[e] = nn; dp = qs[e] * nn; }
        dp = wave_sum(dp); float hs2;
        if ((e & 63) == 0) red[e >> 6] = dp;
        __syncthreads();
        const float den = red[0] + red[1];
        const float hv = acc / fmaxf(fabsf(den), __expf(-mn));
        hs2 = wave_sum(hv * hv);
        if ((e & 63) == 0) red[4 + (e >> 6)] = hs2;
        __syncthreads();
        const float rr = rsqrtf((red[4] + red[5] + red[6] + red[7]) * (1.f / DV) + EPS);
        const float o = bf2f(zr[ZC_O + h * DV + e]);
        YC[row * D + DC + h * DV + e] = (bf16_t)f2bf(sigmoidf_(o) * hv * rr * gml);
        __syncthreads();
    }
    float* oc = dout + (prompt ? O_PC : O_SC) + ((size_t)(b * NH + h) * DK) * DV + e;
#pragma unroll
    for (int d = 0; d < DK; ++d) oc[(size_t)d * DV] = C[d];
    if (e < DK) dout[(prompt ? O_PN : O_SN) + (size_t)(b * NH + h) * DK + e] = ns[e];
    if (e == 0) dout[(prompt ? O_PM : O_SM) + b * NH + h] = mm;
}

struct Args { const float* in[19]; float* out; unsigned char* ws; int ph_lo, ph_hi, li, pad; };
__global__ void __launch_bounds__(NWAVES * 64, 2) mk_fwd(Args args) {
    extern __shared__ __attribute__((aligned(16))) unsigned char lds[];
    Frame F;
    F.lds = (LAS unsigned char*)lds;
    F.MISC = (volatile LAS unsigned*)(F.lds + MISC_OFF);
    F.tid = threadIdx.x; F.lane = F.tid & 63; F.wave = __builtin_amdgcn_readfirstlane(F.tid >> 6);
    F.G = gridDim.x; { const int bx = blockIdx.x; F.vcu = (F.G % 8 == 0) ? (bx % 8) * (F.G / 8) + bx / 8 : bx; }
    unsigned char* ws = args.ws;
    F.ctl = (gu32*)(ws + WS_CTL);
    F.x_p = args.in[0]; F.x_s = args.in[1]; F.st_conv = args.in[2]; F.st_C = args.in[3]; F.st_n = args.in[4]; F.st_m = args.in[5];
    F.g1 = args.in[6]; F.w_in = args.in[7]; F.b_i = args.in[8]; F.b_f = args.in[9]; F.conv_w = args.in[10]; F.conv_g = args.in[11]; F.ml_g = args.in[12];
    F.w_out = args.in[13]; F.g2 = args.in[14]; F.wg = args.in[15]; F.wu = args.in[16]; F.wd = args.in[17]; F.fg = args.in[18]; F.out = args.out;
    F.W1 = (bf16*)(ws + WS_W1); F.W2 = (bf16*)(ws + WS_W2); F.W3 = (bf16*)(ws + WS_W3); F.W4 = (bf16*)(ws + WS_W4);
    F.XN = (bf16*)(ws + WS_A); F.YC = (bf16*)(ws + WS_A); F.Z = (bf16*)(ws + WS_B); F.HB = (bf16*)(ws + WS_B); F.X1b = (bf16*)(ws + WS_C);
    F.gates = (float*)(ws + WS_GATES); F.ssq1 = (float*)(ws + WS_CTL) + CW_SSQ1; F.ssq2 = (float*)(ws + WS_CTL) + CW_SSQ2;
    for (int u = F.tid; u < (LDS_BYTES - LDSCTL_OFF) / 4; u += NWAVES * 64) ((LAS unsigned*)(F.lds + LDSCTL_OFF))[u] = 0u;
    __syncthreads();
    XcdBarrier bar = xcd_barrier_post((unsigned*)(F.ctl + CW_BAR) + args.li * XCD_BAR_WORDS, F.MISC + 8);
    const int lo = args.ph_lo, hi = args.ph_hi;
#define IN(k) (lo <= (k) && (k) < hi)
#define SEAM(k) do { if (IN(k) && IN((k) + 1)) xcd_barrier(bar); } while (0)

    if (IN(0)) { p0_prologue(F); } SEAM(0);
    if (IN(1)) {
        pg8::Gemm g{F.XN, F.W1, M, NZ, D}; pg8::StaticOrder S; S.init(M, NZ, F.G, (int)blockIdx.x);
        pg8::EpiZ E{F.Z, NZ};
        pg8::gemm_phase<pg8::EpiZ, pg8::StaticOrder, PG8_ALIGN, PG8_SP2>(F.lds + RING_OFF, g, S, E);
    } SEAM(1);
    if (IN(2)) { p2_phase(F, ws); } SEAM(2);
    if (IN(3)) { p3_phase(F, ws); } SEAM(3);
    if (IN(4)) {
        pg8::Gemm g{F.YC, F.W2, M, D, D}; pg8::StaticOrder S; S.init(M, D, F.G, (int)blockIdx.x);
        pg8::EpiRes E{F.x_p, F.x_s, MP, F.out, F.X1b, F.ssq1};
        pg8::gemm_phase<pg8::EpiRes, pg8::StaticOrder, PG8_ALIGN, PG8_SP2>(F.lds + RING_OFF, g, S, E);
    } SEAM(4);
    if (IN(5)) {
        pg8::Gemm g{F.X1b, F.W3, M, N3, D}; pg8::StaticOrder S; S.init(M, N3, F.G, (int)blockIdx.x);
        pg8::EpiH E{F.HB, F.ssq1};
        pg8::gemm_phase<pg8::EpiH, pg8::StaticOrder, PG8_ALIGN, PG8_SP2>(F.lds + RING_OFF, g, S, E);
    } SEAM(5);
    if (IN(6)) {
        pg8::Gemm g{F.HB, F.W4, M, D, FF}; pg8::StaticOrder S; S.init(M, D, F.G, (int)blockIdx.x);
        pg8::EpiRes E{F.out, F.out, M, F.out, nullptr, F.ssq2};
        pg8::gemm_phase<pg8::EpiRes, pg8::StaticOrder, PG8_ALIGN, PG8_SP2>(F.lds + RING_OFF, g, S, E);
    } SEAM(6);
    if (IN(7)) { final_norm_phase(F); }
#undef IN
#undef SEAM
}

extern "C" void kernel_launch(void* const* d_in, const int* in_sizes, int n_in, void* d_out, int out_size, void* d_ws, size_t ws_size, hipStream_t stream) {
    static int grid = 0;
    if (grid == 0) {
        if (n_in != 19 || (size_t)out_size != O_END || ws_size < WS_END) { fprintf(stderr, "kernel_launch: unexpected shapes: n_in %d out %d ws %zu; nothing launched\n", n_in, out_size, ws_size); grid = -1; return; }
        int dev = 0, cus = 0;
        if (hipGetDevice(&dev) != hipSuccess || hipDeviceGetAttribute(&cus, hipDeviceAttributeMultiprocessorCount, dev) != hipSuccess) { grid = -1; return; }
        if (hipFuncSetAttribute((const void*)mk_fwd, hipFuncAttributeMaxDynamicSharedMemorySize, LDS_BYTES) != hipSuccess) { fprintf(stderr, "kernel_launch: hipFuncSetAttribute failed\n"); grid = -1; return; }
        grid = cus;
    }
    if (grid < 0) return;
    unsigned char* ws = (unsigned char*)d_ws; float* out = (float*)d_out;
    (void)hipMemsetAsync(ws + WS_CTL, 0, CTL_ZERO_BYTES, stream);
    Args a{};
    for (int i = 0; i < 19; ++i) a.in[i] = (const float*)d_in[i];
    a.out = out; a.ws = ws;
    a.ph_lo = 0; a.ph_hi = 8; a.li = 0;
    hipLaunchKernelGGL(mk_fwd, dim3(grid), dim3(NWAVES * 64), LDS_BYTES, stream, a);
}
```

```cpp
#include <hip/hip_runtime.h>
#include <cstdio>
#include <cstdint>

constexpr int D = 2048, SEQ = 2048, NB = 4, DB = 128, DS = 8;
constexpr int MP = NB * SEQ, MS = DB * DS, M = MP + MS;
constexpr int DC = 1024, NH = 4, DK = 128, DV = 256;
constexpr int NZ = 6144, NIN = 6152, FF = 5632, N3 = 2 * FF;
constexpr float EPS = 1e-6f;
constexpr float QSCALE = 0.08838834764831845f;
constexpr int ZC_BG = 0, ZC_CG = 1024, ZC_XT = 2048, ZC_Q = 3072, ZC_K = 3584, ZC_V = 4096, ZC_O = 5120;
constexpr size_t O_Y = 0, O_PCONV = 18874368, O_PC = 18882560, O_PN = 19406848, O_PM = 19408896,
                 O_SCONV = 19408912, O_SC = 19671056, O_SN = 36448272, O_SM = 36513808, O_END = 36514320;
constexpr size_t MiB = 1u << 20;
constexpr size_t WS_CTL = 0, CTL_ZERO_BYTES = 1 * MiB;
constexpr size_t WS_W1 = 1 * MiB, WS_W2 = 25 * MiB, WS_W3 = 33 * MiB, WS_W4 = 77 * MiB;
constexpr size_t WS_A = 99 * MiB;
constexpr size_t WS_B = 135 * MiB;
constexpr size_t WS_C = 243 * MiB;
constexpr size_t WS_GATES = WS_C + 36 * MiB;
constexpr size_t WS_END = 283 * MiB;
constexpr int CW_TMO = 0, CW_CODE = 1;
constexpr int CW_BAR = 4096;
constexpr int CW_SSQ1 = 65536, CW_SSQ2 = 65536 + 16384;
constexpr int NWAVES = 8;
constexpr int RING_OFF = 0, RING_BYTES = 139264;
constexpr int LDSCTL_OFF = RING_BYTES, MISC_OFF = LDSCTL_OFF + 320;
constexpr int LDS_BYTES = 147456;

namespace pg8 {
#define PG8_LAS __attribute__((address_space(3)))
typedef unsigned short bf16_t;
typedef short bf16x8 __attribute__((ext_vector_type(8)));
typedef float f32x4 __attribute__((ext_vector_type(4)));
typedef unsigned u32x4 __attribute__((ext_vector_type(4)));
constexpr int BM = 256, BK = 64, HALF = 128, HTB = HALF * BK * 2  , STAGE_BYTES = 8 * HTB, NXCD = 8, WGM = 8;

__host__ __device__ __forceinline__ int lds_byte(int r, int c) { const int st = (r >> 4) * 2 + (c >> 5), rr = r & 15, cc = c & 31, ob = rr * 64 + cc * 2; return st * 1024 + (ob ^ (((ob >> 9) & 1) << 5)); }
__host__ __device__ __forceinline__ void stage_rc(int b, int& R, int& C) { const int st = b / 1024, sb = b % 1024, swz = sb ^ (((sb >> 9) & 1) << 5); R = (st >> 1) * 16 + swz / 64; C = (st & 1) * 32 + (swz % 64) / 2; }
__host__ __device__ __forceinline__ int perm32(int rho) { const int n = rho >> 4, i = rho & 15; return 8 * (i >> 2) + 4 * n + (i & 3); }

struct Unit { int pm, pn; };
struct Gemm { const bf16_t* A; const bf16_t* Bt; int M, N, K; };

struct StaticOrder {
    int nM, nN, nwg, G, c;
    __host__ __device__ void init(int M, int N, int G_, int c_) { nM = M / BM; nN = N / BM; nwg = nM * nN; G = G_; c = c_; }
    __host__ __device__ bool next(int i, Unit& u) const {
        const long L = (long)i * G + c; if (L >= nwg) return false;
        int wgid = (int)L; { const int q = nwg / NXCD, r = nwg % NXCD, xcd = wgid % NXCD, off = wgid / NXCD; wgid = (xcd < r ? xcd * (q + 1) : r * (q + 1) + (xcd - r) * q) + off; }
        const int nig = WGM * nN, gid = wgid / nig, fm = gid * WGM, gsz = (nM - fm) < WGM ? (nM - fm) : WGM;
        u.pm = fm + ((wgid % nig) % gsz); u.pn = (wgid % nig) / gsz; return true;
    }
    __device__ __forceinline__ void a_ready(const Unit&) const {}
    __device__ __forceinline__ void done(const Unit&) const {}
};
__device__ __forceinline__ unsigned cvt_pk_bf16(float lo, float hi) { unsigned r; asm volatile("v_cvt_pk_bf16_f32 %0, %1, %2" : "=v"(r) : "v"(lo), "v"(hi)); return r; }
typedef float f32x2 __attribute__((ext_vector_type(2)));
struct EpiZ {
    static constexpr bool PERM = true, AFTER_DRAIN = false;
    bf16_t* O; int ldc;
    __device__ __forceinline__ void operator()(const f32x4 (&acc)[2][2][4][2], const Unit& u, int wr, int wc, int fr, int fq) const {
        const int row0 = u.pm * BM + wr * 64 + fr, col0 = u.pn * BM + wc * 32 + 8 * fq;
#pragma unroll
        for (int ai = 0; ai < 2; ++ai)
#pragma unroll
            for (int m = 0; m < 4; ++m) { bf16_t* rowp = O + (size_t)(row0 + ai * HALF + m * 16) * ldc + col0;
#pragma unroll
                for (int bj = 0; bj < 2; ++bj) { const f32x4 v0 = acc[ai][bj][m][0], v1 = acc[ai][bj][m][1];
                    u32x4 w; w.x = cvt_pk_bf16(v0[0], v0[1]); w.y = cvt_pk_bf16(v0[2], v0[3]); w.z = cvt_pk_bf16(v1[0], v1[1]); w.w = cvt_pk_bf16(v1[2], v1[3]);
                    *(u32x4*)(rowp + bj * HALF) = w; } }
    }
};
struct EpiRes {
    static constexpr bool PERM = true, AFTER_DRAIN = false;
    const float* xp; const float* xs; int rows_p; float* out; bf16_t* X1b; float* ssq;
    __device__ __forceinline__ void operator()(const f32x4 (&acc)[2][2][4][2], const Unit& u, int wr, int wc, int fr, int fq) const {
        const int row0 = u.pm * BM + wr * 64 + fr, col0 = u.pn * BM + wc * 32 + 8 * fq;
#pragma unroll
        for (int ai = 0; ai < 2; ++ai)
#pragma unroll
            for (int m = 0; m < 4; ++m) {
                const int row = row0 + ai * HALF + m * 16;
                const float* xr = (row < rows_p ? xp + (size_t)row * 2048 : xs + (size_t)(row - rows_p) * 2048) + col0;
                float* orow = out + (size_t)row * 2048 + col0; float s = 0.f;
#pragma unroll
                for (int bj = 0; bj < 2; ++bj) {
                    const f32x4 v0 = acc[ai][bj][m][0] + *(const f32x4*)(xr + bj * HALF), v1 = acc[ai][bj][m][1] + *(const f32x4*)(xr + bj * HALF + 4);
                    *(f32x4*)(orow + bj * HALF) = v0; *(f32x4*)(orow + bj * HALF + 4) = v1;
                    s += (v0[0] * v0[0] + v0[1] * v0[1]) + (v0[2] * v0[2] + v0[3] * v0[3]) + (v1[0] * v1[0] + v1[1] * v1[1]) + (v1[2] * v1[2] + v1[3] * v1[3]);
                    if (X1b) { u32x4 w; w.x = cvt_pk_bf16(v0[0], v0[1]); w.y = cvt_pk_bf16(v0[2], v0[3]); w.z = cvt_pk_bf16(v1[0], v1[1]); w.w = cvt_pk_bf16(v1[2], v1[3]);
                        *(u32x4*)(X1b + (size_t)row * 2048 + col0 + bj * HALF) = w; }
                }
                s += __shfl_xor(s, 16); s += __shfl_xor(s, 32);
                if (fq == 0) atomicAdd(ssq + row, s);
                asm volatile("" ::: "memory");
            }
    }
};
struct EpiH {
    static constexpr bool PERM = true, AFTER_DRAIN = false;
    bf16_t* H; const float* ssq;
    __device__ __forceinline__ void operator()(const f32x4 (&acc)[2][2][4][2], const Unit& u, int wr, int wc, int fr, int fq) const {
        const int row0 = u.pm * BM + wr * 64 + fr, col0 = u.pn * HALF + wc * 32 + 8 * fq;
#pragma unroll
        for (int ai = 0; ai < 2; ++ai)
#pragma unroll
            for (int m = 0; m < 4; ++m) {
                const int row = row0 + ai * HALF + m * 16;
                const float r = rsqrtf(ssq[row] * (1.0f / 2048.0f) + 1e-6f);
                float h[8];
#pragma unroll
                for (int n = 0; n < 2; ++n)
#pragma unroll
                    for (int j = 0; j < 4; ++j) { const float g = acc[ai][0][m][n][j] * r, up = acc[ai][1][m][n][j] * r;
                        h[4 * n + j] = g * __builtin_amdgcn_rcpf(1.0f + __expf(-g)) * up; }
                u32x4 w; w.x = cvt_pk_bf16(h[0], h[1]); w.y = cvt_pk_bf16(h[2], h[3]); w.z = cvt_pk_bf16(h[4], h[5]); w.w = cvt_pk_bf16(h[6], h[7]);
                *(u32x4*)(H + (size_t)row * 5632 + col0) = w;
            }
    }
};
template <class Epi, class Sched, bool ALIGN_EPI = false, bool SP2 = false>
__device__ __forceinline__ void gemm_phase(PG8_LAS unsigned char* lds, const Gemm g, const Sched& S, const Epi& E) {
    const int tid = threadIdx.x, wid = __builtin_amdgcn_readfirstlane(tid >> 6), lane = tid & 63, wr = wid >> 2, wc = wid & 3, fr = lane & 15, fq = lane >> 4;
    const int K = g.K, nt = K / BK;
    unsigned voffA[2], voffB[2];
#pragma unroll
    for (int i = 0; i < 2; ++i) { int R, C; stage_rc(tid * 16 + i * 8192, R, C); const int Rb = Epi::PERM ? ((R & ~31) + perm32(R & 31)) : R;
        voffA[i] = (unsigned)(R * K + C) * 2u; voffB[i] = (unsigned)(Rb * K + C) * 2u; }
    const size_t kstep = (size_t)(BK * 2);
    const size_t hstep = (size_t)HALF * K * 2;
    const size_t tstep = 2 * hstep;
    const unsigned ldsw = (unsigned)wid * 1024u;
    const int aoff = lds_byte(wr * 64 + fr, fq * 8), boff = lds_byte(wc * 32 + fr, fq * 8);
#define PG8_SA(b, h) (((b) * 2 + (h)) * HTB)
#define PG8_SB(b, h) ((4 + (b) * 2 + (h)) * HTB)
#define PG8_STAGE(bufoff, gbase, voff) do { _Pragma("unroll") for (int _i = 0; _i < 2; ++_i) \
        __builtin_amdgcn_global_load_lds((const unsigned*)((const char*)(gbase) + (voff)[_i]), (PG8_LAS unsigned*)(lds + (bufoff) + ldsw + _i * 8192), 16, 0, 0); } while (0)
#define PG8_LDA(dst, b, h) do { _Pragma("unroll") for (int m = 0; m < 4; ++m) _Pragma("unroll") for (int k = 0; k < 2; ++k) dst[m][k] = *(const PG8_LAS bf16x8*)(lds + PG8_SA(b, h) + aoff + m * 2048 + k * 1024); } while (0)
#define PG8_LDB(dst, b, h) do { _Pragma("unroll") for (int n = 0; n < 2; ++n) _Pragma("unroll") for (int k = 0; k < 2; ++k) dst[n][k] = *(const PG8_LAS bf16x8*)(lds + PG8_SB(b, h) + boff + n * 2048 + k * 1024); } while (0)
#define PG8_MMA(ai, bj, At, Bt) do { __builtin_amdgcn_s_setprio(1); _Pragma("unroll") for (int m = 0; m < 4; ++m) _Pragma("unroll") for (int n = 0; n < 2; ++n) _Pragma("unroll") for (int k = 0; k < 2; ++k) \
        acc[ai][bj][m][n] = __builtin_amdgcn_mfma_f32_16x16x32_bf16(Bt[n][k], At[m][k], acc[ai][bj][m][n], 0, 0, 0); __builtin_amdgcn_s_setprio(0); } while (0)
#define PG8_WAIT_V(n) asm volatile("s_waitcnt vmcnt(" #n ")" ::: "memory")
#define PG8_WAIT_L(n) asm volatile("s_waitcnt lgkmcnt(" #n ")" ::: "memory")
#define PG8_BAR __builtin_amdgcn_s_barrier()
#define PG8_SCHED __builtin_amdgcn_sched_barrier(0)
    Unit cur, nxt; int ui = 0;
    if (!S.next(0, cur)) return;
    f32x4 acc[2][2][4][2];
#pragma unroll
    for (int a = 0; a < 2; ++a)
#pragma unroll
        for (int b = 0; b < 2; ++b)
#pragma unroll
            for (int m = 0; m < 4; ++m)
#pragma unroll
                for (int n = 0; n < 2; ++n) acc[a][b][m][n] = (f32x4){0.f, 0.f, 0.f, 0.f};
    bf16x8 At[4][2], B0[2][2], B1[2][2];
    const char* cA = (const char*)g.A + (size_t)cur.pm * tstep; const char* cB = (const char*)g.Bt + (size_t)cur.pn * tstep;
    S.a_ready(cur);
    if constexpr (SP2) {
        PG8_STAGE(PG8_SB(0, 0), cB, voffB); PG8_STAGE(PG8_SB(0, 1), cB + hstep, voffB); PG8_STAGE(PG8_SA(0, 0), cA, voffA); PG8_STAGE(PG8_SA(0, 1), cA + hstep, voffA);
        if (wr == 1) PG8_BAR;
        PG8_WAIT_V(2); PG8_BAR;
        PG8_STAGE(PG8_SB(1, 0), cB + kstep, voffB); PG8_STAGE(PG8_SA(1, 0), cA + kstep, voffA); PG8_STAGE(PG8_SB(1, 1), cB + hstep + kstep, voffB);
        PG8_WAIT_V(6); PG8_BAR;
    } else {
        PG8_STAGE(PG8_SB(0, 0), cB, voffB); PG8_STAGE(PG8_SA(0, 0), cA, voffA); PG8_STAGE(PG8_SB(0, 1), cB + hstep, voffB); PG8_STAGE(PG8_SA(0, 1), cA + hstep, voffA);
        if (wr == 1) PG8_BAR;
        PG8_WAIT_V(4); PG8_BAR;
        PG8_STAGE(PG8_SB(1, 0), cB + kstep, voffB); PG8_STAGE(PG8_SA(1, 0), cA + kstep, voffA); PG8_STAGE(PG8_SB(1, 1), cB + hstep + kstep, voffB);
        PG8_WAIT_V(6); PG8_BAR;
    }
    for (;;) {
        const bool has_next = S.next(ui + 1, nxt);
        const char* nA = has_next ? (const char*)g.A + (size_t)nxt.pm * tstep : cA; const char* nB = has_next ? (const char*)g.Bt + (size_t)nxt.pn * tstep : cB;
        for (int t = 0; t < nt; t += 2) {
            const bool last = (t == nt - 2);
            const char* a1 = cA + (size_t)(t + 1) * kstep;
            const char* a2 = last ? nA : cA + (size_t)(t + 2) * kstep; const char* b2 = last ? nB : cB + (size_t)(t + 2) * kstep;
            const char* a3 = a2 + kstep; const char* b3 = b2 + kstep;
            if (last && has_next) S.a_ready(nxt);
            if constexpr (SP2) {
            PG8_LDB(B0, 0, 0); PG8_LDB(B1, 0, 1); PG8_SCHED; PG8_LDA(At, 0, 0); PG8_STAGE(PG8_SA(1, 1), a1 + hstep, voffA);
            PG8_WAIT_V(8); PG8_WAIT_L(0); PG8_BAR; PG8_MMA(0, 0, At, B0); PG8_MMA(0, 1, At, B1); PG8_BAR; PG8_SCHED;
            PG8_LDA(At, 0, 1); PG8_STAGE(PG8_SB(0, 0), b2, voffB); PG8_STAGE(PG8_SB(0, 1), b2 + hstep, voffB); PG8_STAGE(PG8_SA(0, 0), a2, voffA);
            PG8_WAIT_V(8); PG8_WAIT_L(0); PG8_BAR; PG8_MMA(1, 0, At, B0); PG8_MMA(1, 1, At, B1); PG8_BAR; PG8_SCHED;
            PG8_LDB(B0, 1, 0); PG8_LDB(B1, 1, 1); PG8_SCHED; PG8_LDA(At, 1, 0); PG8_STAGE(PG8_SA(0, 1), a2 + hstep, voffA);
            PG8_WAIT_V(8); PG8_WAIT_L(0); PG8_BAR; PG8_MMA(0, 0, At, B0); PG8_MMA(0, 1, At, B1); PG8_BAR; PG8_SCHED;
            PG8_LDA(At, 1, 1); PG8_STAGE(PG8_SB(1, 0), b3, voffB); PG8_STAGE(PG8_SB(1, 1), b3 + hstep, voffB); PG8_STAGE(PG8_SA(1, 0), a3, voffA);
            PG8_WAIT_V(8); PG8_WAIT_L(0); PG8_BAR; PG8_MMA(1, 0, At, B0); PG8_MMA(1, 1, At, B1); PG8_BAR; PG8_SCHED;
            } else {
            PG8_LDB(B0, 0, 0); PG8_SCHED; PG8_LDA(At, 0, 0); PG8_STAGE(PG8_SA(1, 1), a1 + hstep, voffA);
            PG8_WAIT_L(8); PG8_BAR; PG8_WAIT_L(0); PG8_MMA(0, 0, At, B0); PG8_BAR; PG8_SCHED;
            PG8_LDB(B1, 0, 1); PG8_STAGE(PG8_SB(0, 0), b2, voffB);
            PG8_BAR; PG8_WAIT_L(0); PG8_MMA(0, 1, At, B1); PG8_BAR;
            PG8_LDA(At, 0, 1); PG8_STAGE(PG8_SA(0, 0), a2, voffA);
            PG8_BAR; PG8_WAIT_L(0); PG8_MMA(1, 0, At, B0); PG8_BAR; PG8_SCHED;
            PG8_STAGE(PG8_SB(0, 1), b2 + hstep, voffB);
            PG8_WAIT_V(6); PG8_BAR; PG8_MMA(1, 1, At, B1); PG8_BAR;
            PG8_LDB(B0, 1, 0); PG8_SCHED; PG8_LDA(At, 1, 0); PG8_STAGE(PG8_SA(0, 1), a2 + hstep, voffA);
            PG8_WAIT_L(8); PG8_BAR; PG8_WAIT_L(0); PG8_MMA(0, 0, At, B0); PG8_BAR; PG8_SCHED;
            PG8_LDB(B1, 1, 1); PG8_STAGE(PG8_SB(1, 0), b3, voffB);
            PG8_BAR; PG8_WAIT_L(0); PG8_MMA(0, 1, At, B1); PG8_BAR;
            PG8_LDA(At, 1, 1); PG8_STAGE(PG8_SA(1, 0), a3, voffA);
            PG8_BAR; PG8_WAIT_L(0); PG8_MMA(1, 0, At, B0); PG8_BAR; PG8_SCHED;
            PG8_STAGE(PG8_SB(1, 1), b3 + hstep, voffB);
            PG8_WAIT_V(6); PG8_BAR; PG8_MMA(1, 1, At, B1); PG8_BAR;
            }
        }
        if constexpr (ALIGN_EPI) { if (wr == 0) PG8_BAR; }
        if constexpr (!Epi::AFTER_DRAIN) { E(acc, cur, wr, wc, fr, fq); S.done(cur); }
        if (!has_next) break;
#pragma unroll
        for (int a = 0; a < 2; ++a)
#pragma unroll
            for (int b = 0; b < 2; ++b)
#pragma unroll
                for (int m = 0; m < 4; ++m)
#pragma unroll
                    for (int n = 0; n < 2; ++n) acc[a][b][m][n] = (f32x4){0.f, 0.f, 0.f, 0.f};
        cur = nxt; cA = nA; cB = nB; ++ui;
        if constexpr (ALIGN_EPI) { if (wr == 1) PG8_BAR; }
    }
    PG8_WAIT_V(0);
    if constexpr (!ALIGN_EPI) { if (wr == 0) PG8_BAR; }
    PG8_BAR;
    if constexpr (Epi::AFTER_DRAIN) { E.fused(acc, cur, wr, wc, fr, fq, lds, wid, lane); S.done(cur); }
#undef PG8_SA
#undef PG8_SB
#undef PG8_STAGE
#undef PG8_LDA
#undef PG8_LDB
#undef PG8_MMA
#undef PG8_WAIT_V
#undef PG8_WAIT_L
#undef PG8_BAR
#undef PG8_SCHED
}
}
#ifndef PG8_SP2
#define PG8_SP2 true
#endif
#ifndef PG8_ALIGN
#define PG8_ALIGN true
#endif
namespace pg9 {
using pg8::lds_byte; using pg8::stage_rc; using pg8::perm32; using pg8::cvt_pk_bf16; using pg8::bf16_t; using pg8::bf16x8; using pg8::f32x4; using pg8::u32x4; using pg8::Gemm;
constexpr int BMR = 288, BN = 256, BK = 64, HALF = 128, TH = 96, ATB = TH * BK * 2  , HTB = HALF * BK * 2  , STAGE_BYTES = 6 * ATB + 4 * HTB  , NXCD = 8, WGM = 8;
struct Unit { int pm, pn; };
struct StaticOrder {
    int nM, nN, nwg, G, c;
    __host__ __device__ void init(int M, int N, int G_, int c_) { nM = M / BMR; nN = N / BN; nwg = nM * nN; G = G_; c = c_; }
    __host__ __device__ bool next(int i, Unit& u) const {
        const long L = (long)i * G + c; if (L >= nwg) return false;
        int wgid = (int)L; { const int q = nwg / NXCD, r = nwg % NXCD, xcd = wgid % NXCD, off = wgid / NXCD; wgid = (xcd < r ? xcd * (q + 1) : r * (q + 1) + (xcd - r) * q) + off; }
        const int nig = WGM * nN, gid = wgid / nig, fm = gid * WGM, gsz = (nM - fm) < WGM ? (nM - fm) : WGM;
        u.pm = fm + ((wgid % nig) % gsz); u.pn = (wgid % nig) / gsz; return true;
    }
};
typedef f32x4 Acc[3][2][3][2];

struct EpiZ {
    bf16_t* O; int ldc;
    __device__ __forceinline__ void operator()(const Acc& acc, const Unit& u, int wr, int wc, int fr, int fq) const {
        const int row0 = u.pm * BMR + wr * 144 + fr, col0 = u.pn * BN + wc * 32 + 8 * fq;
#pragma unroll
        for (int ai = 0; ai < 3; ++ai)
#pragma unroll
            for (int m = 0; m < 3; ++m) { bf16_t* rowp = O + (size_t)(row0 + ai * 48 + m * 16) * ldc + col0;
#pragma unroll
                for (int bj = 0; bj < 2; ++bj) { const f32x4 v0 = acc[ai][bj][m][0], v1 = acc[ai][bj][m][1];
                    u32x4 w; w.x = cvt_pk_bf16(v0[0], v0[1]); w.y = cvt_pk_bf16(v0[2], v0[3]); w.z = cvt_pk_bf16(v1[0], v1[1]); w.w = cvt_pk_bf16(v1[2], v1[3]);
                    *(u32x4*)(rowp + bj * HALF) = w; } }
    }
};
struct EpiRes {
    const float* xp; const float* xs; int rows_p; float* out; bf16_t* X1b; float* ssq;
    __device__ __forceinline__ void operator()(const Acc& acc, const Unit& u, int wr, int wc, int fr, int fq) const {
        const int row0 = u.pm * BMR + wr * 144 + fr, col0 = u.pn * BN + wc * 32 + 8 * fq;
#pragma unroll
        for (int ai = 0; ai < 3; ++ai)
#pragma unroll
            for (int m = 0; m < 3; ++m) {
                const int row = row0 + ai * 48 + m * 16;
                const float* xr = (row < rows_p ? xp + (size_t)row * 2048 : xs + (size_t)(row - rows_p) * 2048) + col0;
                float* orow = out + (size_t)row * 2048 + col0; float s = 0.f;
#pragma unroll
                for (int bj = 0; bj < 2; ++bj) {
                    const f32x4 v0 = acc[ai][bj][m][0] + *(const f32x4*)(xr + bj * HALF), v1 = acc[ai][bj][m][1] + *(const f32x4*)(xr + bj * HALF + 4);
                    *(f32x4*)(orow + bj * HALF) = v0; *(f32x4*)(orow + bj * HALF + 4) = v1;
                    s += (v0[0] * v0[0] + v0[1] * v0[1]) + (v0[2] * v0[2] + v0[3] * v0[3]) + (v1[0] * v1[0] + v1[1] * v1[1]) + (v1[2] * v1[2] + v1[3] * v1[3]);
                    if (X1b) { u32x4 w; w.x = cvt_pk_bf16(v0[0], v0[1]); w.y = cvt_pk_bf16(v0[2], v0[3]); w.z = cvt_pk_bf16(v1[0], v1[1]); w.w = cvt_pk_bf16(v1[2], v1[3]);
                        *(u32x4*)(X1b + (size_t)row * 2048 + col0 + bj * HALF) = w; }
                }
                s += __shfl_xor(s, 16); s += __shfl_xor(s, 32);
                if (fq == 0) atomicAdd(ssq + row, s);
                asm volatile("" ::: "memory");
            }
    }
};
struct EpiH {
    bf16_t* H; const float* ssq;
    __device__ __forceinline__ void operator()(const Acc& acc, const Unit& u, int wr, int wc, int fr, int fq) const {
        const int row0 = u.pm * BMR + wr * 144 + fr, col0 = u.pn * HALF + wc * 32 + 8 * fq;
#pragma unroll
        for (int ai = 0; ai < 3; ++ai)
#pragma unroll
            for (int m = 0; m < 3; ++m) {
                const int row = row0 + ai * 48 + m * 16;
                const float r = rsqrtf(ssq[row] * (1.0f / 2048.0f) + 1e-6f);
                float h[8];
#pragma unroll
                for (int n = 0; n < 2; ++n)
#pragma unroll
                    for (int j = 0; j < 4; ++j) { const float g = acc[ai][0][m][n][j] * r, up = acc[ai][1][m][n][j] * r;
                        h[4 * n + j] = g * __builtin_amdgcn_rcpf(1.0f + __expf(-g)) * up; }
                u32x4 w; w.x = cvt_pk_bf16(h[0], h[1]); w.y = cvt_pk_bf16(h[2], h[3]); w.z = cvt_pk_bf16(h[4], h[5]); w.w = cvt_pk_bf16(h[6], h[7]);
                *(u32x4*)(H + (size_t)row * 5632 + col0) = w;
            }
    }
};

template <class Epi, bool ALIGN_EPI = true>
__device__ __forceinline__ void gemm_phase(PG8_LAS unsigned char* lds, const Gemm g, const StaticOrder& S, const Epi& E) {
    const int tid = threadIdx.x, wid = __builtin_amdgcn_readfirstlane(tid >> 6), lane = tid & 63, wr = wid >> 2, wc = wid & 3, fr = lane & 15, fq = lane >> 4;
    const int K = g.K, nt = K / BK;
    unsigned voffA[2], voffB[2];
#pragma unroll
    for (int i = 0; i < 2; ++i) { int R, C; stage_rc(tid * 16 + i * 8192, R, C); const int Rb = (R & ~31) + perm32(R & 31); const int Ra = 144 * (R / 48) + (R % 48);
        voffA[i] = (unsigned)(Ra * K + C) * 2u; voffB[i] = (unsigned)(Rb * K + C) * 2u; }
    const size_t kstep = (size_t)(BK * 2);
    const size_t hstep = (size_t)HALF * K * 2;
    const size_t thA = (size_t)48 * K * 2;
    const size_t tstepA = (size_t)BMR * K * 2, tstepB = (size_t)BN * K * 2;
    const unsigned ldsw = (unsigned)wid * 1024u;
    const int aoff = lds_byte(wr * 48 + fr, fq * 8), boff = lds_byte(wc * 32 + fr, fq * 8);
#define PG9_SA(b, a) (((b) * 3 + (a)) * ATB)
#define PG9_SB(b, h) (6 * ATB + ((b) * 2 + (h)) * HTB)
#define PG9_STAGE_B(bufoff, gbase) do { _Pragma("unroll") for (int _i = 0; _i < 2; ++_i) \
        __builtin_amdgcn_global_load_lds((const unsigned*)((const char*)(gbase) + voffB[_i]), (PG8_LAS unsigned*)(lds + (bufoff) + ldsw + _i * 8192), 16, 0, 0); } while (0)
#define PG9_STAGE_A(bufoff, gbase) do { __builtin_amdgcn_global_load_lds((const unsigned*)((const char*)(gbase) + voffA[0]), (PG8_LAS unsigned*)(lds + (bufoff) + ldsw), 16, 0, 0); \
        if (wr == 0) __builtin_amdgcn_global_load_lds((const unsigned*)((const char*)(gbase) + voffA[1]), (PG8_LAS unsigned*)(lds + (bufoff) + ldsw + 8192), 16, 0, 0); } while (0)
#define PG9_LDA(dst, b, a) do { _Pragma("unroll") for (int m = 0; m < 3; ++m) _Pragma("unroll") for (int k = 0; k < 2; ++k) dst[m][k] = *(const PG8_LAS bf16x8*)(lds + PG9_SA(b, a) + aoff + m * 2048 + k * 1024); } while (0)
#define PG9_LDB(dst, b, h) do { _Pragma("unroll") for (int n = 0; n < 2; ++n) _Pragma("unroll") for (int k = 0; k < 2; ++k) dst[n][k] = *(const PG8_LAS bf16x8*)(lds + PG9_SB(b, h) + boff + n * 2048 + k * 1024); } while (0)
#define PG9_MMA(ai, bj, At, Bt) do { __builtin_amdgcn_s_setprio(1); _Pragma("unroll") for (int m = 0; m < 3; ++m) _Pragma("unroll") for (int n = 0; n < 2; ++n) _Pragma("unroll") for (int k = 0; k < 2; ++k) \
        acc[ai][bj][m][n] = __builtin_amdgcn_mfma_f32_16x16x32_bf16(Bt[n][k], At[m][k], acc[ai][bj][m][n], 0, 0, 0); __builtin_amdgcn_s_setprio(0); } while (0)
#define PG9_WAIT_V(n0, n1) do { if (wr == 0) asm volatile("s_waitcnt vmcnt(" #n0 ")" ::: "memory"); else asm volatile("s_waitcnt vmcnt(" #n1 ")" ::: "memory"); } while (0)
#define PG9_WAIT_L0 asm volatile("s_waitcnt lgkmcnt(0)" ::: "memory")
#define PG9_BAR __builtin_amdgcn_s_barrier()
#define PG9_SCHED __builtin_amdgcn_sched_barrier(0)
#define PG9_ZERO() do { _Pragma("unroll") for (int a = 0; a < 3; ++a) _Pragma("unroll") for (int b = 0; b < 2; ++b) _Pragma("unroll") for (int m = 0; m < 3; ++m) _Pragma("unroll") for (int n = 0; n < 2; ++n) acc[a][b][m][n] = (f32x4){0.f, 0.f, 0.f, 0.f}; } while (0)
    Unit cur, nxt; int ui = 0;
    if (!S.next(0, cur)) return;
    Acc acc; PG9_ZERO();
    bf16x8 At[3][2], B0[2][2], B1[2][2];
    const char* cA = (const char*)g.A + (size_t)cur.pm * tstepA; const char* cB = (const char*)g.Bt + (size_t)cur.pn * tstepB;
    PG9_STAGE_B(PG9_SB(0, 0), cB); PG9_STAGE_B(PG9_SB(0, 1), cB + hstep); PG9_STAGE_A(PG9_SA(0, 0), cA); PG9_STAGE_A(PG9_SA(0, 1), cA + thA); PG9_STAGE_A(PG9_SA(0, 2), cA + 2 * thA);
    PG9_STAGE_B(PG9_SB(1, 0), cB + kstep); PG9_STAGE_B(PG9_SB(1, 1), cB + hstep + kstep); PG9_STAGE_A(PG9_SA(1, 0), cA + kstep); PG9_STAGE_A(PG9_SA(1, 1), cA + thA + kstep);
    if (wr == 1) PG9_BAR;
    PG9_WAIT_V(12, 8); PG9_BAR; PG9_BAR;
    for (;;) {
        const bool has_next = S.next(ui + 1, nxt);
        const char* nA = has_next ? (const char*)g.A + (size_t)nxt.pm * tstepA : cA; const char* nB = has_next ? (const char*)g.Bt + (size_t)nxt.pn * tstepB : cB;
        for (int t = 0; t < nt; t += 2) {
            const bool last = (t == nt - 2);
            const char* a1 = cA + (size_t)(t + 1) * kstep;
            const char* a2 = last ? nA : cA + (size_t)(t + 2) * kstep; const char* b2 = last ? nB : cB + (size_t)(t + 2) * kstep;
            const char* a3 = a2 + kstep; const char* b3 = b2 + kstep;
            PG9_LDB(B0, 0, 0); PG9_LDB(B1, 0, 1); PG9_SCHED; PG9_LDA(At, 0, 0); PG9_STAGE_A(PG9_SA(1, 2), a1 + 2 * thA);
            PG9_WAIT_V(12, 8); PG9_WAIT_L0; PG9_BAR; PG9_MMA(0, 0, At, B0); PG9_MMA(0, 1, At, B1); PG9_BAR; PG9_SCHED;
            PG9_LDA(At, 0, 1); PG9_STAGE_B(PG9_SB(0, 0), b2); PG9_STAGE_B(PG9_SB(0, 1), b2 + hstep); PG9_STAGE_A(PG9_SA(0, 0), a2);
            PG9_WAIT_V(16, 12); PG9_WAIT_L0; PG9_BAR; PG9_MMA(1, 0, At, B0); PG9_MMA(1, 1, At, B1); PG9_BAR; PG9_SCHED;
            PG9_LDA(At, 0, 2); PG9_STAGE_A(PG9_SA(0, 1), a2 + thA);
            PG9_WAIT_V(12, 8); PG9_WAIT_L0; PG9_BAR; PG9_MMA(2, 0, At, B0); PG9_MMA(2, 1, At, B1); PG9_BAR; PG9_SCHED;
            PG9_LDB(B0, 1, 0); PG9_LDB(B1, 1, 1); PG9_SCHED; PG9_LDA(At, 1, 0); PG9_STAGE_A(PG9_SA(0, 2), a2 + 2 * thA);
            PG9_WAIT_V(12, 8); PG9_WAIT_L0; PG9_BAR; PG9_MMA(0, 0, At, B0); PG9_MMA(0, 1, At, B1); PG9_BAR; PG9_SCHED;
            PG9_LDA(At, 1, 1); PG9_STAGE_B(PG9_SB(1, 0), b3); PG9_STAGE_B(PG9_SB(1, 1), b3 + hstep); PG9_STAGE_A(PG9_SA(1, 0), a3);
            PG9_WAIT_V(16, 12); PG9_WAIT_L0; PG9_BAR; PG9_MMA(1, 0, At, B0); PG9_MMA(1, 1, At, B1); PG9_BAR; PG9_SCHED;
            PG9_LDA(At, 1, 2); PG9_STAGE_A(PG9_SA(1, 1), a3 + thA);
            PG9_WAIT_V(12, 8); PG9_WAIT_L0; PG9_BAR; PG9_MMA(2, 0, At, B0); PG9_MMA(2, 1, At, B1); PG9_BAR; PG9_SCHED;
        }
        if constexpr (ALIGN_EPI) { if (wr == 0) PG9_BAR; }
        E(acc, cur, wr, wc, fr, fq);
        if (!has_next) break;
        PG9_ZERO();
        cur = nxt; cA = nA; cB = nB; ++ui;
        if constexpr (ALIGN_EPI) { if (wr == 1) PG9_BAR; }
    }
    asm volatile("s_waitcnt vmcnt(0)" ::: "memory");
    if constexpr (!ALIGN_EPI) { if (wr == 0) PG9_BAR; }
    PG9_BAR;
#undef PG9_SA
#undef PG9_SB
#undef PG9_STAGE_A
#undef PG9_STAGE_B
#undef PG9_LDA
#undef PG9_LDB
#undef PG9_MMA
#undef PG9_WAIT_V
#undef PG9_WAIT_L0
#undef PG9_BAR
#undef PG9_SCHED
#undef PG9_ZERO
}
}
#define GAS __attribute__((address_space(1)))
#define LAS __attribute__((address_space(3)))
typedef unsigned short bf16;
typedef unsigned v4u __attribute__((ext_vector_type(4)));
typedef float f32x4 __attribute__((ext_vector_type(4)));
typedef short bf16x8 __attribute__((ext_vector_type(8)));
typedef GAS unsigned gu32;
typedef GAS unsigned long long gu64;
#define RLX_AGENT __ATOMIC_RELAXED, __HIP_MEMORY_SCOPE_AGENT
#define LDS_WAIT() asm volatile("s_waitcnt lgkmcnt(0)" ::: "memory")
#define VM_WAIT() asm volatile("s_waitcnt vmcnt(0)" ::: "memory")
__device__ __forceinline__ unsigned f2bf(float f) { unsigned u = __builtin_bit_cast(unsigned, f); return (u + 0x7fffu + ((u >> 16) & 1u)) >> 16; }
__device__ __forceinline__ unsigned pk2(float lo, float hi) { return f2bf(lo) | (f2bf(hi) << 16); }
__device__ __forceinline__ float bf2f(unsigned b) { return __builtin_bit_cast(float, b << 16); }
__device__ __forceinline__ float wave_sum(float v) {
#pragma unroll
    for (int o = 1; o < 64; o <<= 1) v += __shfl_xor(v, o);
    return v;
}
__device__ __forceinline__ float sigmoidf_(float x) { return 1.f / (1.f + __expf(-x)); }
__device__ __forceinline__ float log_sigmoid(float x) { return fminf(x, 0.f) - log1pf(__expf(-fabsf(x))); }

#define XB_TMO      128
#define XB_XCNT(j)  (256  + 64 * (j))
#define XB_XSUB(j)  (1280 + 64 * (j))
#define XB_XGEN(j)  (2304 + 64 * (j))
#define XB_TOP      3328
#define XB_TOPGEN   3392
#define XCD_BAR_WORDS 3456
#define XB_SPIN_CAP (1u << 18)

__device__ __forceinline__ unsigned xb_ld(unsigned* p)              { return __hip_atomic_load(p, __ATOMIC_RELAXED, __HIP_MEMORY_SCOPE_AGENT); }
__device__ __forceinline__ unsigned xb_add(unsigned* p, unsigned v) { return __hip_atomic_fetch_add(p, v, __ATOMIC_RELAXED, __HIP_MEMORY_SCOPE_AGENT); }
__device__ __forceinline__ unsigned xb_xcc_id() { return (unsigned)__builtin_amdgcn_s_getreg((3 << 11) | 20) & 0xFu; }
#define XB_SPIN(cond, bar) do { unsigned _sp = 0; while (cond) { __builtin_amdgcn_s_sleep(1); \
    if ((++_sp & 255u) == 0u) { if (xb_ld(&(bar)[XB_TMO])) break; if (_sp > XB_SPIN_CAP) { atomicAdd(&(bar)[XB_TMO], 1u); break; } } } } while (0)

struct XcdBarrier {
    unsigned* bar; unsigned x;
    volatile LAS unsigned* st;
};

__device__ __forceinline__ XcdBarrier xcd_barrier_post(unsigned* bar, volatile LAS unsigned* st) {
    XcdBarrier b; b.bar = bar; b.x = xb_xcc_id(); b.st = st;
    if (threadIdx.x == 0) (void)xb_add(&bar[XB_XCNT(b.x)], 1u);
    return b;
}
__device__ __forceinline__ void xcd_barrier_complete(unsigned* bar, unsigned x, unsigned& nloc, unsigned& nx) {
    const unsigned G = gridDim.x * gridDim.y * gridDim.z;
    unsigned sum, cnt, mine, sp = 0u;
    for (;;) {
        sum = 0u; cnt = 0u; mine = 0u;
#pragma unroll
        for (unsigned j = 0; j < 16; ++j) { const unsigned c = xb_ld(&bar[XB_XCNT(j)]); sum += c; cnt += (c > 0u) ? 1u : 0u; mine = (j == x) ? c : mine; }
        if (sum == G) break;
        __builtin_amdgcn_s_sleep(1);
        if ((++sp & 255u) == 0u) { if (xb_ld(&bar[XB_TMO])) break; if (sp > XB_SPIN_CAP) { atomicAdd(&bar[XB_TMO], 1u); break; } }
    }
    nloc = mine > 0u ? mine : 1u; nx = cnt > 0u ? cnt : 1u;
}

__device__ __forceinline__ void xcd_barrier(const XcdBarrier& b) {
    asm volatile("s_waitcnt vmcnt(0)" ::: "memory");
    __syncthreads();
    if (threadIdx.x == 0) {
        unsigned* bar = b.bar;
        __builtin_amdgcn_s_waitcnt(0);
        unsigned nloc = b.st[0], nx = b.st[1];
        if (nloc == 0u) { xcd_barrier_complete(bar, b.x, nloc, nx); b.st[0] = nloc; b.st[1] = nx; }
        const unsigned old = xb_add(&bar[XB_XSUB(b.x)], 1u);
        const unsigned gen = old / nloc;
        if (old + 1u == (gen + 1u) * nloc) {
            __builtin_amdgcn_fence(__ATOMIC_RELEASE, "agent");
            asm volatile("s_waitcnt vmcnt(0)" ::: "memory");
            const unsigned og = xb_add(&bar[XB_TOP], 1u);
            const unsigned tg = og / nx;
            if (og + 1u == (tg + 1u) * nx) xb_add(&bar[XB_TOPGEN], 1u);
            else XB_SPIN(xb_ld(&bar[XB_TOPGEN]) == tg, bar);
            __builtin_amdgcn_fence(__ATOMIC_ACQUIRE, "agent");
            xb_add(&bar[XB_XGEN(b.x)], 1u);
            asm volatile("s_waitcnt vmcnt(0)" ::: "memory");
        } else {
            XB_SPIN(xb_ld(&bar[XB_XGEN(b.x)]) == gen, bar);
            __builtin_amdgcn_fence(__ATOMIC_ACQUIRE, "agent");
            asm volatile("s_waitcnt vmcnt(0)" ::: "memory");
        }
    }
    __syncthreads();
}
struct Frame {
    LAS unsigned char* lds;
    volatile LAS unsigned* MISC;
    gu32* ctl;
    int tid, lane, wave;
    int vcu, G;
    const float *x_p, *x_s, *st_conv, *st_C, *st_n, *st_m, *g1, *w_in, *b_i, *b_f, *conv_w, *conv_g, *ml_g, *w_out, *g2, *wg, *wu, *wd, *fg;
    float* out;
    bf16 *W1, *W2, *W3, *W4, *XN, *YC, *Z, *HB, *X1b;
    float *gates, *ssq1, *ssq2;
};

__device__ __forceinline__ void p0_transpose_item(const float* W, int ldw, int K, int nblk, bf16* WT, int mode, const float* kgain, LAS float* scr, int item, int lane) {
    const int kb = item / nblk, nb = item % nblk, k0 = 64 * kb, n0 = 32 * nb;
#pragma unroll 8
    for (int i = 0; i < 32; ++i) { const int kk = 2 * i + (lane >> 5); const float g = kgain ? kgain[k0 + kk] : 1.f; scr[kk * 33 + (lane & 31)] = W[(size_t)(k0 + kk) * ldw + n0 + (lane & 31)] * g; }
    LDS_WAIT(); asm volatile("" ::: "memory");
    const int c = lane & 7;
#pragma unroll
    for (int j = 0; j < 4; ++j) { const int n = (lane >> 3) + 8 * j; const LAS float* s = scr + (8 * c) * 33 + n;
        v4u o; o.x = pk2(s[0 * 33], s[1 * 33]); o.y = pk2(s[2 * 33], s[3 * 33]); o.z = pk2(s[4 * 33], s[5 * 33]); o.w = pk2(s[6 * 33], s[7 * 33]);
        const int jn = n0 + n; int drow = jn; if (mode == 1) drow = 256 * (jn >> 7) + (jn & 127); if (mode == 2) drow = 256 * (jn >> 7) + 128 + (jn & 127);
        *(GAS v4u*)(WT + (size_t)drow * K + k0 + 8 * c) = o; }
    LDS_WAIT(); asm volatile("" ::: "memory");
}
__device__ __forceinline__ void p0_xrow(Frame& F, int m, const LAS float* gwl) {
    const float* xr = m < MP ? F.x_p + (size_t)m * D : F.x_s + (size_t)(m - MP) * D;
    const int lane = F.lane;
    f32x4 v[8]; float s = 0.f;
#pragma unroll
    for (int j = 0; j < 8; ++j) { v[j] = *(const GAS f32x4*)(xr + 256 * j + 4 * lane); s += (v[j].x * v[j].x + v[j].y * v[j].y) + (v[j].z * v[j].z + v[j].w * v[j].w); }
    const float r = rsqrtf(wave_sum(s) * (1.f / D) + EPS);
    float ga[8] = {0.f, 0.f, 0.f, 0.f, 0.f, 0.f, 0.f, 0.f};
#pragma unroll
    for (int j = 0; j < 8; ++j) {
        const int k = 256 * j + 4 * lane;
        const f32x4 gg = *(const GAS f32x4*)(F.g1 + k);
        const f32x4 xn = v[j] * r * gg;
        *(GAS unsigned long long*)(F.XN + (size_t)m * D + k) = (unsigned long long)pk2(xn.x, xn.y) | ((unsigned long long)pk2(xn.z, xn.w) << 32);
#pragma unroll
        for (int q = 0; q < 8; ++q) { const f32x4 w = *(const LAS f32x4*)(gwl + q * D + k); ga[q] += (xn.x * w.x + xn.y * w.y) + (xn.z * w.z + xn.w * w.w); }
    }
#pragma unroll
    for (int q = 0; q < 8; ++q) ga[q] = wave_sum(ga[q]);
    if (lane == 0) {
#pragma unroll
        for (int h = 0; h < 4; ++h) { F.gates[(size_t)m * 8 + h] = ga[h] + F.b_i[h]; F.gates[(size_t)m * 8 + 4 + h] = log_sigmoid(ga[4 + h] + F.b_f[h]); }
    }
}
__device__ __forceinline__ void p0_prologue(Frame& F) {
    LAS float* scr = (LAS float*)(F.lds + RING_OFF + F.wave * 16384);
    const int gw = F.vcu * NWAVES + F.wave, NGW = F.G * NWAVES;
    constexpr int I_1 = (D / 64) * (NZ / 32), I_2 = (D / 64) * (D / 32), I_3 = (D / 64) * (FF / 32), I_4 = (FF / 64) * (D / 32);
    constexpr int NITEMS = I_1 + I_2 + 2 * I_3 + I_4;
    for (int it = gw; it < NITEMS; it += NGW) {
        int r = it;
        if (r < I_1) { p0_transpose_item(F.w_in, NIN, D, NZ / 32, F.W1, 0, nullptr, scr, r, F.lane); continue; } r -= I_1;
        if (r < I_2) { p0_transpose_item(F.w_out, D, D, D / 32, F.W2, 0, nullptr, scr, r, F.lane); continue; } r -= I_2;
        if (r < I_3) { p0_transpose_item(F.wg, FF, D, FF / 32, F.W3, 1, F.g2, scr, r, F.lane); continue; } r -= I_3;
        if (r < I_3) { p0_transpose_item(F.wu, FF, D, FF / 32, F.W3, 2, F.g2, scr, r, F.lane); continue; } r -= I_3;
        p0_transpose_item(F.wd, D, FF, D / 32, F.W4, 0, nullptr, scr, r, F.lane);
    }
    __syncthreads();
    LAS float* gwl = (LAS float*)(F.lds + RING_OFF);
    for (int k = F.tid; k < D; k += NWAVES * 64) {
        const f32x4 a = *(const GAS f32x4*)(F.w_in + (size_t)k * NIN + NZ), b = *(const GAS f32x4*)(F.w_in + (size_t)k * NIN + NZ + 4);
        gwl[0 * D + k] = a.x; gwl[1 * D + k] = a.y; gwl[2 * D + k] = a.z; gwl[3 * D + k] = a.w; gwl[4 * D + k] = b.x; gwl[5 * D + k] = b.y; gwl[6 * D + k] = b.z; gwl[7 * D + k] = b.w;
    }
    __syncthreads();
    for (int m = gw; m < M; m += NGW) { asm volatile("" ::: "memory"); p0_xrow(F, m, gwl); }
    __syncthreads();
}
__device__ __forceinline__ void final_norm_phase(Frame& F) {
    const int gw = F.vcu * NWAVES + F.wave, NGW = F.G * NWAVES;
    for (int m = gw; m < M; m += NGW) {
        const float r = rsqrtf(F.ssq2[m] * (1.f / D) + EPS);
#pragma unroll
        for (int j = 0; j < 8; ++j) { GAS f32x4* p = (GAS f32x4*)(F.out + (size_t)m * D + 256 * j + 4 * F.lane); const f32x4 g = *(const GAS f32x4*)(F.fg + 256 * j + 4 * F.lane); *p = *p * r * g; }
    }
}
__device__ __forceinline__ void unpack8(const v4u w, float (&f)[8]) {
    f[0] = bf2f(w.x & 0xffffu); f[1] = bf2f(w.x >> 16); f[2] = bf2f(w.y & 0xffffu); f[3] = bf2f(w.y >> 16);
    f[4] = bf2f(w.z & 0xffffu); f[5] = bf2f(w.z >> 16); f[6] = bf2f(w.w & 0xffffu); f[7] = bf2f(w.w >> 16);
}
__device__ __forceinline__ void conv_item(Frame& F, int item) {
    const bool prompt = item < 1024;
    const int b = prompt ? (item >> 8) : (item - 1024);
    const int row0 = prompt ? 8 * item : MP + 8 * (item - 1024);
    const int t0 = prompt ? 8 * (item & 255) : 0;
    const bool last_item = prompt ? ((item & 255) == 255) : true;
    const int lane = F.lane;
    float w0[16], w1[16], w2[16], cg_[16], up2[16], up1[16];
#pragma unroll
    for (int p = 0; p < 2; ++p) {
        const int c0 = 8 * lane + 512 * p;
#pragma unroll
        for (int q = 0; q < 2; ++q) {
            const f32x4 a = *(const GAS f32x4*)(F.conv_w + c0 + 4 * q), bb = *(const GAS f32x4*)(F.conv_w + DC + c0 + 4 * q), c = *(const GAS f32x4*)(F.conv_w + 2 * DC + c0 + 4 * q), g = *(const GAS f32x4*)(F.conv_g + c0 + 4 * q);
#pragma unroll
            for (int i = 0; i < 4; ++i) { w0[8 * p + 4 * q + i] = a[i]; w1[8 * p + 4 * q + i] = bb[i]; w2[8 * p + 4 * q + i] = c[i]; cg_[8 * p + 4 * q + i] = g[i]; }
        }
    }
    if (prompt) {
        if (t0 == 0) {
#pragma unroll
            for (int i = 0; i < 16; ++i) { up2[i] = 0.f; up1[i] = 0.f; }
        } else {
#pragma unroll
            for (int p = 0; p < 2; ++p) {
                const int c0 = 8 * lane + 512 * p; float a[8], x[8];
                const bf16* z2 = F.Z + (size_t)(row0 - 2) * NZ; const bf16* z1 = F.Z + (size_t)(row0 - 1) * NZ;
                unpack8(*(const GAS v4u*)(z2 + ZC_CG + c0), a); unpack8(*(const GAS v4u*)(z2 + ZC_XT + c0), x);
#pragma unroll
                for (int i = 0; i < 8; ++i) up2[8 * p + i] = a[i] * x[i];
                unpack8(*(const GAS v4u*)(z1 + ZC_CG + c0), a); unpack8(*(const GAS v4u*)(z1 + ZC_XT + c0), x);
#pragma unroll
                for (int i = 0; i < 8; ++i) up1[8 * p + i] = a[i] * x[i];
            }
        }
    } else {
#pragma unroll
        for (int p = 0; p < 2; ++p) {
            const int c0 = 8 * lane + 512 * p;
#pragma unroll
            for (int q = 0; q < 2; ++q) {
                const f32x4 a = *(const GAS f32x4*)(F.st_conv + ((size_t)b * 2 + 0) * DC + c0 + 4 * q), bb = *(const GAS f32x4*)(F.st_conv + ((size_t)b * 2 + 1) * DC + c0 + 4 * q);
#pragma unroll
                for (int i = 0; i < 4; ++i) { up2[8 * p + 4 * q + i] = a[i]; up1[8 * p + 4 * q + i] = bb[i]; }
            }
        }
    }
#pragma unroll 1
    for (int r = 0; r < 8; ++r) {
        const int row = row0 + r; const bf16* zr = F.Z + (size_t)row * NZ;
        float tt[16]; float ss = 0.f;
#pragma unroll
        for (int p = 0; p < 2; ++p) {
            const int c0 = 8 * lane + 512 * p; float a[8], x[8], g[8];
            unpack8(*(const GAS v4u*)(zr + ZC_CG + c0), a); unpack8(*(const GAS v4u*)(zr + ZC_XT + c0), x); unpack8(*(const GAS v4u*)(zr + ZC_BG + c0), g);
#pragma unroll
            for (int i = 0; i < 8; ++i) { const int ci = 8 * p + i; const float u = a[i] * x[i];
                const float cv = w0[ci] * up2[ci] + w1[ci] * up1[ci] + w2[ci] * u; tt[ci] = g[i] * cv; ss += tt[ci] * tt[ci]; up2[ci] = up1[ci]; up1[ci] = u; }
        }
        const float rr = rsqrtf(wave_sum(ss) * (1.f / DC) + EPS);
#pragma unroll
        for (int p = 0; p < 2; ++p) {
            const int c0 = 8 * lane + 512 * p; v4u o;
            o.x = pk2(tt[8 * p + 0] * rr * cg_[8 * p + 0], tt[8 * p + 1] * rr * cg_[8 * p + 1]); o.y = pk2(tt[8 * p + 2] * rr * cg_[8 * p + 2], tt[8 * p + 3] * rr * cg_[8 * p + 3]);
            o.z = pk2(tt[8 * p + 4] * rr * cg_[8 * p + 4], tt[8 * p + 5] * rr * cg_[8 * p + 5]); o.w = pk2(tt[8 * p + 6] * rr * cg_[8 * p + 6], tt[8 * p + 7] * rr * cg_[8 * p + 7]);
            *(GAS v4u*)(F.YC + (size_t)row * D + c0) = o;
        }
        if (last_item && r >= 6) {
            float* o = F.out + (prompt ? O_PCONV : O_SCONV) + ((size_t)b * 2 + (r - 6)) * DC;
#pragma unroll
            for (int p = 0; p < 2; ++p) { const int c0 = 8 * lane + 512 * p;
                *(GAS f32x4*)(o + c0) = (f32x4){up1[8 * p + 0], up1[8 * p + 1], up1[8 * p + 2], up1[8 * p + 3]}; *(GAS f32x4*)(o + c0 + 4) = (f32x4){up1[8 * p + 4], up1[8 * p + 5], up1[8 * p + 6], up1[8 * p + 7]}; }
        }
    }
}

__device__ __forceinline__ void sample_item(Frame& F, int item) {
    LAS float* L = (LAS float*)(F.lds + RING_OFF);
    LAS float* qT = L; LAS float* kT = L + 1024; LAS float* kwT = L + 2048; LAS float* vS = L + 3072; LAS float* accx = L + 5120; LAS float* Sm = L + 7168;
    LAS float* ai = L + 7232; LAS float* dd = L + 7240; LAS float* wk = L + 7248; LAS float* misc = L + 7256; LAS float* n0s = L + 7264; LAS float* red = L + 7392; LAS float* lis = L + 7424; LAS float* lfs = L + 7432;
    const int tid = F.tid, b = item >> 2, h = item & 3, row0 = MP + 8 * b;
    __syncthreads();
    for (int i = tid; i < 1024; i += NWAVES * 64) { const int t = i >> 7, d = i & 127; const bf16* zr = F.Z + (size_t)(row0 + t) * NZ;
        qT[d * 8 + t] = bf2f(zr[ZC_Q + h * DK + d]) * QSCALE; kT[d * 8 + t] = bf2f(zr[ZC_K + h * DK + d]); }
    for (int i = tid; i < 2048; i += NWAVES * 64) { const int t = i >> 8, e = i & 255; vS[t * 256 + e] = bf2f(F.Z[(size_t)(row0 + t) * NZ + ZC_V + h * DV + e]); }
    if (tid < 8) { lis[tid] = F.gates[(size_t)(row0 + tid) * 8 + h]; lfs[tid] = F.gates[(size_t)(row0 + tid) * 8 + 4 + h]; }
    if (tid < DK) n0s[tid] = F.st_n[(size_t)(b * NH + h) * DK + tid];
    __syncthreads();
    if (F.wave == 0) {
        const int lane = F.lane, t = lane >> 3, s = lane & 7;
        const float m0 = F.st_m[b * NH + h];
        float bc[8]; { float run = 0.f;
#pragma unroll
            for (int i = 0; i < 8; ++i) { run += lfs[i]; bc[i] = run; } }
        float bt = 0.f, bs = 0.f;
#pragma unroll
        for (int i = 0; i < 8; ++i) { bt = (i == t) ? bc[i] : bt; bs = (i == s) ? bc[i] : bs; }
        const float lis_s = lis[s];
        const float dm = (s <= t) ? (bt - bs + lis_s) : -INFINITY;
        float mx = dm; mx = fmaxf(mx, __shfl_xor(mx, 1)); mx = fmaxf(mx, __shfl_xor(mx, 2)); mx = fmaxf(mx, __shfl_xor(mx, 4));
        const float mt = fmaxf(bt + m0, mx);
        const float w = (s <= t) ? __expf(dm - mt) : 0.f;
        const float a_i = __expf(bt + m0 - mt);
        float dot = 0.f, qn = 0.f;
        for (int d = 0; d < DK; ++d) { const float qv = qT[d * 8 + t]; dot += qv * kT[d * 8 + s]; qn += qv * n0s[d]; }
        const float sv = dot * w;
        float rs = sv; rs += __shfl_xor(rs, 1); rs += __shfl_xor(rs, 2); rs += __shfl_xor(rs, 4);
        const float den = a_i * qn + rs;
        Sm[t * 8 + s] = sv;
        const float bL = bc[7];
        const float gs = bL - bs + lis_s;
        float gm = gs; gm = fmaxf(gm, __shfl_xor(gm, 1)); gm = fmaxf(gm, __shfl_xor(gm, 2)); gm = fmaxf(gm, __shfl_xor(gm, 4));
        const float mnew = fmaxf(bL + m0, gm);
        if (s == 0) { ai[t] = a_i; dd[t] = 1.f / fmaxf(fabsf(den), __expf(-mt)); }
        if (t == 0) wk[s] = __expf(gs - mnew);
        if (lane == 0) { misc[0] = __expf(bL + m0 - mnew); misc[1] = mnew; }
    }
    __syncthreads();
    const float sc = misc[0];
    for (int i = tid; i < 1024; i += NWAVES * 64) kwT[i] = kT[i] * wk[i & 7];
    __syncthreads();
    if (tid < DK) { float nn = sc * n0s[tid];
#pragma unroll
        for (int s = 0; s < 8; ++s) nn += kwT[tid * 8 + s];
        F.out[O_SN + (size_t)(b * NH + h) * DK + tid] = nn; }
    if (tid == 0) F.out[O_SM + b * NH + h] = misc[1];
    const int e = tid & 255, half = tid >> 8;
    float vv[8], acc[8];
#pragma unroll
    for (int s = 0; s < 8; ++s) { vv[s] = vS[s * 256 + e]; acc[s] = 0.f; }
    const float* c0p = F.st_C + ((size_t)(b * NH + h) * DK + 64 * half) * DV + e;
    float* c1p = F.out + O_SC + ((size_t)(b * NH + h) * DK + 64 * half) * DV + e;
#pragma unroll 1
    for (int d0 = 0; d0 < 64; d0 += 8) {
        float c[8];
#pragma unroll
        for (int j = 0; j < 8; ++j) c[j] = *(const GAS float*)(c0p + (size_t)(d0 + j) * DV);
#pragma unroll
        for (int j = 0; j < 8; ++j) {
            const int d = 64 * half + d0 + j;
            const f32x4 q0 = *(const LAS f32x4*)(qT + d * 8), q1 = *(const LAS f32x4*)(qT + d * 8 + 4), k0 = *(const LAS f32x4*)(kwT + d * 8), k1 = *(const LAS f32x4*)(kwT + d * 8 + 4);
            float cn = sc * c[j];
#pragma unroll
            for (int s = 0; s < 4; ++s) { acc[s] += q0[s] * c[j]; acc[4 + s] += q1[s] * c[j]; cn += k0[s] * vv[s]; cn += k1[s] * vv[4 + s]; }
            *(GAS float*)(c1p + (size_t)(d0 + j) * DV) = cn;
        }
    }
    if (half == 1) {
#pragma unroll
        for (int t = 0; t < 8; ++t) accx[t * 256 + e] = acc[t]; }
    __syncthreads();
    float hv[8];
    if (half == 0) {
#pragma unroll
        for (int t = 0; t < 8; ++t) { float num = ai[t] * (acc[t] + accx[t * 256 + e]);
#pragma unroll
            for (int s = 0; s < 8; ++s) num += Sm[t * 8 + s] * vv[s];
            hv[t] = num * dd[t]; const float p = wave_sum(hv[t] * hv[t]); if (F.lane == 0) red[F.wave * 8 + t] = p; }
    }
    __syncthreads();
    if (half == 0) {
        const float gml = F.ml_g[h * DV + e];
#pragma unroll
        for (int t = 0; t < 8; ++t) { const float rr = rsqrtf((red[t] + red[8 + t] + red[16 + t] + red[24 + t]) * (1.f / DV) + EPS);
            const float o = bf2f(F.Z[(size_t)(row0 + t) * NZ + ZC_O + h * DV + e]);
            F.YC[(size_t)(row0 + t) * D + DC + h * DV + e] = (bf16)f2bf(sigmoidf_(o) * hv[t] * rr * gml); }
    }
}

typedef short s16x4 __attribute__((ext_vector_type(4)));
typedef float f32x16 __attribute__((ext_vector_type(16)));
#define MFMA32(a, b, c) __builtin_amdgcn_mfma_f32_32x32x16_bf16((a), (b), (c), 0, 0, 0)
__device__ __forceinline__ unsigned tr_addr(unsigned base, int P, int rbase, int C0, int lane) {
    const int h = lane >> 5, blk = (lane >> 4) & 1, q = (lane & 15) >> 2, p = lane & 3;
    return base + (unsigned)((rbase + 8 * h + q) * P + (C0 + 16 * blk + 4 * p) * 2);
}
__device__ __forceinline__ void tr_frag_pair(unsigned a0, unsigned a1, unsigned b0, unsigned b1, bf16x8& A, bf16x8& B) {
    s16x4 x0, x1, y0, y1;
    asm volatile("ds_read_b64_tr_b16 %0, %4\n\tds_read_b64_tr_b16 %1, %5\n\tds_read_b64_tr_b16 %2, %6\n\tds_read_b64_tr_b16 %3, %7\n\ts_waitcnt lgkmcnt(0)"
                 : "=&v"(x0), "=&v"(x1), "=&v"(y0), "=&v"(y1) : "v"(a0), "v"(a1), "v"(b0), "v"(b1) : "memory");
    A = __builtin_shufflevector(x0, x1, 0, 1, 2, 3, 4, 5, 6, 7); B = __builtin_shufflevector(y0, y1, 0, 1, 2, 3, 4, 5, 6, 7);
}
__device__ __forceinline__ bf16x8 tr_frag(unsigned a0, unsigned a1) {
    s16x4 x0, x1;
    asm volatile("ds_read_b64_tr_b16 %0, %2\n\tds_read_b64_tr_b16 %1, %3\n\ts_waitcnt lgkmcnt(0)" : "=&v"(x0), "=&v"(x1) : "v"(a0), "v"(a1) : "memory");
    return __builtin_shufflevector(x0, x1, 0, 1, 2, 3, 4, 5, 6, 7);
}
__device__ __forceinline__ int crow(int reg, int h) { return (reg & 3) + 8 * (reg >> 2) + 4 * h; }

constexpr int SC_PK = 320, SC_PV = 192;
constexpr int SC_KIMG = 0, SC_VIMG = 2 * 64 * SC_PK, SC_WK = SC_VIMG + 2 * 64 * SC_PV, SC_SC = SC_WK + 2048 * 4, SC_BL = SC_SC + 32 * 4, SC_GM = SC_BL + 32 * 4, SC_MST = SC_GM + 32 * 4, SC_NV = SC_MST + 36 * 4, SC_END = SC_NV + 128 * 4;
constexpr size_t WS_CST = WS_C;
constexpr size_t WS_BCUM = WS_GATES + 1 * MiB;
constexpr size_t WS_MST = WS_BCUM + 256 * 1024;
constexpr size_t WS_NST = WS_MST + 64 * 1024;
__device__ __forceinline__ void scan_unit(Frame& F, int unit, unsigned char* ws) {
    const int bh = unit >> 2, es = unit & 3, b = bh >> 2, h = bh & 3, tid = F.tid, lane = F.lane, wave = F.wave;
    LAS unsigned char* L = F.lds + RING_OFF;
    LAS float* wkS = (LAS float*)(L + SC_WK); LAS float* scS = (LAS float*)(L + SC_SC); LAS float* bLS = (LAS float*)(L + SC_BL); LAS float* gmS = (LAS float*)(L + SC_GM); LAS float* mstS = (LAS float*)(L + SC_MST); LAS float* nvS = (LAS float*)(L + SC_NV);
    float* bcumG = (float*)(ws + WS_BCUM) + (size_t)bh * 2048; float* mstG = (float*)(ws + WS_MST) + (size_t)bh * 64; float* nstG = (float*)(ws + WS_NST) + (size_t)bh * 32 * 128;
    bf16* cstG = (bf16*)(ws + WS_CST) + (size_t)bh * 32 * 256 * 128;
    const size_t rowb = (size_t)b * SEQ;
    __syncthreads();
    for (int cc = 0; cc < 4; ++cc) {
        const int c = 4 * wave + cc; const size_t row = rowb + 64 * c + lane;
        const float li = F.gates[row * 8 + h], lf = F.gates[row * 8 + 4 + h];
        float bsum = lf;
#pragma unroll
        for (int o = 1; o < 64; o <<= 1) { const float t = __shfl_up(bsum, o); if (lane >= o) bsum += t; }
        const float bL = __shfl(bsum, 63);
        const float g = bL - bsum + li;
        float gm = g;
#pragma unroll
        for (int o = 1; o < 64; o <<= 1) gm = fmaxf(gm, __shfl_xor(gm, o));
        wkS[64 * c + lane] = g;
        if (es == 0) bcumG[64 * c + lane] = bsum;
        if (lane == 0) { bLS[c] = bL; gmS[c] = gm; }
    }
    __syncthreads();
    if (tid == 0) { float m = 0.f; mstS[0] = 0.f;
        for (int c = 0; c < 32; ++c) { const float mn = fmaxf(bLS[c] + m, gmS[c]); scS[c] = __expf(bLS[c] + m - mn); m = mn; mstS[c + 1] = mn; } }
    __syncthreads();
    for (int i = tid; i < 2048; i += NWAVES * 64) wkS[i] = __expf(wkS[i] - mstS[(i >> 6) + 1]);
    if (es == 0 && tid < 33) mstG[tid] = mstS[tid];
    if (tid < 128) nvS[tid] = 0.f;
    const int dt = wave & 3, et = wave >> 2, hh = lane >> 5;
    f32x16 acc;
#pragma unroll
    for (int i = 0; i < 16; ++i) acc[i] = 0.f;
    const int kr0 = tid >> 4, kc0 = tid & 15;
    const int vr = tid >> 3, vc = tid & 7;
    const bf16* zk = F.Z + rowb * NZ + ZC_K + h * DK; const bf16* zv = F.Z + rowb * NZ + ZC_V + h * DV + 64 * es;
    v4u rk0, rk1, rv;
#define SC_LOAD(c) do { rk0 = *(const GAS v4u*)(zk + (size_t)(64 * (c) + kr0) * NZ + 8 * kc0); rk1 = *(const GAS v4u*)(zk + (size_t)(64 * (c) + kr0 + 32) * NZ + 8 * kc0); \
                        rv = *(const GAS v4u*)(zv + (size_t)(64 * (c) + vr) * NZ + 8 * vc); } while (0)
#define SC_WRITE(c) do { LAS unsigned char* kb = L + SC_KIMG + ((c) & 1) * 64 * SC_PK; LAS unsigned char* vb = L + SC_VIMG + ((c) & 1) * 64 * SC_PV; \
                         *(LAS v4u*)(kb + kr0 * SC_PK + 16 * kc0) = rk0; *(LAS v4u*)(kb + (kr0 + 32) * SC_PK + 16 * kc0) = rk1; \
                         float vf[8]; unpack8(rv, vf); const float w_ = wkS[64 * (c) + vr]; v4u o_; o_.x = pk2(vf[0] * w_, vf[1] * w_); o_.y = pk2(vf[2] * w_, vf[3] * w_); o_.z = pk2(vf[4] * w_, vf[5] * w_); o_.w = pk2(vf[6] * w_, vf[7] * w_); \
                         *(LAS v4u*)(vb + vr * SC_PV + 16 * vc) = o_; } while (0)
    SC_LOAD(0);
    __syncthreads();
    SC_WRITE(0);
    const unsigned lbase = (unsigned)(size_t)L;
#pragma unroll 1
    for (int c = 0; c < 32; ++c) {
        if (c + 1 < 32) SC_LOAD(c + 1);
        __syncthreads();
        { bf16* dst = cstG + ((size_t)c * 256 + 64 * es + 32 * et + (lane & 31)) * 128 + 32 * dt + 4 * hh;
#pragma unroll
          for (int g = 0; g < 4; ++g) *(GAS unsigned long long*)(dst + 8 * g) = (unsigned long long)pk2(acc[4 * g], acc[4 * g + 1]) | ((unsigned long long)pk2(acc[4 * g + 2], acc[4 * g + 3]) << 32); }
        const float sc = scS[c];
#pragma unroll
        for (int i = 0; i < 16; ++i) acc[i] *= sc;
        const unsigned kimg = lbase + SC_KIMG + (c & 1) * 64 * SC_PK, vimg = lbase + SC_VIMG + (c & 1) * 64 * SC_PV;
#pragma unroll
        for (int ks = 0; ks < 4; ++ks) {
            bf16x8 A, B;
            tr_frag_pair(tr_addr(kimg, SC_PK, 16 * ks, 32 * dt, lane), tr_addr(kimg, SC_PK, 16 * ks + 4, 32 * dt, lane),
                         tr_addr(vimg, SC_PV, 16 * ks, 32 * et, lane), tr_addr(vimg, SC_PV, 16 * ks + 4, 32 * et, lane), A, B);
            acc = MFMA32(A, B, acc);
        }
        if (es == 0 && tid < 128) {
            float nn = nvS[tid]; nstG[c * 128 + tid] = nn; nn *= sc;
            const LAS unsigned short* kcol = (const LAS unsigned short*)(L + SC_KIMG + (c & 1) * 64 * SC_PK) + tid;
#pragma unroll 8
            for (int s = 0; s < 64; ++s) nn += wkS[64 * c + s] * bf2f(kcol[s * (SC_PK / 2)]);
            nvS[tid] = nn;
        }
        if (c + 1 < 32) SC_WRITE(c + 1);
    }
#undef SC_LOAD
#undef SC_WRITE
    { float* dst = F.out + O_PC + ((size_t)bh * 128 + 32 * dt) * 256 + 64 * es + 32 * et + (lane & 31);
#pragma unroll
      for (int i = 0; i < 16; ++i) dst[(size_t)crow(i, hh) * 256] = acc[i]; }
    if (es == 0 && tid < 128) F.out[O_PN + (size_t)bh * 128 + tid] = nvS[tid];
    if (es == 0 && tid == 0) F.out[O_PM + bh] = mstS[32];
    __syncthreads();
}
constexpr int P3_PQ = 272, P3_PKK = 272, P3_PV = 576, P3_PP = 144, P3_PH = 1040;
constexpr int P3_Q = 0, P3_K = P3_Q + 64 * P3_PQ, P3_V = P3_K + 64 * P3_PKK, P3_P = P3_V + 64 * P3_PV, P3_H = 0;
constexpr int P3_SM = 81920;
static_assert(P3_P + 64 * P3_PP <= P3_SM && 64 * P3_PH <= P3_SM, "P3 LDS map");
__device__ __forceinline__ void p3_item(Frame& F, int item, unsigned char* ws) {
    const int bh = item >> 5, c = item & 31, b = bh >> 2, h = bh & 3, tid = F.tid, lane = F.lane, wave = F.wave, hh = lane >> 5, l31 = lane & 31;
    LAS unsigned char* L = F.lds + RING_OFF;
    LAS float* sm = (LAS float*)(L + P3_SM); LAS float* bmS = sm; LAS float* aS = sm + 64; LAS float* aiS = sm + 128; LAS float* ddS = sm + 192; LAS float* rsS = sm + 256; LAS float* qnS = sm + 320; LAS float* mtS = sm + 384; LAS float* nvS = sm + 448;
    const size_t row0 = (size_t)b * SEQ + 64 * c;
    const bf16* cst = (const bf16*)(ws + WS_CST) + ((size_t)bh * 32 + c) * 256 * 128;
    __syncthreads();
    { const bf16* zq = F.Z + row0 * NZ + ZC_Q + h * DK; const bf16* zk = F.Z + row0 * NZ + ZC_K + h * DK; const bf16* zv = F.Z + row0 * NZ + ZC_V + h * DV;
#pragma unroll
      for (int i = 0; i < 2; ++i) { const int r = (tid >> 4) + 32 * i, cc = tid & 15;
          *(LAS v4u*)(L + P3_Q + r * P3_PQ + 16 * cc) = *(const GAS v4u*)(zq + (size_t)r * NZ + 8 * cc); *(LAS v4u*)(L + P3_K + r * P3_PKK + 16 * cc) = *(const GAS v4u*)(zk + (size_t)r * NZ + 8 * cc); }
#pragma unroll
      for (int i = 0; i < 4; ++i) { const int r = (tid >> 5) + 16 * i, cc = tid & 31; *(LAS v4u*)(L + P3_V + r * P3_PV + 16 * cc) = *(const GAS v4u*)(zv + (size_t)r * NZ + 8 * cc); } }
    if (wave == 0) {
        const float mc = ((const float*)(ws + WS_MST))[(size_t)bh * 64 + c];
        const float bt = ((const float*)(ws + WS_BCUM))[(size_t)bh * 2048 + 64 * c + lane];
        const float li = F.gates[(row0 + lane) * 8 + h];
        const float a = li - bt; float pm = a;
#pragma unroll
        for (int o = 1; o < 64; o <<= 1) { const float t = __shfl_up(pm, o); if (lane >= o) pm = fmaxf(pm, t); }
        const float mt = bt + fmaxf(mc, pm);
        bmS[lane] = bt - mt; aS[lane] = a; aiS[lane] = __expf(bt + mc - mt); mtS[lane] = mt; rsS[lane] = 0.f;
    }
    if (wave == 1) { const float* np = (const float*)(ws + WS_NST) + ((size_t)bh * 32 + c) * 128; nvS[lane] = np[lane]; nvS[64 + lane] = np[64 + lane]; }
    bf16x8 Cf[8];
    { const bf16* cp = cst + (size_t)(32 * wave + l31) * 128 + 8 * hh;
#pragma unroll
      for (int kd = 0; kd < 8; ++kd) Cf[kd] = *(const GAS bf16x8*)(cp + 16 * kd); }
    __syncthreads();
    { const int t = tid >> 3, part = tid & 7; float s = 0.f;
      const LAS unsigned short* qr = (const LAS unsigned short*)(L + P3_Q + t * P3_PQ) + 16 * part;
#pragma unroll
      for (int j = 0; j < 16; ++j) s += bf2f(qr[j]) * nvS[16 * part + j];
      s += __shfl_xor(s, 1); s += __shfl_xor(s, 2); s += __shfl_xor(s, 4);
      if (part == 0) qnS[t] = s * QSCALE; }
    if (wave < 3) {
        const int si = wave == 2 ? 1 : 0, ti = wave == 0 ? 0 : 1;
        f32x16 x;
#pragma unroll
        for (int i = 0; i < 16; ++i) x[i] = 0.f;
#pragma unroll
        for (int kd = 0; kd < 8; ++kd) {
            const bf16x8 A = *(const LAS bf16x8*)(L + P3_K + (32 * si + l31) * P3_PKK + (16 * kd + 8 * hh) * 2);
            const bf16x8 B = *(const LAS bf16x8*)(L + P3_Q + (32 * ti + l31) * P3_PQ + (16 * kd + 8 * hh) * 2);
            x = MFMA32(A, B, x);
        }
        const int t = 32 * ti + l31; const float bm = bmS[t]; float rsum = 0.f;
#pragma unroll
        for (int g = 0; g < 4; ++g) {
            float p[4];
#pragma unroll
            for (int j = 0; j < 4; ++j) { const int s = 32 * si + 8 * g + 4 * hh + j; const float w = (s <= t) ? __expf(bm + aS[s]) : 0.f; p[j] = x[4 * g + j] * QSCALE * w; rsum += p[j]; }
            *(LAS unsigned long long*)(L + P3_P + t * P3_PP + (32 * si + 8 * g + 4 * hh) * 2) = (unsigned long long)pk2(p[0], p[1]) | ((unsigned long long)pk2(p[2], p[3]) << 32);
        }
        rsum += __shfl_xor(rsum, 32);
        if (hh == 0) atomicAdd((float*)(rsS + t), rsum);
    }
    __syncthreads();
    if (tid < 64) { const float den = aiS[tid] * qnS[tid] + rsS[tid]; ddS[tid] = 1.f / fmaxf(fabsf(den), __expf(-mtS[tid])); }
    bf16x8 Vf[4];
    { const unsigned vimg = (unsigned)(size_t)(L + P3_V);
#pragma unroll
      for (int ks = 0; ks < 4; ++ks) Vf[ks] = tr_frag(tr_addr(vimg, P3_PV, 16 * ks, 32 * wave, lane), tr_addr(vimg, P3_PV, 16 * ks + 4, 32 * wave, lane)); }
    f32x16 n1[2], n2[2];
#pragma unroll
    for (int ti = 0; ti < 2; ++ti) {
#pragma unroll
        for (int i = 0; i < 16; ++i) { n1[ti][i] = 0.f; n2[ti][i] = 0.f; }
#pragma unroll
        for (int kd = 0; kd < 8; ++kd) { const bf16x8 A = *(const LAS bf16x8*)(L + P3_Q + (32 * ti + l31) * P3_PQ + (16 * kd + 8 * hh) * 2); n1[ti] = MFMA32(A, Cf[kd], n1[ti]); }
#pragma unroll
        for (int ks = 0; ks < 2 * (ti + 1); ++ks) { const bf16x8 A = *(const LAS bf16x8*)(L + P3_P + (32 * ti + l31) * P3_PP + (16 * ks + 8 * hh) * 2); n2[ti] = MFMA32(A, Vf[ks], n2[ti]); }
    }
    __syncthreads();
#pragma unroll
    for (int ti = 0; ti < 2; ++ti)
#pragma unroll
        for (int i = 0; i < 16; ++i) { const int t = 32 * ti + crow(i, hh);
            *(LAS float*)(L + P3_H + t * P3_PH + (32 * wave + l31) * 4) = (aiS[t] * QSCALE * n1[ti][i] + n2[ti][i]) * ddS[t]; }
    __syncthreads();
    { const int t = tid >> 3, j = tid & 7; f32x4 hv4[8]; float s = 0.f;
#pragma unroll
      for (int q = 0; q < 8; ++q) { hv4[q] = *(const LAS f32x4*)(L + P3_H + t * P3_PH + (32 * j + 4 * q) * 4); s += (hv4[q].x * hv4[q].x + hv4[q].y * hv4[q].y) + (hv4[q].z * hv4[q].z + hv4[q].w * hv4[q].w); }
      s += __shfl_xor(s, 1); s += __shfl_xor(s, 2); s += __shfl_xor(s, 4);
      const float rr = rsqrtf(s * (1.f / DV) + EPS);
      const bf16* zo = F.Z + (row0 + t) * NZ + ZC_O + h * DV + 32 * j; const float* gp = F.ml_g + h * DV + 32 * j; bf16* yo = F.YC + (row0 + t) * D + DC + h * DV + 32 * j;
#pragma unroll
      for (int q = 0; q < 4; ++q) { float o[8]; unpack8(*(const GAS v4u*)(zo + 8 * q), o);
          const f32x4 g0 = *(const GAS f32x4*)(gp + 8 * q), g1 = *(const GAS f32x4*)(gp + 8 * q + 4); const f32x4 a = hv4[2 * q], bq = hv4[2 * q + 1];
          v4u w; w.x = pk2(sigmoidf_(o[0]) * a.x * rr * g0.x, sigmoidf_(o[1]) * a.y * rr * g0.y); w.y = pk2(sigmoidf_(o[2]) * a.z * rr * g0.z, sigmoidf_(o[3]) * a.w * rr * g0.w);
          w.z = pk2(sigmoidf_(o[4]) * bq.x * rr * g1.x, sigmoidf_(o[5]) * bq.y * rr * g1.y); w.w = pk2(sigmoidf_(o[6]) * bq.z * rr * g1.z, sigmoidf_(o[7]) * bq.w * rr * g1.w);
          *(GAS v4u*)(yo + 8 * q) = w; } }
}
__device__ __forceinline__ void p2_phase(Frame& F, unsigned char* ws) {
    if (F.vcu < 64) scan_unit(F, F.vcu, ws);
    for (int it = F.vcu; it < DB * NH; it += F.G) sample_item(F, it);
    const int gw = F.vcu * NWAVES + F.wave, NGW = F.G * NWAVES;
    for (int it = gw; it < 1152; it += NGW) conv_item(F, it);
    __syncthreads();
}
__device__ __forceinline__ void p3_phase(Frame& F, unsigned char* ws) {
    for (int it = F.vcu; it < 512; it += F.G) p3_item(F, it, ws);
    __syncthreads();
}
typedef unsigned short bf16_t;
__global__ void k_conv(const bf16_t* __restrict__ Z, const float* __restrict__ state_conv, const float* __restrict__ conv_w, const float* __restrict__ conv_g,
                       bf16_t* __restrict__ YC, float* __restrict__ dout) {
    __shared__ float red[4];
    const int m = blockIdx.x, tid = threadIdx.x;
    int b, t, S; const bool prompt = m < MP;
    if (prompt) { b = m / SEQ; t = m % SEQ; S = SEQ; } else { b = (m - MP) / DS; t = (m - MP) % DS; S = DS; }
    float tt[4]; float ss = 0.f;
#pragma unroll
    for (int i = 0; i < 4; ++i) {
        const int c = tid * 4 + i;
        float u[3];
#pragma unroll
        for (int j = 0; j < 3; ++j) {
            const int tp = t - 2 + j;
            if (tp >= 0) { const bf16_t* zr = Z + (size_t)(m - 2 + j) * NZ; u[j] = bf2f(zr[ZC_CG + c]) * bf2f(zr[ZC_XT + c]); }
            else u[j] = prompt ? 0.f : state_conv[((size_t)b * 2 + (tp + 2)) * DC + c];
        }
        const float cv = u[0] * conv_w[c] + u[1] * conv_w[DC + c] + u[2] * conv_w[2 * DC + c];
        tt[i] = bf2f(Z[(size_t)m * NZ + ZC_BG + c]) * cv; ss += tt[i] * tt[i];
        if (t >= S - 2) { float* o = dout + (prompt ? O_PCONV : O_SCONV) + ((size_t)b * 2 + (t - (S - 2))) * DC + c; *o = u[2]; }
    }
    ss = wave_sum(ss); if ((tid & 63) == 0) red[tid >> 6] = ss; __syncthreads();
    const float r = rsqrtf((red[0] + red[1] + red[2] + red[3]) * (1.f / DC) + EPS);
#pragma unroll
    for (int i = 0; i < 4; ++i) { const int c = tid * 4 + i; YC[(size_t)m * D + c] = (bf16_t)f2bf(tt[i] * r * conv_g[c]); }
}

__global__ void __launch_bounds__(256) k_mlstm_naive(const bf16_t* __restrict__ Z, const float* __restrict__ gates, const float* __restrict__ C0, const float* __restrict__ n0, const float* __restrict__ m0,
                              const float* __restrict__ ml_g, bf16_t* __restrict__ YC, float* __restrict__ dout) {
    __shared__ float qs[DK], ks[DK], ns[DK], red[8];
    const int e = threadIdx.x, h = blockIdx.x & 3, sb = blockIdx.x >> 2;
    const bool prompt = sb < NB; const int b = prompt ? sb : sb - NB; const int S = prompt ? SEQ : DS; const int row0 = prompt ? b * SEQ : MP + b * DS;
    float C[DK]; float mm;
    if (prompt) {
#pragma unroll
        for (int d = 0; d < DK; ++d) C[d] = 0.f;
        if (e < DK) ns[e] = 0.f; mm = 0.f;
    } else {
        const float* c0 = C0 + ((size_t)(b * NH + h) * DK) * DV + e;
#pragma unroll
        for (int d = 0; d < DK; ++d) C[d] = c0[(size_t)d * DV];
        if (e < DK) ns[e] = n0[(size_t)(b * NH + h) * DK + e]; mm = m0[b * NH + h];
    }
    const float gml = ml_g[h * DV + e];
    __syncthreads();
    for (int t = 0; t < S; ++t) {
        const size_t row = row0 + t; const bf16_t* zr = Z + row * NZ;
        const float li = gates[row * 8 + h], lf = gates[row * 8 + 4 + h];
        const float mn = fmaxf(lf + mm, li), fp = __expf(lf + mm - mn), ip = __expf(li - mn); mm = mn;
        if (e < DK) { qs[e] = bf2f(zr[ZC_Q + h * DK + e]) * QSCALE; ks[e] = bf2f(zr[ZC_K + h * DK + e]); }
        const float ve = bf2f(zr[ZC_V + h * DV + e]);
        __syncthreads();
        float acc = 0.f;
#pragma unroll
        for (int d = 0; d < DK; ++d) { C[d] = fp * C[d] + (ip * ks[d]) * ve; acc += qs[d] * C[d]; }
        float dp = 0.f;
        if (e < DK) { const float nn = fp * ns[e] + ip * ks[e]; ns[e] = nn; dp = qs[e] * nn; }
        dp = wave_sum(dp); float hs2;
        if ((e & 63) == 0) red[e >> 6] = dp;
        __syncthreads();
        const float den = red[0] + red[1];
        const float hv = acc / fmaxf(fabsf(den), __expf(-mn));
        hs2 = wave_sum(hv * hv);
        if ((e & 63) == 0) red[4 + (e >> 6)] = hs2;
        __syncthreads();
        const float rr = rsqrtf((red[4] + red[5] + red[6] + red[7]) * (1.f / DV) + EPS);
        const float o = bf2f(zr[ZC_O + h * DV + e]);
        YC[row * D + DC + h * DV + e] = (bf16_t)f2bf(sigmoidf_(o) * hv * rr * gml);
        __syncthreads();
    }
    float* oc = dout + (prompt ? O_PC : O_SC) + ((size_t)(b * NH + h) * DK) * DV + e;
#pragma unroll
    for (int d = 0; d < DK; ++d) oc[(size_t)d * DV] = C[d];
    if (e < DK) dout[(prompt ? O_PN : O_SN) + (size_t)(b * NH + h) * DK + e] = ns[e];
    if (e == 0) dout[(prompt ? O_PM : O_SM) + b * NH + h] = mm;
}

struct Args { const float* in[19]; float* out; unsigned char* ws; int ph_lo, ph_hi, li, pad; };
__global__ void __launch_bounds__(NWAVES * 64, 2) mk_fwd(Args args) {
    extern __shared__ __attribute__((aligned(16))) unsigned char lds[];
    Frame F;
    F.lds = (LAS unsigned char*)lds;
    F.MISC = (volatile LAS unsigned*)(F.lds + MISC_OFF);
    F.tid = threadIdx.x; F.lane = F.tid & 63; F.wave = __builtin_amdgcn_readfirstlane(F.tid >> 6);
    F.G = gridDim.x; { const int bx = blockIdx.x; F.vcu = (F.G % 8 == 0) ? (bx % 8) * (F.G / 8) + bx / 8 : bx; }
    unsigned char* ws = args.ws;
    F.ctl = (gu32*)(ws + WS_CTL);
    F.x_p = args.in[0]; F.x_s = args.in[1]; F.st_conv = args.in[2]; F.st_C = args.in[3]; F.st_n = args.in[4]; F.st_m = args.in[5];
    F.g1 = args.in[6]; F.w_in = args.in[7]; F.b_i = args.in[8]; F.b_f = args.in[9]; F.conv_w = args.in[10]; F.conv_g = args.in[11]; F.ml_g = args.in[12];
    F.w_out = args.in[13]; F.g2 = args.in[14]; F.wg = args.in[15]; F.wu = args.in[16]; F.wd = args.in[17]; F.fg = args.in[18]; F.out = args.out;
    F.W1 = (bf16*)(ws + WS_W1); F.W2 = (bf16*)(ws + WS_W2); F.W3 = (bf16*)(ws + WS_W3); F.W4 = (bf16*)(ws + WS_W4);
    F.XN = (bf16*)(ws + WS_A); F.YC = (bf16*)(ws + WS_A); F.Z = (bf16*)(ws + WS_B); F.HB = (bf16*)(ws + WS_B); F.X1b = (bf16*)(ws + WS_C);
    F.gates = (float*)(ws + WS_GATES); F.ssq1 = (float*)(ws + WS_CTL) + CW_SSQ1; F.ssq2 = (float*)(ws + WS_CTL) + CW_SSQ2;
    for (int u = F.tid; u < (LDS_BYTES - LDSCTL_OFF) / 4; u += NWAVES * 64) ((LAS unsigned*)(F.lds + LDSCTL_OFF))[u] = 0u;
    __syncthreads();
    XcdBarrier bar = xcd_barrier_post((unsigned*)(F.ctl + CW_BAR) + args.li * XCD_BAR_WORDS, F.MISC + 8);
    const int lo = args.ph_lo, hi = args.ph_hi;
#define IN(k) (lo <= (k) && (k) < hi)
#define SEAM(k) do { if (IN(k) && IN((k) + 1)) xcd_barrier(bar); } while (0)

    if (IN(0)) { p0_prologue(F); } SEAM(0);
    if (IN(1)) {
        pg8::Gemm g{F.XN, F.W1, M, NZ, D}; pg9::StaticOrder S; S.init(M, NZ, F.G, (int)blockIdx.x);
        pg9::EpiZ E{F.Z, NZ};
        pg9::gemm_phase<pg9::EpiZ>(F.lds + RING_OFF, g, S, E);
    } SEAM(1);
    if (IN(2)) { p2_phase(F, ws); } SEAM(2);
    if (IN(3)) { p3_phase(F, ws); } SEAM(3);
    if (IN(4)) {
        pg8::Gemm g{F.YC, F.W2, M, D, D}; pg9::StaticOrder S; S.init(M, D, F.G, (int)blockIdx.x);
        pg9::EpiRes E{F.x_p, F.x_s, MP, F.out, F.X1b, F.ssq1};
        pg9::gemm_phase<pg9::EpiRes>(F.lds + RING_OFF, g, S, E);
    } SEAM(4);
    if (IN(5)) {
        pg8::Gemm g{F.X1b, F.W3, M, N3, D}; pg9::StaticOrder S; S.init(M, N3, F.G, (int)blockIdx.x);
        pg9::EpiH E{F.HB, F.ssq1};
        pg9::gemm_phase<pg9::EpiH>(F.lds + RING_OFF, g, S, E);
    } SEAM(5);
    if (IN(6)) {
        pg8::Gemm g{F.HB, F.W4, M, D, FF}; pg9::StaticOrder S; S.init(M, D, F.G, (int)blockIdx.x);
        pg9::EpiRes E{F.out, F.out, M, F.out, nullptr, F.ssq2};
        pg9::gemm_phase<pg9::EpiRes>(F.lds + RING_OFF, g, S, E);
    } SEAM(6);
    if (IN(7)) { final_norm_phase(F); }
#undef IN
#undef SEAM
}

extern "C" void kernel_launch(void* const* d_in, const int* in_sizes, int n_in, void* d_out, int out_size, void* d_ws, size_t ws_size, hipStream_t stream) {
    static int grid = 0;
    if (grid == 0) {
        if (n_in != 19 || (size_t)out_size != O_END || ws_size < WS_END) { fprintf(stderr, "kernel_launch: unexpected shapes: n_in %d out %d ws %zu; nothing launched\n", n_in, out_size, ws_size); grid = -1; return; }
        int dev = 0, cus = 0;
        if (hipGetDevice(&dev) != hipSuccess || hipDeviceGetAttribute(&cus, hipDeviceAttributeMultiprocessorCount, dev) != hipSuccess) { grid = -1; return; }
        if (hipFuncSetAttribute((const void*)mk_fwd, hipFuncAttributeMaxDynamicSharedMemorySize, LDS_BYTES) != hipSuccess) { fprintf(stderr, "kernel_launch: hipFuncSetAttribute failed\n"); grid = -1; return; }
        grid = cus;
    }
    if (grid < 0) return;
    unsigned char* ws = (unsigned char*)d_ws; float* out = (float*)d_out;
    (void)hipMemsetAsync(ws + WS_CTL, 0, CTL_ZERO_BYTES, stream);
    Args a{};
    for (int i = 0; i < 19; ++i) a.in[i] = (const float*)d_in[i];
    a.out = out; a.ws = ws;
    a.ph_lo = 0; a.ph_hi = 8; a.li = 0;
    hipLaunchKernelGGL(mk_fwd, dim3(grid), dim3(NWAVES * 64), LDS_BYTES, stream, a);
}
```

```cpp
#include <hip/hip_runtime.h>
#include <cstdio>
#include <cstdint>

constexpr int D = 2048, SEQ = 2048, NB = 4, DB = 128, DS = 8;
constexpr int MP = NB * SEQ, MS = DB * DS, M = MP + MS;
constexpr int DC = 1024, NH = 4, DK = 128, DV = 256;
constexpr int NZ = 6144, NIN = 6152, FF = 5632, N3 = 2 * FF;
constexpr float EPS = 1e-6f;
constexpr float QSCALE = 0.08838834764831845f;
#ifndef FFN2_FP8
#define FFN2_FP8 1
#endif
constexpr int H8_EXP = 3, W8_EXP = 8;
constexpr int ZC_BG = 0, ZC_CG = 1024, ZC_XT = 2048, ZC_Q = 3072, ZC_K = 3584, ZC_V = 4096, ZC_O = 5120;
constexpr size_t O_Y = 0, O_PCONV = 18874368, O_PC = 18882560, O_PN = 19406848, O_PM = 19408896,
                 O_SCONV = 19408912, O_SC = 19671056, O_SN = 36448272, O_SM = 36513808, O_END = 36514320;
constexpr size_t MiB = 1u << 20;
constexpr size_t WS_CTL = 0, CTL_ZERO_BYTES = 1 * MiB;
constexpr size_t WS_W1 = 1 * MiB, WS_W2 = 25 * MiB, WS_W3 = 33 * MiB, WS_W4 = 77 * MiB;
constexpr size_t WS_A = 99 * MiB;
constexpr size_t WS_B = 135 * MiB;
constexpr size_t WS_C = 243 * MiB;
constexpr size_t WS_GATES = WS_C + 36 * MiB;
constexpr size_t WS_END = 283 * MiB;
constexpr int CW_TMO = 0, CW_CODE = 1;
constexpr int CW_BAR = 4096;
constexpr int CW_QUEUE = 30656;
constexpr int CW_SCAN = 30720;
constexpr int CW_CNT4 = 32768;
constexpr int CW_SSQ1 = 65536, CW_SSQ2 = 65536 + 16384;
constexpr int NWAVES = 8;
constexpr int RING_OFF = 0, RING_BYTES = 139264;
constexpr int LDSCTL_OFF = RING_BYTES, MISC_OFF = LDSCTL_OFF + 320;
constexpr int LDS_BYTES = 147456;

namespace pg8 {
#define PG8_LAS __attribute__((address_space(3)))
typedef unsigned short bf16_t;
typedef short bf16x8 __attribute__((ext_vector_type(8)));
typedef float f32x4 __attribute__((ext_vector_type(4)));
typedef unsigned u32x4 __attribute__((ext_vector_type(4)));
constexpr int BM = 256, BK = 64, HALF = 128, HTB = HALF * BK * 2  , STAGE_BYTES = 8 * HTB, NXCD = 8, WGM = 8;

__host__ __device__ __forceinline__ int lds_byte(int r, int c) { const int st = (r >> 4) * 2 + (c >> 5), rr = r & 15, cc = c & 31, ob = rr * 64 + cc * 2; return st * 1024 + (ob ^ (((ob >> 9) & 1) << 5)); }
__host__ __device__ __forceinline__ void stage_rc(int b, int& R, int& C) { const int st = b / 1024, sb = b % 1024, swz = sb ^ (((sb >> 9) & 1) << 5); R = (st >> 1) * 16 + swz / 64; C = (st & 1) * 32 + (swz % 64) / 2; }
__host__ __device__ __forceinline__ int perm32(int rho) { const int n = rho >> 4, i = rho & 15; return 8 * (i >> 2) + 4 * n + (i & 3); }

struct Unit { int pm, pn; };
struct Gemm { const bf16_t* A; const bf16_t* Bt; int M, N, K; };

struct StaticOrder {
    int nM, nN, nwg, G, c;
    __host__ __device__ void init(int M, int N, int G_, int c_) { nM = M / BM; nN = N / BM; nwg = nM * nN; G = G_; c = c_; }
    __host__ __device__ bool next(int i, Unit& u) const {
        const long L = (long)i * G + c; if (L >= nwg) return false;
        int wgid = (int)L; { const int q = nwg / NXCD, r = nwg % NXCD, xcd = wgid % NXCD, off = wgid / NXCD; wgid = (xcd < r ? xcd * (q + 1) : r * (q + 1) + (xcd - r) * q) + off; }
        const int nig = WGM * nN, gid = wgid / nig, fm = gid * WGM, gsz = (nM - fm) < WGM ? (nM - fm) : WGM;
        u.pm = fm + ((wgid % nig) % gsz); u.pn = (wgid % nig) / gsz; return true;
    }
    __device__ __forceinline__ void a_ready(const Unit&) const {}
    __device__ __forceinline__ void done(const Unit&) const {}
};
__device__ __forceinline__ unsigned cvt_pk_bf16(float lo, float hi) { unsigned r; asm volatile("v_cvt_pk_bf16_f32 %0, %1, %2" : "=v"(r) : "v"(lo), "v"(hi)); return r; }
typedef float f32x2 __attribute__((ext_vector_type(2)));
}
namespace pg9 {
using pg8::lds_byte; using pg8::stage_rc; using pg8::perm32; using pg8::cvt_pk_bf16; using pg8::bf16_t; using pg8::bf16x8; using pg8::f32x4; using pg8::u32x4; using pg8::Gemm;
constexpr int BMR = 288, BN = 256, BK = 64, HALF = 128, TH = 96, ATB = TH * BK * 2  , HTB = HALF * BK * 2  , STAGE_BYTES = 6 * ATB + 4 * HTB  , NXCD = 8, WGM = 8;
typedef int v8i __attribute__((ext_vector_type(8))); typedef int v4i __attribute__((ext_vector_type(4)));
__device__ __forceinline__ v8i cat8(bf16x8 lo, bf16x8 hi) { const v4i a = __builtin_bit_cast(v4i, lo), b = __builtin_bit_cast(v4i, hi); return __builtin_shufflevector(a, b, 0, 1, 2, 3, 4, 5, 6, 7); }
struct Unit { int pm, pn; };
struct StaticOrder {
    int nM, nN, nwg, G, c;
    __host__ __device__ void init(int M, int N, int G_, int c_) { nM = M / BMR; nN = N / BN; nwg = nM * nN; G = G_; c = c_; }
    __host__ __device__ bool next(int i, Unit& u) const {
        const long L = (long)i * G + c; if (L >= nwg) return false;
        int wgid = (int)L; { const int q = nwg / NXCD, r = nwg % NXCD, xcd = wgid % NXCD, off = wgid / NXCD; wgid = (xcd < r ? xcd * (q + 1) : r * (q + 1) + (xcd - r) * q) + off; }
        const int nig = WGM * nN, gid = wgid / nig, fm = gid * WGM, gsz = (nM - fm) < WGM ? (nM - fm) : WGM;
        u.pm = fm + ((wgid % nig) % gsz); u.pn = (wgid % nig) / gsz; return true;
    }
};
typedef f32x4 Acc[3][2][3][2];

struct EpiZ {
    bf16_t* O; int ldc;
    __device__ __forceinline__ void operator()(Acc& acc, const Unit& u, int wr, int wc, int fr, int fq) const {
        const int row0 = u.pm * BMR + wr * 144 + fr, col0 = u.pn * BN + wc * 32 + 8 * fq;
#pragma unroll
        for (int ai = 0; ai < 3; ++ai)
#pragma unroll
            for (int m = 0; m < 3; ++m) { bf16_t* rowp = O + (size_t)(row0 + ai * 48 + m * 16) * ldc + col0;
#pragma unroll
                for (int bj = 0; bj < 2; ++bj) { const f32x4 v0 = acc[ai][bj][m][0], v1 = acc[ai][bj][m][1];
                    u32x4 w; w.x = cvt_pk_bf16(v0[0], v0[1]); w.y = cvt_pk_bf16(v0[2], v0[3]); w.z = cvt_pk_bf16(v1[0], v1[1]); w.w = cvt_pk_bf16(v1[2], v1[3]);
                    *(u32x4*)(rowp + bj * HALF) = w; } }
    }
};
struct EpiRes {
    const float* xp; const float* xs; int rows_p; float* out; bf16_t* X1b; float* ssq;
    __device__ __forceinline__ const float* xrow(int row, int col0) const { return (row < rows_p ? xp + (size_t)row * 2048 : xs + (size_t)(row - rows_p) * 2048) + col0; }
    __device__ __forceinline__ void operator()(Acc& acc, const Unit& u, int wr, int wc, int fr, int fq) const {
        const int row0 = u.pm * BMR + wr * 144 + fr, col0 = u.pn * BN + wc * 32 + 8 * fq;
        f32x4 xr[2][4];
#define EPI_LOADX(g) do { const float* p_ = xrow(row0 + ((g) / 3) * 48 + ((g) % 3) * 16, col0); xr[(g) % 2][0] = *(const f32x4*)(p_); xr[(g) % 2][1] = *(const f32x4*)(p_ + 4); xr[(g) % 2][2] = *(const f32x4*)(p_ + HALF); xr[(g) % 2][3] = *(const f32x4*)(p_ + HALF + 4); } while (0)
        EPI_LOADX(0); EPI_LOADX(1);
#pragma unroll
        for (int g = 0; g < 9; ++g) {
            const int ai = g / 3, m = g % 3, row = row0 + ai * 48 + m * 16;
            float* orow = out + (size_t)row * 2048 + col0; float s = 0.f;
            f32x4 v[2][2];
#pragma unroll
            for (int bj = 0; bj < 2; ++bj) { v[bj][0] = acc[ai][bj][m][0] + xr[g % 2][2 * bj]; v[bj][1] = acc[ai][bj][m][1] + xr[g % 2][2 * bj + 1]; }
            asm volatile("" : "+v"(v[0][0]), "+v"(v[0][1]), "+v"(v[1][0]), "+v"(v[1][1]));
            if (g + 2 < 9) EPI_LOADX(g + 2);
#pragma unroll
            for (int bj = 0; bj < 2; ++bj) { const f32x4 v0 = v[bj][0], v1 = v[bj][1];
                if (out) { *(f32x4*)(orow + bj * HALF) = v0; *(f32x4*)(orow + bj * HALF + 4) = v1; }
                s += (v0[0] * v0[0] + v0[1] * v0[1]) + (v0[2] * v0[2] + v0[3] * v0[3]) + (v1[0] * v1[0] + v1[1] * v1[1]) + (v1[2] * v1[2] + v1[3] * v1[3]);
                if (X1b) { u32x4 w; w.x = cvt_pk_bf16(v0[0], v0[1]); w.y = cvt_pk_bf16(v0[2], v0[3]); w.z = cvt_pk_bf16(v1[0], v1[1]); w.w = cvt_pk_bf16(v1[2], v1[3]);
                    *(u32x4*)(X1b + (size_t)row * 2048 + col0 + bj * HALF) = w; } }
            s += __shfl_xor(s, 16); s += __shfl_xor(s, 32);
            if (fq == 0) atomicAdd(ssq + row, s);
        }
#undef EPI_LOADX
    }
};
struct EpiH {
    bf16_t* H; const float* ssq;
    __device__ __forceinline__ void operator()(Acc& acc, const Unit& u, int wr, int wc, int fr, int fq) const {
        const int row0 = u.pm * BMR + wr * 144 + fr, col0 = u.pn * HALF + wc * 32 + 8 * fq;
#pragma unroll
        for (int ai = 0; ai < 3; ++ai)
#pragma unroll
            for (int m = 0; m < 3; ++m) {
                const int row = row0 + ai * 48 + m * 16;
                const float r = rsqrtf(ssq[row] * (1.0f / 2048.0f) + 1e-6f);
                float h[8];
#pragma unroll
                for (int n = 0; n < 2; ++n)
#pragma unroll
                    for (int j = 0; j < 4; ++j) { const float g = acc[ai][0][m][n][j] * r, up = acc[ai][1][m][n][j] * r;
                        h[4 * n + j] = g * __builtin_amdgcn_rcpf(1.0f + __expf(-g)) * up; }
                u32x4 w; w.x = cvt_pk_bf16(h[0], h[1]); w.y = cvt_pk_bf16(h[2], h[3]); w.z = cvt_pk_bf16(h[4], h[5]); w.w = cvt_pk_bf16(h[6], h[7]);
                *(u32x4*)(H + (size_t)row * 5632 + col0) = w;
            }
    }
};

struct EpiH8 {
    unsigned char* H; const float* ssq; float hsc;
    __device__ __forceinline__ void operator()(Acc& acc, const Unit& u, int wr, int wc, int fr, int fq) const {
        const int row0 = u.pm * BMR + wr * 144 + fr, col0 = u.pn * HALF + wc * 32 + 8 * fq;
#pragma unroll
        for (int ai = 0; ai < 3; ++ai)
#pragma unroll
            for (int m = 0; m < 3; ++m) {
                const int row = row0 + ai * 48 + m * 16;
                const float r = rsqrtf(ssq[row] * (1.0f / 2048.0f) + 1e-6f), nr = r * -1.4426950408889634f, rr = r * r * hsc;
                float h[8];
#pragma unroll
                for (int n = 0; n < 2; ++n)
#pragma unroll
                    for (int j = 0; j < 4; ++j) { const float ga = acc[ai][0][m][n][j], ua = acc[ai][1][m][n][j];
                        h[4 * n + j] = __builtin_amdgcn_fmed3f(ga * ua * rr * __builtin_amdgcn_rcpf(1.0f + __builtin_amdgcn_exp2f(ga * nr)), -448.f, 448.f); }
                int w0 = __builtin_amdgcn_cvt_pk_fp8_f32(h[0], h[1], 0, false); w0 = __builtin_amdgcn_cvt_pk_fp8_f32(h[2], h[3], w0, true);
                int w1 = __builtin_amdgcn_cvt_pk_fp8_f32(h[4], h[5], 0, false); w1 = __builtin_amdgcn_cvt_pk_fp8_f32(h[6], h[7], w1, true);
                *(unsigned long long*)(H + (size_t)row * 5632 + col0) = (unsigned long long)(unsigned)w0 | ((unsigned long long)(unsigned)w1 << 32);
            }
    }
};
struct EpiFinal {
    float* out; float* ssq; unsigned* cnt; const float* fg; const bf16_t* x1b;
    __device__ __forceinline__ void operator()(Acc& acc, const Unit& u, int wr, int wc, int fr, int fq) const {
        const int row0 = u.pm * BMR + wr * 144 + fr, col0 = u.pn * BN + wc * 32 + 8 * fq;
        { f32x4 xr[2][4];
#define EPI_LOADX(g) do { const size_t o_ = (size_t)(row0 + ((g) / 3) * 48 + ((g) % 3) * 16) * 2048 + col0; \
            if (x1b) { const u32x4 a_ = *(const u32x4*)(x1b + o_), b_ = *(const u32x4*)(x1b + o_ + HALF); \
                xr[(g) % 2][0] = (f32x4){__uint_as_float(a_.x << 16), __uint_as_float(a_.x & 0xffff0000u), __uint_as_float(a_.y << 16), __uint_as_float(a_.y & 0xffff0000u)}; \
                xr[(g) % 2][1] = (f32x4){__uint_as_float(a_.z << 16), __uint_as_float(a_.z & 0xffff0000u), __uint_as_float(a_.w << 16), __uint_as_float(a_.w & 0xffff0000u)}; \
                xr[(g) % 2][2] = (f32x4){__uint_as_float(b_.x << 16), __uint_as_float(b_.x & 0xffff0000u), __uint_as_float(b_.y << 16), __uint_as_float(b_.y & 0xffff0000u)}; \
                xr[(g) % 2][3] = (f32x4){__uint_as_float(b_.z << 16), __uint_as_float(b_.z & 0xffff0000u), __uint_as_float(b_.w << 16), __uint_as_float(b_.w & 0xffff0000u)}; } \
            else { const float* p_ = out + o_; xr[(g) % 2][0] = *(const f32x4*)(p_); xr[(g) % 2][1] = *(const f32x4*)(p_ + 4); xr[(g) % 2][2] = *(const f32x4*)(p_ + HALF); xr[(g) % 2][3] = *(const f32x4*)(p_ + HALF + 4); } } while (0)
          EPI_LOADX(0); EPI_LOADX(1);
#pragma unroll
          for (int g = 0; g < 9; ++g) {
              const int ai = g / 3, m = g % 3, row = row0 + ai * 48 + m * 16; float s = 0.f;
#pragma unroll
              for (int bj = 0; bj < 2; ++bj) { acc[ai][bj][m][0] += xr[g % 2][2 * bj]; acc[ai][bj][m][1] += xr[g % 2][2 * bj + 1]; }
              asm volatile("" : "+v"(acc[ai][0][m][0]), "+v"(acc[ai][0][m][1]), "+v"(acc[ai][1][m][0]), "+v"(acc[ai][1][m][1]));
              if (g + 2 < 9) EPI_LOADX(g + 2);
#pragma unroll
              for (int bj = 0; bj < 2; ++bj) { const f32x4 v0 = acc[ai][bj][m][0], v1 = acc[ai][bj][m][1];
                  s += (v0[0] * v0[0] + v0[1] * v0[1]) + (v0[2] * v0[2] + v0[3] * v0[3]) + (v1[0] * v1[0] + v1[1] * v1[1]) + (v1[2] * v1[2] + v1[3] * v1[3]); }
              s += __shfl_xor(s, 16); s += __shfl_xor(s, 32);
              if (fq == 0) atomicAdd(ssq + row, s);
          }
#undef EPI_LOADX
        }
        asm volatile("s_waitcnt vmcnt(0)" ::: "memory");
        unsigned* cw = cnt + 64 * u.pm;
        if ((threadIdx.x & 63) == 0) __hip_atomic_fetch_add(cw, 1u, __ATOMIC_RELAXED, __HIP_MEMORY_SCOPE_AGENT);
        { unsigned spins = 0;
          while ((unsigned)__builtin_amdgcn_readfirstlane(__hip_atomic_load(cw, __ATOMIC_RELAXED, __HIP_MEMORY_SCOPE_AGENT)) < 64u) { __builtin_amdgcn_s_sleep(2); if (++spins > (1u << 20)) break; } }
        f32x4 gv[2][2];
#pragma unroll
        for (int bj = 0; bj < 2; ++bj) { gv[bj][0] = *(const f32x4*)(fg + col0 + bj * HALF); gv[bj][1] = *(const f32x4*)(fg + col0 + bj * HALF + 4); }
#pragma unroll
        for (int ai = 0; ai < 3; ++ai)
#pragma unroll
            for (int m = 0; m < 3; ++m) {
                const int row = row0 + ai * 48 + m * 16; float* orow = out + (size_t)row * 2048 + col0;
                const float tot = __hip_atomic_load(ssq + row, __ATOMIC_RELAXED, __HIP_MEMORY_SCOPE_AGENT);
                const float r = rsqrtf(tot * (1.0f / 2048.0f) + 1e-6f);
#pragma unroll
                for (int bj = 0; bj < 2; ++bj) { *(f32x4*)(orow + bj * HALF) = acc[ai][bj][m][0] * r * gv[bj][0]; *(f32x4*)(orow + bj * HALF + 4) = acc[ai][bj][m][1] * r * gv[bj][1]; }
            }
    }
};

template <class Epi, bool ALIGN_EPI = true, bool FP8 = false, int SCA = 127, int SCB = 127>
__device__ __forceinline__ void gemm_phase(PG8_LAS unsigned char* lds, const Gemm g, const StaticOrder& S, const Epi& E) {
    const int tid = threadIdx.x, wid = __builtin_amdgcn_readfirstlane(tid >> 6), lane = tid & 63, wr = wid >> 2, wc = wid & 3, fr = lane & 15, fq = lane >> 4;
    const int K = g.K, nt = K / BK;
    unsigned voffA[2], voffB[2];
#pragma unroll
    for (int i = 0; i < 2; ++i) { const int R = 8 * (wid + 8 * i) + (lane >> 3), C = 8 * ((lane & 7) ^ (R & 7)); const int Ra = 144 * (R / 48) + (R % 48);
        voffA[i] = (unsigned)(Ra * K + C) * 2u;
        voffB[i] = (unsigned)((wid + 8 * i) * (K >> 6)) * 1024u + (unsigned)((lane >> 3) * 128 + (((lane & 7) ^ (lane >> 3)) << 4)); }
    const size_t kstep = (size_t)(BK * 2);
    const size_t kstepB = 1024;
    const size_t hstep = (size_t)HALF * K * 2;
    const size_t thA = (size_t)48 * K * 2;
    const size_t tstepA = (size_t)BMR * K * 2, tstepB = (size_t)BN * K * 2;
    const unsigned ldsw = (unsigned)wid * 1024u;
    const int aoff0 = (wr * 48 + fr) * 128 + ((fq ^ (fr & 7)) << 4), aoff1 = (wr * 48 + fr) * 128 + (((fq + 4) ^ (fr & 7)) << 4);
    const int boff0 = (wc * 32 + fr) * 128 + ((fq ^ (fr & 7)) << 4), boff1 = (wc * 32 + fr) * 128 + (((fq + 4) ^ (fr & 7)) << 4);
#define PG9_SA(b, a) (((b) * 3 + (a)) * ATB)
#define PG9_SB(b, h) (6 * ATB + ((b) * 2 + (h)) * HTB)
#define PG9_STAGE_B(bufoff, gbase) do { _Pragma("unroll") for (int _i = 0; _i < 2; ++_i) \
        __builtin_amdgcn_global_load_lds((const unsigned*)((const char*)(gbase) + voffB[_i]), (PG8_LAS unsigned*)(lds + (bufoff) + ldsw + _i * 8192), 16, 0, 0); } while (0)
#define PG9_STAGE_A(bufoff, gbase) do { __builtin_amdgcn_global_load_lds((const unsigned*)((const char*)(gbase) + voffA[0]), (PG8_LAS unsigned*)(lds + (bufoff) + ldsw), 16, 0, 0); \
        if (wr == 0) __builtin_amdgcn_global_load_lds((const unsigned*)((const char*)(gbase) + voffA[1]), (PG8_LAS unsigned*)(lds + (bufoff) + ldsw + 8192), 16, 0, 0); } while (0)
#define PG9_LDA(dst, b, a) do { _Pragma("unroll") for (int m = 0; m < 3; ++m) { if constexpr (FP8) { dst##8[m] = cat8(*(const PG8_LAS bf16x8*)(lds + PG9_SA(b, a) + aoff0 + m * 2048), *(const PG8_LAS bf16x8*)(lds + PG9_SA(b, a) + aoff1 + m * 2048)); } \
        else { dst[m][0] = *(const PG8_LAS bf16x8*)(lds + PG9_SA(b, a) + aoff0 + m * 2048); dst[m][1] = *(const PG8_LAS bf16x8*)(lds + PG9_SA(b, a) + aoff1 + m * 2048); } } } while (0)
#define PG9_LDB(dst, b, h) do { int _b0 = boff0, _b1 = boff1; asm volatile("" : "+v"(_b0), "+v"(_b1));     \
        _Pragma("unroll") for (int n = 0; n < 2; ++n) { if constexpr (FP8) { dst##8[n] = cat8(*(const PG8_LAS bf16x8*)(lds + PG9_SB(b, h) + _b0 + n * 2048), *(const PG8_LAS bf16x8*)(lds + PG9_SB(b, h) + _b1 + n * 2048)); } \
        else { dst[n][0] = *(const PG8_LAS bf16x8*)(lds + PG9_SB(b, h) + _b0 + n * 2048); dst[n][1] = *(const PG8_LAS bf16x8*)(lds + PG9_SB(b, h) + _b1 + n * 2048); } } } while (0)
#define PG9_MMA(ai, bj, At, Bt) do { __builtin_amdgcn_s_setprio(1); _Pragma("unroll") for (int m = 0; m < 3; ++m) _Pragma("unroll") for (int n = 0; n < 2; ++n) { \
        if constexpr (FP8) { acc[ai][bj][m][n] = __builtin_amdgcn_mfma_scale_f32_16x16x128_f8f6f4(Bt##8[n], At##8[m], acc[ai][bj][m][n], 0, 0, 0, SCB, 0, SCA); } \
        else { _Pragma("unroll") for (int k = 0; k < 2; ++k) acc[ai][bj][m][n] = __builtin_amdgcn_mfma_f32_16x16x32_bf16(Bt[n][k], At[m][k], acc[ai][bj][m][n], 0, 0, 0); } } __builtin_amdgcn_s_setprio(0); } while (0)
#define PG9_WAIT_V(n0, n1) do { if (wr == 0) asm volatile("s_waitcnt vmcnt(" #n0 ")" ::: "memory"); else asm volatile("s_waitcnt vmcnt(" #n1 ")" ::: "memory"); } while (0)
#define PG9_WAIT_L0 asm volatile("s_waitcnt lgkmcnt(0)" ::: "memory")
#define PG9_BAR __builtin_amdgcn_s_barrier()
#define PG9_SCHED __builtin_amdgcn_sched_barrier(0)
#define PG9_PIN(ai) do { if constexpr (FP8) asm volatile("" : "+v"(acc[ai][0][0][0]), "+v"(acc[ai][0][0][1]), "+v"(acc[ai][0][1][0]), "+v"(acc[ai][0][1][1]), "+v"(acc[ai][0][2][0]), "+v"(acc[ai][0][2][1]), \
        "+v"(acc[ai][1][0][0]), "+v"(acc[ai][1][0][1]), "+v"(acc[ai][1][1][0]), "+v"(acc[ai][1][1][1]), "+v"(acc[ai][1][2][0]), "+v"(acc[ai][1][2][1])); } while (0)
#define PG9_SCHED8 do { if constexpr (FP8) __builtin_amdgcn_sched_barrier(0); } while (0)
#define PG9_ZERO() do { _Pragma("unroll") for (int a = 0; a < 3; ++a) _Pragma("unroll") for (int b = 0; b < 2; ++b) _Pragma("unroll") for (int m = 0; m < 3; ++m) _Pragma("unroll") for (int n = 0; n < 2; ++n) acc[a][b][m][n] = (f32x4){0.f, 0.f, 0.f, 0.f}; } while (0)
    Unit cur, nxt; int ui = 0;
    if (!S.next(0, cur)) return;
    Acc acc; PG9_ZERO();
    bf16x8 At[3][2], B0[2][2], B1[2][2];
    v8i At8[3], B08[2], B18[2];
    const char* cA = (const char*)g.A + (size_t)cur.pm * tstepA; const char* cB = (const char*)g.Bt + (size_t)cur.pn * tstepB;
    PG9_STAGE_B(PG9_SB(0, 0), cB); PG9_STAGE_A(PG9_SA(0, 0), cA); PG9_STAGE_B(PG9_SB(0, 1), cB + hstep); PG9_STAGE_A(PG9_SA(0, 1), cA + thA); PG9_STAGE_A(PG9_SA(0, 2), cA + 2 * thA);
    PG9_STAGE_B(PG9_SB(1, 0), cB + kstepB); PG9_STAGE_A(PG9_SA(1, 0), cA + kstep); PG9_STAGE_B(PG9_SB(1, 1), cB + hstep + kstepB); PG9_STAGE_A(PG9_SA(1, 1), cA + thA + kstep);
    if (wr == 1) PG9_BAR;
    PG9_WAIT_V(12, 8); PG9_BAR; PG9_BAR;
    for (;;) {
        const bool has_next = S.next(ui + 1, nxt);
        const char* nA = has_next ? (const char*)g.A + (size_t)nxt.pm * tstepA : cA; const char* nB = has_next ? (const char*)g.Bt + (size_t)nxt.pn * tstepB : cB;
        for (int t = 0; t < nt; t += 2) {
            const bool last = (t == nt - 2);
            const char* a1 = cA + (size_t)(t + 1) * kstep;
            const char* a2 = last ? nA : cA + (size_t)(t + 2) * kstep; const char* b2 = last ? nB : cB + (size_t)(t + 2) * kstepB;
            const char* a3 = a2 + kstep; const char* b3 = b2 + kstepB;
            PG9_LDB(B0, 0, 0); PG9_LDB(B1, 0, 1); PG9_SCHED; PG9_LDA(At, 0, 0); PG9_STAGE_A(PG9_SA(1, 2), a1 + 2 * thA);
            PG9_WAIT_V(12, 8); PG9_WAIT_L0; PG9_BAR; PG9_SCHED8; PG9_MMA(0, 0, At, B0); PG9_MMA(0, 1, At, B1); PG9_PIN(0); PG9_SCHED8; PG9_BAR; PG9_SCHED;
            PG9_LDA(At, 0, 1); PG9_STAGE_B(PG9_SB(0, 0), b2); PG9_STAGE_A(PG9_SA(0, 0), a2);
            PG9_WAIT_V(14, 10); PG9_WAIT_L0; PG9_BAR; PG9_SCHED8; PG9_MMA(1, 0, At, B0); PG9_MMA(1, 1, At, B1); PG9_PIN(1); PG9_SCHED8; PG9_BAR; PG9_SCHED;
            PG9_LDA(At, 0, 2); PG9_STAGE_B(PG9_SB(0, 1), b2 + hstep); PG9_STAGE_A(PG9_SA(0, 1), a2 + thA);
            PG9_WAIT_V(12, 8); PG9_WAIT_L0; PG9_BAR; PG9_SCHED8; PG9_MMA(2, 0, At, B0); PG9_MMA(2, 1, At, B1); PG9_PIN(2); PG9_SCHED8; PG9_BAR; PG9_SCHED;
            PG9_LDB(B0, 1, 0); PG9_LDB(B1, 1, 1); PG9_SCHED; PG9_LDA(At, 1, 0); PG9_STAGE_A(PG9_SA(0, 2), a2 + 2 * thA);
            PG9_WAIT_V(12, 8); PG9_WAIT_L0; PG9_BAR; PG9_SCHED8; PG9_MMA(0, 0, At, B0); PG9_MMA(0, 1, At, B1); PG9_PIN(0); PG9_SCHED8; PG9_BAR; PG9_SCHED;
            PG9_LDA(At, 1, 1); PG9_STAGE_B(PG9_SB(1, 0), b3); PG9_STAGE_A(PG9_SA(1, 0), a3);
            PG9_WAIT_V(14, 10); PG9_WAIT_L0; PG9_BAR; PG9_SCHED8; PG9_MMA(1, 0, At, B0); PG9_MMA(1, 1, At, B1); PG9_PIN(1); PG9_SCHED8; PG9_BAR; PG9_SCHED;
            PG9_LDA(At, 1, 2); PG9_STAGE_B(PG9_SB(1, 1), b3 + hstep); PG9_STAGE_A(PG9_SA(1, 1), a3 + thA);
            PG9_WAIT_V(12, 8); PG9_WAIT_L0; PG9_BAR; PG9_SCHED8; PG9_MMA(2, 0, At, B0); PG9_MMA(2, 1, At, B1); PG9_PIN(2); PG9_SCHED8; PG9_BAR; PG9_SCHED;
        }
        if constexpr (ALIGN_EPI) { if (wr == 0) PG9_BAR; }
        E(acc, cur, wr, wc, fr, fq);
        if (!has_next) break;
        PG9_ZERO();
        cur = nxt; cA = nA; cB = nB; ++ui;
        if constexpr (ALIGN_EPI) { if (wr == 1) PG9_BAR; }
    }
    asm volatile("s_waitcnt vmcnt(0)" ::: "memory");
    if constexpr (!ALIGN_EPI) { if (wr == 0) PG9_BAR; }
    PG9_BAR;
#undef PG9_SA
#undef PG9_SB
#undef PG9_STAGE_A
#undef PG9_STAGE_B
#undef PG9_LDA
#undef PG9_LDB
#undef PG9_MMA
#undef PG9_WAIT_V
#undef PG9_WAIT_L0
#undef PG9_BAR
#undef PG9_SCHED
#undef PG9_SCHED8
#undef PG9_PIN
#undef PG9_ZERO
}
}
#define GAS __attribute__((address_space(1)))
#define LAS __attribute__((address_space(3)))
typedef unsigned short bf16;
typedef unsigned v4u __attribute__((ext_vector_type(4)));
typedef float f32x4 __attribute__((ext_vector_type(4)));
typedef short bf16x8 __attribute__((ext_vector_type(8)));
typedef GAS unsigned gu32;
typedef GAS unsigned long long gu64;
#define RLX_AGENT __ATOMIC_RELAXED, __HIP_MEMORY_SCOPE_AGENT
#define LDS_WAIT() asm volatile("s_waitcnt lgkmcnt(0)" ::: "memory")
#define VM_WAIT() asm volatile("s_waitcnt vmcnt(0)" ::: "memory")
__device__ __forceinline__ unsigned f2bf(float f) { unsigned u = __builtin_bit_cast(unsigned, f); return (u + 0x7fffu + ((u >> 16) & 1u)) >> 16; }
__device__ __forceinline__ unsigned pk2(float lo, float hi) { return f2bf(lo) | (f2bf(hi) << 16); }
__device__ __forceinline__ float bf2f(unsigned b) { return __builtin_bit_cast(float, b << 16); }
__device__ __forceinline__ float wave_sum(float v) {
#pragma unroll
    for (int o = 1; o < 64; o <<= 1) v += __shfl_xor(v, o);
    return v;
}
__device__ __forceinline__ float sigmoidf_(float x) { return 1.f / (1.f + __expf(-x)); }
__device__ __forceinline__ float log_sigmoid(float x) { return fminf(x, 0.f) - log1pf(__expf(-fabsf(x))); }

#define XB_TMO      128
#define XB_XCNT(j)  (256  + 64 * (j))
#define XB_XSUB(j)  (1280 + 64 * (j))
#define XB_XGEN(j)  (2304 + 64 * (j))
#define XB_TOP      3328
#define XB_TOPGEN   3392
#define XCD_BAR_WORDS 3456
#define XB_SPIN_CAP (1u << 18)

__device__ __forceinline__ unsigned xb_ld(unsigned* p)              { return __hip_atomic_load(p, __ATOMIC_RELAXED, __HIP_MEMORY_SCOPE_AGENT); }
__device__ __forceinline__ unsigned xb_add(unsigned* p, unsigned v) { return __hip_atomic_fetch_add(p, v, __ATOMIC_RELAXED, __HIP_MEMORY_SCOPE_AGENT); }
__device__ __forceinline__ unsigned xb_xcc_id() { return (unsigned)__builtin_amdgcn_s_getreg((3 << 11) | 20) & 0xFu; }
#define XB_SPIN(cond, bar) do { unsigned _sp = 0; while (cond) { __builtin_amdgcn_s_sleep(1); \
    if ((++_sp & 255u) == 0u) { if (xb_ld(&(bar)[XB_TMO])) break; if (_sp > XB_SPIN_CAP) { atomicAdd(&(bar)[XB_TMO], 1u); break; } } } } while (0)

struct XcdBarrier {
    unsigned* bar; unsigned x;
    volatile LAS unsigned* st;
};

__device__ __forceinline__ XcdBarrier xcd_barrier_post(unsigned* bar, volatile LAS unsigned* st) {
    XcdBarrier b; b.bar = bar; b.x = xb_xcc_id(); b.st = st;
    if (threadIdx.x == 0) (void)xb_add(&bar[XB_XCNT(b.x)], 1u);
    return b;
}
__device__ __forceinline__ void xcd_barrier_complete(unsigned* bar, unsigned x, unsigned& nloc, unsigned& nx) {
    const unsigned G = gridDim.x * gridDim.y * gridDim.z;
    unsigned sum, cnt, mine, sp = 0u;
    for (;;) {
        sum = 0u; cnt = 0u; mine = 0u;
#pragma unroll
        for (unsigned j = 0; j < 16; ++j) { const unsigned c = xb_ld(&bar[XB_XCNT(j)]); sum += c; cnt += (c > 0u) ? 1u : 0u; mine = (j == x) ? c : mine; }
        if (sum == G) break;
        __builtin_amdgcn_s_sleep(1);
        if ((++sp & 255u) == 0u) { if (xb_ld(&bar[XB_TMO])) break; if (sp > XB_SPIN_CAP) { atomicAdd(&bar[XB_TMO], 1u); break; } }
    }
    nloc = mine > 0u ? mine : 1u; nx = cnt > 0u ? cnt : 1u;
}

__device__ __forceinline__ void xcd_barrier(const XcdBarrier& b) {
    asm volatile("s_waitcnt vmcnt(0)" ::: "memory");
    __syncthreads();
    if (threadIdx.x == 0) {
        unsigned* bar = b.bar;
        __builtin_amdgcn_s_waitcnt(0);
        unsigned nloc = b.st[0], nx = b.st[1];
        if (nloc == 0u) { xcd_barrier_complete(bar, b.x, nloc, nx); b.st[0] = nloc; b.st[1] = nx; }
        const unsigned old = xb_add(&bar[XB_XSUB(b.x)], 1u);
        const unsigned gen = old / nloc;
        if (old + 1u == (gen + 1u) * nloc) {
            __builtin_amdgcn_fence(__ATOMIC_RELEASE, "agent");
            asm volatile("s_waitcnt vmcnt(0)" ::: "memory");
            const unsigned og = xb_add(&bar[XB_TOP], 1u);
            const unsigned tg = og / nx;
            if (og + 1u == (tg + 1u) * nx) xb_add(&bar[XB_TOPGEN], 1u);
            else XB_SPIN(xb_ld(&bar[XB_TOPGEN]) == tg, bar);
            __builtin_amdgcn_fence(__ATOMIC_ACQUIRE, "agent");
            xb_add(&bar[XB_XGEN(b.x)], 1u);
            asm volatile("s_waitcnt vmcnt(0)" ::: "memory");
        } else {
            XB_SPIN(xb_ld(&bar[XB_XGEN(b.x)]) == gen, bar);
            __builtin_amdgcn_fence(__ATOMIC_ACQUIRE, "agent");
            asm volatile("s_waitcnt vmcnt(0)" ::: "memory");
        }
    }
    __syncthreads();
}
struct Frame {
    LAS unsigned char* lds;
    volatile LAS unsigned* MISC;
    gu32* ctl;
    int tid, lane, wave;
    int vcu, G;
    const float *x_p, *x_s, *st_conv, *st_C, *st_n, *st_m, *g1, *w_in, *b_i, *b_f, *conv_w, *conv_g, *ml_g, *w_out, *g2, *wg, *wu, *wd, *fg;
    float* out;
    bf16 *W1, *W2, *W3, *W4, *XN, *YC, *Z, *HB, *X1b;
    float *gates, *ssq1, *ssq2;
};

struct TrItem { const float* W; int ldw, K, nblk; bf16* WT; int mode; const float* kgain; int item; };
__device__ __forceinline__ void p0_tr_load(const TrItem& T, int lane, f32x4 (&v)[16]) {
    const int kb = T.item / T.nblk, nb = T.item % T.nblk, k0 = 64 * kb, n0 = 64 * nb; const int r4 = lane >> 4, c4 = 4 * (lane & 15);
#pragma unroll
    for (int i = 0; i < 16; ++i) v[i] = *(const GAS f32x4*)(T.W + (size_t)(k0 + 4 * i + r4) * T.ldw + n0 + c4);
}
__device__ __forceinline__ void p0_tr_finish(const TrItem& T, int lane, const f32x4 (&v)[16], LAS float* scr) {
    const int kb = T.item / T.nblk, nb = T.item % T.nblk, k0 = 64 * kb, n0 = 64 * nb; const int r4 = lane >> 4, c4 = 4 * (lane & 15);
#pragma unroll
    for (int i = 0; i < 16; ++i) { const int kk = 4 * i + r4; const float g = T.kgain ? T.kgain[k0 + kk] : 1.f; LAS float* d = scr + kk * 65 + c4; d[0] = v[i].x * g; d[1] = v[i].y * g; d[2] = v[i].z * g; d[3] = v[i].w * g; }
    LDS_WAIT(); asm volatile("" ::: "memory");
    const int c = lane & 7;
#pragma unroll
    for (int j = 0; j < 8; ++j) { const int n = (lane >> 3) + 8 * j; const LAS float* s = scr + (8 * c) * 65 + n;
        v4u o; o.x = pk2(s[0 * 65], s[1 * 65]); o.y = pk2(s[2 * 65], s[3 * 65]); o.z = pk2(s[4 * 65], s[5 * 65]); o.w = pk2(s[6 * 65], s[7 * 65]);
        const int jn = n0 + n; int drow = jn; if (T.mode == 1) drow = 256 * (jn >> 7) + (jn & 127); if (T.mode == 2) drow = 256 * (jn >> 7) + 128 + (jn & 127);
        const int x = drow & 31, slot = (drow & ~31) + 16 * ((x >> 2) & 1) + 4 * (x >> 3) + (x & 3);
        *(GAS v4u*)((GAS unsigned char*)T.WT + ((size_t)(slot >> 3) * (T.K >> 6) + (k0 >> 6)) * 1024 + (slot & 7) * 128 + 16 * c) = o; }
    LDS_WAIT(); asm volatile("" ::: "memory");
}
__device__ __forceinline__ void p0_tr_finish_fp8(const TrItem& T, int lane, const f32x4 (&v)[16], LAS float* scr, float wsc) {
    const int kb = T.item / T.nblk, nb = T.item % T.nblk, k0 = 64 * kb, n0 = 64 * nb; const int r4 = lane >> 4, c4 = 4 * (lane & 15);
#pragma unroll
    for (int i = 0; i < 16; ++i) { const int kk = 4 * i + r4; LAS float* d = scr + kk * 65 + c4; d[0] = v[i].x * wsc; d[1] = v[i].y * wsc; d[2] = v[i].z * wsc; d[3] = v[i].w * wsc; }
    LDS_WAIT(); asm volatile("" ::: "memory");
    const int c = lane & 3;
#pragma unroll
    for (int j = 0; j < 4; ++j) { const int n = (lane >> 2) + 16 * j; const LAS float* s = scr + (16 * c) * 65 + n; int w[4];
#pragma unroll
        for (int q = 0; q < 4; ++q) { w[q] = __builtin_amdgcn_cvt_pk_fp8_f32(s[(4 * q) * 65], s[(4 * q + 1) * 65], 0, false); w[q] = __builtin_amdgcn_cvt_pk_fp8_f32(s[(4 * q + 2) * 65], s[(4 * q + 3) * 65], w[q], true); }
        const int drow = n0 + n, x = drow & 31, slot = (drow & ~31) + 16 * ((x >> 2) & 1) + 4 * (x >> 3) + (x & 3);
        v4u o; o.x = (unsigned)w[0]; o.y = (unsigned)w[1]; o.z = (unsigned)w[2]; o.w = (unsigned)w[3];
        *(GAS v4u*)((GAS unsigned char*)T.WT + ((size_t)(slot >> 3) * (T.K >> 7) + (k0 >> 7)) * 1024 + (slot & 7) * 128 + (k0 & 127) + 16 * c) = o; }
    LDS_WAIT(); asm volatile("" ::: "memory");
}
__device__ __forceinline__ void p0_transpose_item_fp8(const float* W, int ldw, int K, int nblk, bf16* WT, LAS float* scr, int item, int lane, float wsc) {
    const TrItem T{W, ldw, K, nblk, WT, 0, nullptr, item}; f32x4 v[16]; p0_tr_load(T, lane, v); p0_tr_finish_fp8(T, lane, v, scr, wsc);
}
__device__ __forceinline__ void p0_transpose_item(const float* W, int ldw, int K, int nblk, bf16* WT, int mode, const float* kgain, LAS float* scr, int item, int lane) {
    const TrItem T{W, ldw, K, nblk, WT, mode, kgain, item}; f32x4 v[16]; p0_tr_load(T, lane, v); p0_tr_finish(T, lane, v, scr);
}
__device__ __forceinline__ void p0_xrow_load(Frame& F, int m, f32x4 (&v)[8]) {
    const float* xr = m < MP ? F.x_p + (size_t)m * D : F.x_s + (size_t)(m - MP) * D;
#pragma unroll
    for (int j = 0; j < 8; ++j) v[j] = *(const GAS f32x4*)(xr + 256 * j + 4 * F.lane);
}
__device__ __forceinline__ void p0_xrow(Frame& F, int m, const LAS float* gwl, const f32x4 (&v)[8], const f32x4 (&g)[8], float bq) {
    const int lane = F.lane; float s = 0.f;
#pragma unroll
    for (int j = 0; j < 8; ++j) s += (v[j].x * v[j].x + v[j].y * v[j].y) + (v[j].z * v[j].z + v[j].w * v[j].w);
    const float r = rsqrtf(wave_sum(s) * (1.f / D) + EPS);
    float ga[8]; pg8::f32x2 ga2[8];
#pragma unroll
    for (int q = 0; q < 8; ++q) ga2[q] = (pg8::f32x2){0.f, 0.f};
#pragma unroll
    for (int j = 0; j < 8; ++j) {
        const int k = 256 * j + 4 * lane;
        const f32x4 xn = v[j] * r * g[j];
        *(GAS unsigned long long*)(F.XN + (size_t)m * D + k) = (unsigned long long)pg8::cvt_pk_bf16(xn.x, xn.y) | ((unsigned long long)pg8::cvt_pk_bf16(xn.z, xn.w) << 32);
        f32x4 w[8];
#pragma unroll
        for (int q = 0; q < 8; ++q) w[q] = *(const LAS f32x4*)(gwl + q * D + k);
        const pg8::f32x2 xlo = {xn.x, xn.y}, xhi = {xn.z, xn.w};
#pragma unroll
        for (int q = 0; q < 8; ++q) { ga2[q] = __builtin_elementwise_fma(xlo, (pg8::f32x2){w[q].x, w[q].y}, ga2[q]); ga2[q] = __builtin_elementwise_fma(xhi, (pg8::f32x2){w[q].z, w[q].w}, ga2[q]); }
    }
#pragma unroll
    for (int q = 0; q < 8; ++q) ga[q] = ga2[q].x + ga2[q].y;
    float k4[4], k2[2], k1;
    { const bool hi = (lane & 32) != 0;
#pragma unroll
      for (int i = 0; i < 4; ++i) { const float recv = __shfl_xor(hi ? ga[i] : ga[4 + i], 32); k4[i] = (hi ? ga[4 + i] : ga[i]) + recv; } }
    { const bool hi = (lane & 16) != 0;
#pragma unroll
      for (int i = 0; i < 2; ++i) { const float recv = __shfl_xor(hi ? k4[i] : k4[2 + i], 16); k2[i] = (hi ? k4[2 + i] : k4[i]) + recv; } }
    { const bool hi = (lane & 8) != 0; const float recv = __shfl_xor(hi ? k2[0] : k2[1], 8); k1 = (hi ? k2[1] : k2[0]) + recv; }
    k1 += __shfl_xor(k1, 4); k1 += __shfl_xor(k1, 2); k1 += __shfl_xor(k1, 1);
    if ((lane & 7) == 0) { const int q = lane >> 3; F.gates[(size_t)m * 8 + q] = q < 4 ? k1 + bq : log_sigmoid(k1 + bq); }
}
constexpr int TR_I1 = (D / 64) * (NZ / 64), TR_I2 = (D / 64) * (D / 64), TR_I3 = (D / 64) * (FF / 64), TR_I4 = (FF / 64) * (D / 64);
__device__ __forceinline__ TrItem tr_make(Frame& F, int it) {
    int r = it;
    if (r < TR_I1) return TrItem{F.w_in, NIN, D, NZ / 64, F.W1, 0, nullptr, r}; r -= TR_I1;
    if (r < TR_I2) return TrItem{F.w_out, D, D, D / 64, F.W2, 0, nullptr, r}; r -= TR_I2;
    if (r < TR_I3) return TrItem{F.wg, FF, D, FF / 64, F.W3, 1, F.g2, r}; r -= TR_I3;
    if (r < TR_I3) return TrItem{F.wu, FF, D, FF / 64, F.W3, 2, F.g2, r}; r -= TR_I3;
    return TrItem{F.wd, D, FF, D / 64, F.W4, 0, nullptr, r};
}
__device__ __forceinline__ void tr_run(Frame& F, int lo, int hi, int first, int stride, LAS float* scr) {
    f32x4 va[16], vb[16]; int it = lo + first; TrItem Ta{}, Tb{};
    if (it < hi) { Ta = tr_make(F, it); p0_tr_load(Ta, F.lane, va); }
    while (it < hi) {
        const int it2 = it + stride;
        if (it2 < hi) { Tb = tr_make(F, it2); p0_tr_load(Tb, F.lane, vb); }
        p0_tr_finish(Ta, F.lane, va, scr);
        if (it2 >= hi) break;
        const int it3 = it2 + stride;
        if (it3 < hi) { Ta = tr_make(F, it3); p0_tr_load(Ta, F.lane, va); }
        p0_tr_finish(Tb, F.lane, vb, scr);
        it = it3;
    }
}
__device__ __forceinline__ void p0_prologue(Frame& F, bool w4_later, bool w23_later) {
    LAS float* scr = (LAS float*)(F.lds + RING_OFF + F.wave * 16640);
    const int gw = F.vcu * NWAVES + F.wave, NGW = F.G * NWAVES;
    constexpr int I_1 = (D / 64) * (NZ / 64), I_2 = (D / 64) * (D / 64), I_3 = (D / 64) * (FF / 64), I_4 = (FF / 64) * (D / 64);
    constexpr int NITEMS = I_1 + I_2 + 2 * I_3 + I_4;
    const int NIT = w23_later ? I_1 : (w4_later ? NITEMS - I_4 : NITEMS);
    tr_run(F, 0, NIT, gw, NGW, scr);
    __syncthreads();
    LAS float* gwl = (LAS float*)(F.lds + RING_OFF);
    for (int k = F.tid; k < D; k += NWAVES * 64) {
        const f32x4 a = *(const GAS f32x4*)(F.w_in + (size_t)k * NIN + NZ), b = *(const GAS f32x4*)(F.w_in + (size_t)k * NIN + NZ + 4);
        gwl[0 * D + k] = a.x; gwl[1 * D + k] = a.y; gwl[2 * D + k] = a.z; gwl[3 * D + k] = a.w; gwl[4 * D + k] = b.x; gwl[5 * D + k] = b.y; gwl[6 * D + k] = b.z; gwl[7 * D + k] = b.w;
    }
    __syncthreads();
    {
        f32x4 g[8];
#pragma unroll
        for (int j = 0; j < 8; ++j) g[j] = *(const GAS f32x4*)(F.g1 + 256 * j + 4 * F.lane);
        const float bq = (F.lane >> 3) < 4 ? F.b_i[F.lane >> 3] : F.b_f[(F.lane >> 3) - 4];
        f32x4 va[8], vb[8]; int m = gw;
        p0_xrow_load(F, m < M ? m : M - 1, va);
        while (m < M) {
            const int m2 = m + NGW;
            p0_xrow_load(F, m2 < M ? m2 : M - 1, vb);
            asm volatile("" ::: "memory");
            p0_xrow(F, m, gwl, va, g, bq);
            if (m2 >= M) break;
            const int m3 = m2 + NGW;
            p0_xrow_load(F, m3 < M ? m3 : M - 1, va);
            asm volatile("" ::: "memory");
            p0_xrow(F, m2, gwl, vb, g, bq);
            m = m3;
        }
    }
    __syncthreads();
}
__device__ __forceinline__ void final_norm_phase(Frame& F) {
    const int gw = F.vcu * NWAVES + F.wave, NGW = F.G * NWAVES;
    for (int m = gw; m < M; m += NGW) {
        const float r = rsqrtf(F.ssq2[m] * (1.f / D) + EPS);
#pragma unroll
        for (int j = 0; j < 8; ++j) { GAS f32x4* p = (GAS f32x4*)(F.out + (size_t)m * D + 256 * j + 4 * F.lane); const f32x4 g = *(const GAS f32x4*)(F.fg + 256 * j + 4 * F.lane); *p = *p * r * g; }
    }
}
__device__ __forceinline__ void unpack8(const v4u w, float (&f)[8]) {
    f[0] = bf2f(w.x & 0xffffu); f[1] = bf2f(w.x >> 16); f[2] = bf2f(w.y & 0xffffu); f[3] = bf2f(w.y >> 16);
    f[4] = bf2f(w.z & 0xffffu); f[5] = bf2f(w.z >> 16); f[6] = bf2f(w.w & 0xffffu); f[7] = bf2f(w.w >> 16);
}
__device__ __forceinline__ void conv_item(Frame& F, int item) {
    const bool prompt = item < 1024;
    const int b = prompt ? (item >> 8) : (item - 1024);
    const int row0 = prompt ? 8 * item : MP + 8 * (item - 1024);
    const int t0 = prompt ? 8 * (item & 255) : 0;
    const bool last_item = prompt ? ((item & 255) == 255) : true;
    const int lane = F.lane;
    float w0[16], w1[16], w2[16], cg_[16], up2[16], up1[16];
#pragma unroll
    for (int p = 0; p < 2; ++p) {
        const int c0 = 8 * lane + 512 * p;
#pragma unroll
        for (int q = 0; q < 2; ++q) {
            const f32x4 a = *(const GAS f32x4*)(F.conv_w + c0 + 4 * q), bb = *(const GAS f32x4*)(F.conv_w + DC + c0 + 4 * q), c = *(const GAS f32x4*)(F.conv_w + 2 * DC + c0 + 4 * q), g = *(const GAS f32x4*)(F.conv_g + c0 + 4 * q);
#pragma unroll
            for (int i = 0; i < 4; ++i) { w0[8 * p + 4 * q + i] = a[i]; w1[8 * p + 4 * q + i] = bb[i]; w2[8 * p + 4 * q + i] = c[i]; cg_[8 * p + 4 * q + i] = g[i]; }
        }
    }
    if (prompt) {
        if (t0 == 0) {
#pragma unroll
            for (int i = 0; i < 16; ++i) { up2[i] = 0.f; up1[i] = 0.f; }
        } else {
#pragma unroll
            for (int p = 0; p < 2; ++p) {
                const int c0 = 8 * lane + 512 * p; float a[8], x[8];
                const bf16* z2 = F.Z + (size_t)(row0 - 2) * NZ; const bf16* z1 = F.Z + (size_t)(row0 - 1) * NZ;
                unpack8(*(const GAS v4u*)(z2 + ZC_CG + c0), a); unpack8(*(const GAS v4u*)(z2 + ZC_XT + c0), x);
#pragma unroll
                for (int i = 0; i < 8; ++i) up2[8 * p + i] = a[i] * x[i];
                unpack8(*(const GAS v4u*)(z1 + ZC_CG + c0), a); unpack8(*(const GAS v4u*)(z1 + ZC_XT + c0), x);
#pragma unroll
                for (int i = 0; i < 8; ++i) up1[8 * p + i] = a[i] * x[i];
            }
        }
    } else {
#pragma unroll
        for (int p = 0; p < 2; ++p) {
            const int c0 = 8 * lane + 512 * p;
#pragma unroll
            for (int q = 0; q < 2; ++q) {
                const f32x4 a = *(const GAS f32x4*)(F.st_conv + ((size_t)b * 2 + 0) * DC + c0 + 4 * q), bb = *(const GAS f32x4*)(F.st_conv + ((size_t)b * 2 + 1) * DC + c0 + 4 * q);
#pragma unroll
                for (int i = 0; i < 4; ++i) { up2[8 * p + 4 * q + i] = a[i]; up1[8 * p + 4 * q + i] = bb[i]; }
            }
        }
    }
#pragma unroll 1
    for (int r = 0; r < 8; ++r) {
        const int row = row0 + r; const bf16* zr = F.Z + (size_t)row * NZ;
        float tt[16]; float ss = 0.f;
#pragma unroll
        for (int p = 0; p < 2; ++p) {
            const int c0 = 8 * lane + 512 * p; float a[8], x[8], g[8];
            unpack8(*(const GAS v4u*)(zr + ZC_CG + c0), a); unpack8(*(const GAS v4u*)(zr + ZC_XT + c0), x); unpack8(*(const GAS v4u*)(zr + ZC_BG + c0), g);
#pragma unroll
            for (int i = 0; i < 8; ++i) { const int ci = 8 * p + i; const float u = a[i] * x[i];
                const float cv = w0[ci] * up2[ci] + w1[ci] * up1[ci] + w2[ci] * u; tt[ci] = g[i] * cv; ss += tt[ci] * tt[ci]; up2[ci] = up1[ci]; up1[ci] = u; }
        }
        const float rr = rsqrtf(wave_sum(ss) * (1.f / DC) + EPS);
#pragma unroll
        for (int p = 0; p < 2; ++p) {
            const int c0 = 8 * lane + 512 * p; v4u o;
            o.x = pk2(tt[8 * p + 0] * rr * cg_[8 * p + 0], tt[8 * p + 1] * rr * cg_[8 * p + 1]); o.y = pk2(tt[8 * p + 2] * rr * cg_[8 * p + 2], tt[8 * p + 3] * rr * cg_[8 * p + 3]);
            o.z = pk2(tt[8 * p + 4] * rr * cg_[8 * p + 4], tt[8 * p + 5] * rr * cg_[8 * p + 5]); o.w = pk2(tt[8 * p + 6] * rr * cg_[8 * p + 6], tt[8 * p + 7] * rr * cg_[8 * p + 7]);
            *(GAS v4u*)(F.YC + (size_t)row * D + c0) = o;
        }
        if (last_item && r >= 6) {
            float* o = F.out + (prompt ? O_PCONV : O_SCONV) + ((size_t)b * 2 + (r - 6)) * DC;
#pragma unroll
            for (int p = 0; p < 2; ++p) { const int c0 = 8 * lane + 512 * p;
                *(GAS f32x4*)(o + c0) = (f32x4){up1[8 * p + 0], up1[8 * p + 1], up1[8 * p + 2], up1[8 * p + 3]}; *(GAS f32x4*)(o + c0 + 4) = (f32x4){up1[8 * p + 4], up1[8 * p + 5], up1[8 * p + 6], up1[8 * p + 7]}; }
        }
    }
}

template <bool WITH_STATE>
__device__ __forceinline__ void sample_item(Frame& F, int item) {
    LAS float* L = (LAS float*)(F.lds + RING_OFF);
    LAS float* qT = L; LAS float* kT = L + 1024; LAS float* kwT = L + 2048; LAS float* qR = L + 3072; LAS float* kR = L + 4128; LAS float* vS = L + 5184; LAS float* accx = L + 7232; LAS float* Sm = L + 23616;
    LAS float* ai = L + 23680; LAS float* dd = L + 23688; LAS float* wk = L + 23696; LAS float* misc = L + 23704; LAS float* n0s = L + 23712; LAS float* red = L + 23840; LAS float* lis = L + 23872; LAS float* lfs = L + 23880;
    const int tid = F.tid, b = item >> 2, h = item & 3, row0 = MP + 8 * b;
    __syncthreads();
    if (tid < 256) { const int isk = tid >> 7, t = (tid >> 4) & 7, c = tid & 15; float f[8];
        unpack8(*(const GAS v4u*)(F.Z + (size_t)(row0 + t) * NZ + (isk ? ZC_K : ZC_Q) + h * DK + 8 * c), f);
        LAS float* T_ = isk ? kT : qT; LAS float* R_ = isk ? kR : qR; const float sc_ = isk ? 1.f : QSCALE;
#pragma unroll
        for (int i = 0; i < 8; ++i) { const float x = f[i] * sc_; T_[(8 * c + i) * 8 + t] = x; R_[t * 132 + 8 * c + i] = x; }
    } else { const int u = tid - 256, t = u >> 5, c = u & 31; float f[8]; unpack8(*(const GAS v4u*)(F.Z + (size_t)(row0 + t) * NZ + ZC_V + h * DV + 8 * c), f);
#pragma unroll
        for (int i = 0; i < 8; ++i) vS[t * 256 + 8 * c + i] = f[i]; }
    if (tid < 8) { lis[tid] = F.gates[(size_t)(row0 + tid) * 8 + h]; lfs[tid] = F.gates[(size_t)(row0 + tid) * 8 + 4 + h]; }
    if (tid >= 64 && tid < 64 + DK) n0s[tid - 64] = F.st_n[(size_t)(b * NH + h) * DK + tid - 64];
    __syncthreads();
    if (F.wave == 0) {
        const int lane = F.lane, t = lane >> 3, s = lane & 7;
        const float m0 = F.st_m[b * NH + h];
        float bc[8]; { float run = 0.f;
#pragma unroll
            for (int i = 0; i < 8; ++i) { run += lfs[i]; bc[i] = run; } }
        float bt = 0.f, bs = 0.f;
#pragma unroll
        for (int i = 0; i < 8; ++i) { bt = (i == t) ? bc[i] : bt; bs = (i == s) ? bc[i] : bs; }
        const float lis_s = lis[s];
        const float dm = (s <= t) ? (bt - bs + lis_s) : -INFINITY;
        float mx = dm; mx = fmaxf(mx, __shfl_xor(mx, 1)); mx = fmaxf(mx, __shfl_xor(mx, 2)); mx = fmaxf(mx, __shfl_xor(mx, 4));
        const float mt = fmaxf(bt + m0, mx);
        const float w = (s <= t) ? __expf(dm - mt) : 0.f;
        const float a_i = __expf(bt + m0 - mt);
        float dot = 0.f, qn = 0.f;
#pragma unroll 8
        for (int d4 = 0; d4 < DK; d4 += 4) { const f32x4 qv = *(const LAS f32x4*)(qR + t * 132 + d4), kv = *(const LAS f32x4*)(kR + s * 132 + d4), nv = *(const LAS f32x4*)(n0s + d4);
            dot += (qv.x * kv.x + qv.y * kv.y) + (qv.z * kv.z + qv.w * kv.w); qn += (qv.x * nv.x + qv.y * nv.y) + (qv.z * nv.z + qv.w * nv.w); }
        const float sv = dot * w;
        float rs = sv; rs += __shfl_xor(rs, 1); rs += __shfl_xor(rs, 2); rs += __shfl_xor(rs, 4);
        const float den = a_i * qn + rs;
        Sm[t * 8 + s] = sv;
        const float bL = bc[7];
        const float gs = bL - bs + lis_s;
        float gm = gs; gm = fmaxf(gm, __shfl_xor(gm, 1)); gm = fmaxf(gm, __shfl_xor(gm, 2)); gm = fmaxf(gm, __shfl_xor(gm, 4));
        const float mnew = fmaxf(bL + m0, gm);
        if (s == 0) { ai[t] = a_i; dd[t] = 1.f / fmaxf(fabsf(den), __expf(-mt)); }
        if (t == 0) wk[s] = __expf(gs - mnew);
        if (lane == 0) { misc[0] = __expf(bL + m0 - mnew); misc[1] = mnew; }
    }
    __syncthreads();
    const float sc = misc[0];
    for (int i = tid; i < 1024; i += NWAVES * 64) kwT[i] = kT[i] * wk[i & 7];
    __syncthreads();
    if (tid < DK) { float nn = sc * n0s[tid];
#pragma unroll
        for (int s = 0; s < 8; ++s) nn += kwT[tid * 8 + s];
        F.out[O_SN + (size_t)(b * NH + h) * DK + tid] = nn; }
    if (tid == 0) F.out[O_SM + b * NH + h] = misc[1];
    { const int e4 = tid & 63, dg = F.wave;
      f32x4 vv[8], acc[8];
#pragma unroll
      for (int s = 0; s < 8; ++s) { vv[s] = *(const LAS f32x4*)(vS + s * 256 + 4 * e4); acc[s] = (f32x4){0.f, 0.f, 0.f, 0.f}; }
      const float* c0p = F.st_C + ((size_t)(b * NH + h) * DK + 16 * dg) * DV + 4 * e4;
      float* c1p = F.out + O_SC + ((size_t)(b * NH + h) * DK + 16 * dg) * DV + 4 * e4;
      {   constexpr int d0 = 0;
          f32x4 c[16];
#pragma unroll
          for (int j = 0; j < 16; ++j) c[j] = *(const GAS f32x4*)(c0p + (size_t)(d0 + j) * DV);
#pragma unroll
          for (int j = 0; j < 16; ++j) {
              const int d = 16 * dg + d0 + j;
              const f32x4 q0 = *(const LAS f32x4*)(qT + d * 8), q1 = *(const LAS f32x4*)(qT + d * 8 + 4), k0 = *(const LAS f32x4*)(kwT + d * 8), k1 = *(const LAS f32x4*)(kwT + d * 8 + 4);
              f32x4 cn = c[j] * sc;
#pragma unroll
              for (int s = 0; s < 4; ++s) { acc[s] += c[j] * q0[s]; acc[4 + s] += c[j] * q1[s]; if (WITH_STATE) { cn += vv[s] * k0[s]; cn += vv[4 + s] * k1[s]; } }
              if (WITH_STATE) *(GAS f32x4*)(c1p + (size_t)(d0 + j) * DV) = cn;
          }
      }
#pragma unroll
      for (int t = 0; t < 8; ++t) *(LAS f32x4*)(accx + (dg * 8 + t) * 256 + 4 * e4) = acc[t];
    }
    __syncthreads();
    { const int e = tid & 255, th = tid >> 8; float hv[4];
#pragma unroll
      for (int tt = 0; tt < 4; ++tt) { const int t = 4 * th + tt; float a = 0.f;
#pragma unroll
          for (int w = 0; w < 8; ++w) a += accx[(w * 8 + t) * 256 + e];
          float num = ai[t] * a;
#pragma unroll
          for (int s = 0; s < 8; ++s) num += Sm[t * 8 + s] * vS[s * 256 + e];
          hv[tt] = num * dd[t]; const float p = wave_sum(hv[tt] * hv[tt]); if (F.lane == 0) red[F.wave * 4 + tt] = p; }
      __syncthreads();
      const float gml = F.ml_g[h * DV + e];
#pragma unroll
      for (int tt = 0; tt < 4; ++tt) { const int t = 4 * th + tt, w0 = 4 * th;
          const float rr = rsqrtf((red[(w0 + 0) * 4 + tt] + red[(w0 + 1) * 4 + tt] + red[(w0 + 2) * 4 + tt] + red[(w0 + 3) * 4 + tt]) * (1.f / DV) + EPS);
          const float o = bf2f(F.Z[(size_t)(row0 + t) * NZ + ZC_O + h * DV + e]);
          F.YC[(size_t)(row0 + t) * D + DC + h * DV + e] = (bf16)f2bf(sigmoidf_(o) * hv[tt] * rr * gml); }
    }
}

__device__ __forceinline__ void sample_state_item(Frame& F, int item) {
    LAS float* L = (LAS float*)(F.lds + RING_OFF);
    LAS float* kT = L; LAS float* kwT = L + 1024; LAS float* vS = L + 2048; LAS float* lis = L + 4096; LAS float* lfs = L + 4104; LAS float* wk = L + 4112; LAS float* misc = L + 4120;
    const int tid = F.tid, b = item >> 2, h = item & 3, row0 = MP + 8 * b;
    const int e4 = tid & 63, dg = F.wave;
    const float* c0p = F.st_C + ((size_t)(b * NH + h) * DK + 16 * dg) * DV + 4 * e4;
    float* c1p = F.out + O_SC + ((size_t)(b * NH + h) * DK + 16 * dg) * DV + 4 * e4;
    f32x4 c[16];
#pragma unroll
    for (int j = 0; j < 16; ++j) c[j] = *(const GAS f32x4*)(c0p + (size_t)j * DV);
    __syncthreads();
    if (tid >= 128 && tid < 256) { const int u = tid - 128, t = u >> 4, cc = u & 15; float f[8]; unpack8(*(const GAS v4u*)(F.Z + (size_t)(row0 + t) * NZ + ZC_K + h * DK + 8 * cc), f);
#pragma unroll
        for (int i = 0; i < 8; ++i) kT[(8 * cc + i) * 8 + t] = f[i];
    } else if (tid >= 256) { const int u = tid - 256, t = u >> 5, cc = u & 31; float f[8]; unpack8(*(const GAS v4u*)(F.Z + (size_t)(row0 + t) * NZ + ZC_V + h * DV + 8 * cc), f);
#pragma unroll
        for (int i = 0; i < 8; ++i) vS[t * 256 + 8 * cc + i] = f[i]; }
    if (tid < 8) { lis[tid] = F.gates[(size_t)(row0 + tid) * 8 + h]; lfs[tid] = F.gates[(size_t)(row0 + tid) * 8 + 4 + h]; }
    __syncthreads();
    if (tid < 8) {
        const float m0 = F.st_m[b * NH + h]; float run = 0.f, bs = 0.f;
#pragma unroll
        for (int i = 0; i < 8; ++i) { run += lfs[i]; bs = (i == tid) ? run : bs; }
        const float bL = run, gs = bL - bs + lis[tid];
        float gm = gs; gm = fmaxf(gm, __shfl_xor(gm, 1)); gm = fmaxf(gm, __shfl_xor(gm, 2)); gm = fmaxf(gm, __shfl_xor(gm, 4));
        const float mnew = fmaxf(bL + m0, gm);
        wk[tid] = __expf(gs - mnew); if (tid == 0) misc[0] = __expf(bL + m0 - mnew);
    }
    __syncthreads();
    const float sc = misc[0];
    for (int i = tid; i < 1024; i += NWAVES * 64) kwT[i] = kT[i] * wk[i & 7];
    __syncthreads();
    f32x4 vv[8];
#pragma unroll
    for (int s = 0; s < 8; ++s) vv[s] = *(const LAS f32x4*)(vS + s * 256 + 4 * e4);
#pragma unroll
    for (int j = 0; j < 16; ++j) {
        const int d = 16 * dg + j;
        const f32x4 k0 = *(const LAS f32x4*)(kwT + d * 8), k1 = *(const LAS f32x4*)(kwT + d * 8 + 4);
        f32x4 cn = c[j] * sc;
#pragma unroll
        for (int s = 0; s < 4; ++s) { cn += vv[s] * k0[s]; cn += vv[4 + s] * k1[s]; }
        *(GAS f32x4*)(c1p + (size_t)j * DV) = cn;
    }
}

typedef short s16x4 __attribute__((ext_vector_type(4)));
typedef float f32x16 __attribute__((ext_vector_type(16)));
#define MFMA32(a, b, c) __builtin_amdgcn_mfma_f32_32x32x16_bf16((a), (b), (c), 0, 0, 0)
__device__ __forceinline__ unsigned tr_addr(unsigned base, int P, int rbase, int C0, int lane) {
    const int h = lane >> 5, blk = (lane >> 4) & 1, q = (lane & 15) >> 2, p = lane & 3;
    return base + (unsigned)((rbase + 8 * h + q) * P + (C0 + 16 * blk + 4 * p) * 2);
}
__device__ __forceinline__ void tr_frag_pair(unsigned a0, unsigned a1, unsigned b0, unsigned b1, bf16x8& A, bf16x8& B) {
    s16x4 x0, x1, y0, y1;
    asm volatile("ds_read_b64_tr_b16 %0, %4\n\tds_read_b64_tr_b16 %1, %5\n\tds_read_b64_tr_b16 %2, %6\n\tds_read_b64_tr_b16 %3, %7\n\ts_waitcnt lgkmcnt(0)"
                 : "=&v"(x0), "=&v"(x1), "=&v"(y0), "=&v"(y1) : "v"(a0), "v"(a1), "v"(b0), "v"(b1) : "memory");
    A = __builtin_shufflevector(x0, x1, 0, 1, 2, 3, 4, 5, 6, 7); B = __builtin_shufflevector(y0, y1, 0, 1, 2, 3, 4, 5, 6, 7);
}
__device__ __forceinline__ bf16x8 tr_frag(unsigned a0, unsigned a1) {
    s16x4 x0, x1;
    asm volatile("ds_read_b64_tr_b16 %0, %2\n\tds_read_b64_tr_b16 %1, %3\n\ts_waitcnt lgkmcnt(0)" : "=&v"(x0), "=&v"(x1) : "v"(a0), "v"(a1) : "memory");
    return __builtin_shufflevector(x0, x1, 0, 1, 2, 3, 4, 5, 6, 7);
}
__device__ __forceinline__ int crow(int reg, int h) { return (reg & 3) + 8 * (reg >> 2) + 4 * h; }

constexpr int SC_PK = 320, SC_PV = 192;
constexpr int SC_KIMG = 0, SC_VIMG = 2 * 64 * SC_PK, SC_WK = SC_VIMG + 2 * 64 * SC_PV, SC_SC = SC_WK + 2048 * 4, SC_BL = SC_SC + 32 * 4, SC_GM = SC_BL + 32 * 4, SC_MST = SC_GM + 32 * 4, SC_NV = SC_MST + 36 * 4, SC_CST = ((SC_NV + 128 * 4 + 15) / 16) * 16, SC_PC = 272, SC_END = SC_CST + 2 * 64 * SC_PC;
constexpr size_t WS_CST = WS_C;
constexpr size_t WS_BCUM = WS_GATES + 1 * MiB;
constexpr size_t WS_MST = WS_BCUM + 256 * 1024;
constexpr size_t WS_NST = WS_MST + 64 * 1024;
static_assert(SC_PK == 320 && SC_PV == 192, "sc_frags hard-codes the row offsets of the two images");
__device__ __forceinline__ void sc_frags(unsigned abase, unsigned bbase, bf16x8 (&A)[4], bf16x8 (&B)[4]) {
    s16x4 x[8], y[8];
    asm volatile("ds_read_b64_tr_b16 %0, %16\n\tds_read_b64_tr_b16 %1, %16 offset:1280\n\tds_read_b64_tr_b16 %8, %17\n\tds_read_b64_tr_b16 %9, %17 offset:768\n\t"
                 "ds_read_b64_tr_b16 %2, %16 offset:5120\n\tds_read_b64_tr_b16 %3, %16 offset:6400\n\tds_read_b64_tr_b16 %10, %17 offset:3072\n\tds_read_b64_tr_b16 %11, %17 offset:3840\n\t"
                 "ds_read_b64_tr_b16 %4, %16 offset:10240\n\tds_read_b64_tr_b16 %5, %16 offset:11520\n\tds_read_b64_tr_b16 %12, %17 offset:6144\n\tds_read_b64_tr_b16 %13, %17 offset:6912\n\t"
                 "ds_read_b64_tr_b16 %6, %16 offset:15360\n\tds_read_b64_tr_b16 %7, %16 offset:16640\n\tds_read_b64_tr_b16 %14, %17 offset:9216\n\tds_read_b64_tr_b16 %15, %17 offset:9984\n\ts_waitcnt lgkmcnt(0)"
                 : "=&v"(x[0]), "=&v"(x[1]), "=&v"(x[2]), "=&v"(x[3]), "=&v"(x[4]), "=&v"(x[5]), "=&v"(x[6]), "=&v"(x[7]),
                   "=&v"(y[0]), "=&v"(y[1]), "=&v"(y[2]), "=&v"(y[3]), "=&v"(y[4]), "=&v"(y[5]), "=&v"(y[6]), "=&v"(y[7])
                 : "v"(abase), "v"(bbase) : "memory");
#pragma unroll
    for (int k = 0; k < 4; ++k) { A[k] = __builtin_shufflevector(x[2 * k], x[2 * k + 1], 0, 1, 2, 3, 4, 5, 6, 7); B[k] = __builtin_shufflevector(y[2 * k], y[2 * k + 1], 0, 1, 2, 3, 4, 5, 6, 7); }
}
__device__ __forceinline__ void scan_unit(Frame& F, int unit, unsigned char* ws) {
    const int bh = unit >> 2, es = unit & 3, b = bh >> 2, h = bh & 3, tid = F.tid, lane = F.lane, wave = F.wave;
    LAS unsigned char* L = F.lds + RING_OFF;
    LAS float* wkS = (LAS float*)(L + SC_WK); LAS float* scS = (LAS float*)(L + SC_SC); LAS float* bLS = (LAS float*)(L + SC_BL); LAS float* gmS = (LAS float*)(L + SC_GM); LAS float* mstS = (LAS float*)(L + SC_MST); LAS float* nvS = (LAS float*)(L + SC_NV);
    float* bcumG = (float*)(ws + WS_BCUM) + (size_t)bh * 2048; float* mstG = (float*)(ws + WS_MST) + (size_t)bh * 64; float* nstG = (float*)(ws + WS_NST) + (size_t)bh * 32 * 128;
    bf16* cstG = (bf16*)(ws + WS_CST) + (size_t)bh * 32 * 256 * 128;
    const size_t rowb = (size_t)b * SEQ;
    __syncthreads();
    for (int cc = 0; cc < 4; ++cc) {
        const int c = 4 * wave + cc; const size_t row = rowb + 64 * c + lane;
        const float li = F.gates[row * 8 + h], lf = F.gates[row * 8 + 4 + h];
        float bsum = lf;
#pragma unroll
        for (int o = 1; o < 64; o <<= 1) { const float t = __shfl_up(bsum, o); if (lane >= o) bsum += t; }
        const float bL = __shfl(bsum, 63);
        const float g = bL - bsum + li;
        float gm = g;
#pragma unroll
        for (int o = 1; o < 64; o <<= 1) gm = fmaxf(gm, __shfl_xor(gm, o));
        wkS[64 * c + lane] = g;
        if (es == 0) bcumG[64 * c + lane] = bsum;
        if (lane == 0) { bLS[c] = bL; gmS[c] = gm; }
    }
    __syncthreads();
    if (tid == 0) { float m = 0.f; mstS[0] = 0.f;
        for (int c = 0; c < 32; ++c) { const float mn = fmaxf(bLS[c] + m, gmS[c]); scS[c] = __expf(bLS[c] + m - mn); m = mn; mstS[c + 1] = mn; } }
    __syncthreads();
    for (int i = tid; i < 2048; i += NWAVES * 64) wkS[i] = __expf(wkS[i] - mstS[(i >> 6) + 1]);
    if (es == 0 && tid < 33) mstG[tid] = mstS[tid];
    if (tid < 128) nvS[tid] = 0.f;
    const int dt = wave & 3, et = wave >> 2, hh = lane >> 5;
    f32x16 acc;
#pragma unroll
    for (int i = 0; i < 16; ++i) acc[i] = 0.f;
    const int kr0 = tid >> 4, kc0 = tid & 15;
    const int vr = tid >> 3, vc = tid & 7;
    const bf16* zk = F.Z + rowb * NZ + ZC_K + h * DK; const bf16* zv = F.Z + rowb * NZ + ZC_V + h * DV + 64 * es;
    v4u rkA0, rkA1, rvA, rkB0, rkB1, rvB, rkC0, rkC1, rvC, rkD0, rkD1, rvD;
#define SC_LOAD(c, rk0, rk1, rv) do { rk0 = *(const GAS v4u*)(zk + (size_t)(64 * (c) + kr0) * NZ + 8 * kc0); rk1 = *(const GAS v4u*)(zk + (size_t)(64 * (c) + kr0 + 32) * NZ + 8 * kc0); \
                        rv = *(const GAS v4u*)(zv + (size_t)(64 * (c) + vr) * NZ + 8 * vc); } while (0)
#define SC_WRITE(c, rk0, rk1, rv) do { LAS unsigned char* kb = L + SC_KIMG + ((c) & 1) * 64 * SC_PK; LAS unsigned char* vb = L + SC_VIMG + ((c) & 1) * 64 * SC_PV; \
                         *(LAS v4u*)(kb + kr0 * SC_PK + 16 * kc0) = rk0; *(LAS v4u*)(kb + (kr0 + 32) * SC_PK + 16 * kc0) = rk1; \
                         float vf[8]; unpack8(rv, vf); const float w_ = wkS[64 * (c) + vr]; v4u o_; o_.x = pk2(vf[0] * w_, vf[1] * w_); o_.y = pk2(vf[2] * w_, vf[3] * w_); o_.z = pk2(vf[4] * w_, vf[5] * w_); o_.w = pk2(vf[6] * w_, vf[7] * w_); \
                         *(LAS v4u*)(vb + vr * SC_PV + 16 * vc) = o_; } while (0)
    const unsigned lbase = (unsigned)(size_t)L;
#define SC_STAGE(cn) do { LAS unsigned char* st_ = L + SC_CST + ((cn) & 1) * 64 * SC_PC + (32 * et + (lane & 31)) * SC_PC + (32 * dt + 4 * hh) * 2; \
        _Pragma("unroll") for (int g = 0; g < 4; ++g) *(LAS unsigned long long*)(st_ + 16 * g) = (unsigned long long)pk2(acc[4 * g], acc[4 * g + 1]) | ((unsigned long long)pk2(acc[4 * g + 2], acc[4 * g + 3]) << 32); } while (0)
#define SC_STEP(c) do { \
        {   \
          _Pragma("unroll") for (int i_ = 0; i_ < 2; ++i_) { const int p_ = tid + 512 * i_, e_ = p_ >> 4, c16 = p_ & 15; \
              *(GAS v4u*)(cstG + ((size_t)(c) * 256 + 64 * es + e_) * 128 + 8 * c16) = *(const LAS v4u*)(L + SC_CST + ((c) & 1) * 64 * SC_PC + e_ * SC_PC + 16 * c16); } } \
        const float sc = scS[c]; \
        _Pragma("unroll") for (int i = 0; i < 16; ++i) acc[i] *= sc; \
        const unsigned kimg = lbase + SC_KIMG + ((c) & 1) * 64 * SC_PK, vimg = lbase + SC_VIMG + ((c) & 1) * 64 * SC_PV; \
        bf16x8 Af[4], Bf[4]; sc_frags(tr_addr(kimg, SC_PK, 0, 32 * dt, lane), tr_addr(vimg, SC_PV, 0, 32 * et, lane), Af, Bf); \
        _Pragma("unroll") for (int ks = 0; ks < 4; ++ks) acc = MFMA32(Af[ks], Bf[ks], acc); \
        if (es == 0 && et == 0) {     \
            float part = 0.f; \
            _Pragma("unroll") for (int ks = 0; ks < 4; ++ks) { const f32x4 w0 = *(const LAS f32x4*)(wkS + 64 * (c) + 16 * ks + 8 * hh), w1 = *(const LAS f32x4*)(wkS + 64 * (c) + 16 * ks + 8 * hh + 4); \
                const v4u kk = __builtin_bit_cast(v4u, Af[ks]); \
                part += (bf2f(kk.x & 0xffffu) * w0.x + bf2f(kk.x >> 16) * w0.y) + (bf2f(kk.y & 0xffffu) * w0.z + bf2f(kk.y >> 16) * w0.w) \
                      + (bf2f(kk.z & 0xffffu) * w1.x + bf2f(kk.z >> 16) * w1.y) + (bf2f(kk.w & 0xffffu) * w1.z + bf2f(kk.w >> 16) * w1.w); } \
            part += __shfl_xor(part, 32); \
            if (hh == 0) { const int d = 32 * dt + (lane & 31); const float nn = nvS[d]; nstG[(c) * 128 + d] = nn; nvS[d] = nn * sc + part; } } \
        SC_STAGE((c) + 1); } while (0)
    SC_LOAD(0, rkA0, rkA1, rvA); SC_LOAD(1, rkB0, rkB1, rvB); SC_LOAD(2, rkC0, rkC1, rvC); SC_LOAD(3, rkD0, rkD1, rvD);
    SC_STAGE(0);
    __syncthreads();
    SC_WRITE(0, rkA0, rkA1, rvA);
#pragma unroll 1
    for (int c = 0; c < 32; c += 4) {
        if (c + 4 < 32) SC_LOAD(c + 4, rkA0, rkA1, rvA);
        __syncthreads();
        SC_STEP(c);
        SC_WRITE(c + 1, rkB0, rkB1, rvB);
        if (c + 5 < 32) SC_LOAD(c + 5, rkB0, rkB1, rvB);
        __syncthreads();
        SC_STEP(c + 1);
        SC_WRITE(c + 2, rkC0, rkC1, rvC);
        if (c + 6 < 32) SC_LOAD(c + 6, rkC0, rkC1, rvC);
        __syncthreads();
        SC_STEP(c + 2);
        SC_WRITE(c + 3, rkD0, rkD1, rvD);
        if (c + 7 < 32) SC_LOAD(c + 7, rkD0, rkD1, rvD);
        __syncthreads();
        SC_STEP(c + 3);
        if (c + 4 < 32) SC_WRITE(c + 4, rkA0, rkA1, rvA);
    }
#undef SC_STEP
#undef SC_STAGE
    __syncthreads();
#undef SC_LOAD
#undef SC_WRITE
    { float* dst = F.out + O_PC + ((size_t)bh * 128 + 32 * dt) * 256 + 64 * es + 32 * et + (lane & 31);
#pragma unroll
      for (int i = 0; i < 16; ++i) dst[(size_t)crow(i, hh) * 256] = acc[i]; }
    if (es == 0 && tid < 128) F.out[O_PN + (size_t)bh * 128 + tid] = nvS[tid];
    if (es == 0 && tid == 0) F.out[O_PM + bh] = mstS[32];
    asm volatile("s_waitcnt vmcnt(0)" ::: "memory");
    __syncthreads();
    if (tid == 0) { __builtin_amdgcn_fence(__ATOMIC_RELEASE, "agent"); asm volatile("s_waitcnt vmcnt(0)" ::: "memory");
        __hip_atomic_fetch_add((unsigned*)(F.ctl + CW_SCAN) + 64 * bh, 1u, __ATOMIC_RELAXED, __HIP_MEMORY_SCOPE_AGENT); }
}
constexpr int P3_PQ = 272, P3_PKK = 272, P3_PV = 576, P3_PP = 144, P3_PH = 1040;
constexpr int P3_Q = 0, P3_K = P3_Q + 64 * P3_PQ, P3_V = P3_K + 64 * P3_PKK, P3_P = P3_V + 64 * P3_PV, P3_H = 0;
constexpr int P3_SM = 81920;
static_assert(P3_P + 64 * P3_PP <= P3_SM && 64 * P3_PH <= P3_SM, "P3 LDS map");
__device__ __forceinline__ void p3_item(Frame& F, int item, unsigned char* ws) {
    const int bh = item >> 5, c = item & 31, b = bh >> 2, h = bh & 3, tid = F.tid, lane = F.lane, wave = F.wave, hh = lane >> 5, l31 = lane & 31;
    LAS unsigned char* L = F.lds + RING_OFF;
    LAS float* sm = (LAS float*)(L + P3_SM); LAS float* bmS = sm; LAS float* aS = sm + 64; LAS float* aiS = sm + 128; LAS float* ddS = sm + 192; LAS float* rsS = sm + 256; LAS float* qnS = sm + 320; LAS float* mtS = sm + 384; LAS float* nvS = sm + 448;
    const size_t row0 = (size_t)b * SEQ + 64 * c;
    const bf16* cst = (const bf16*)(ws + WS_CST) + ((size_t)bh * 32 + c) * 256 * 128;
    __syncthreads();
    { const bf16* zq = F.Z + row0 * NZ + ZC_Q + h * DK; const bf16* zk = F.Z + row0 * NZ + ZC_K + h * DK; const bf16* zv = F.Z + row0 * NZ + ZC_V + h * DV;
#pragma unroll
      for (int i = 0; i < 2; ++i) { const int r = (tid >> 4) + 32 * i, cc = tid & 15;
          *(LAS v4u*)(L + P3_Q + r * P3_PQ + 16 * cc) = *(const GAS v4u*)(zq + (size_t)r * NZ + 8 * cc); *(LAS v4u*)(L + P3_K + r * P3_PKK + 16 * cc) = *(const GAS v4u*)(zk + (size_t)r * NZ + 8 * cc); }
#pragma unroll
      for (int i = 0; i < 4; ++i) { const int r = (tid >> 5) + 16 * i, cc = tid & 31; *(LAS v4u*)(L + P3_V + r * P3_PV + 16 * cc) = *(const GAS v4u*)(zv + (size_t)r * NZ + 8 * cc); } }
    if (wave == 0) {
        const float mc = ((const float*)(ws + WS_MST))[(size_t)bh * 64 + c];
        const float bt = ((const float*)(ws + WS_BCUM))[(size_t)bh * 2048 + 64 * c + lane];
        const float li = F.gates[(row0 + lane) * 8 + h];
        const float a = li - bt; float pm = a;
#pragma unroll
        for (int o = 1; o < 64; o <<= 1) { const float t = __shfl_up(pm, o); if (lane >= o) pm = fmaxf(pm, t); }
        const float mt = bt + fmaxf(mc, pm);
        bmS[lane] = bt - mt; aS[lane] = a; aiS[lane] = __expf(bt + mc - mt); mtS[lane] = mt; rsS[lane] = 0.f;
    }
    if (wave == 1) { const float* np = (const float*)(ws + WS_NST) + ((size_t)bh * 32 + c) * 128; nvS[lane] = np[lane]; nvS[64 + lane] = np[64 + lane]; }
    bf16x8 Cf[8];
    { const bf16* cp = cst + (size_t)(32 * wave + l31) * 128 + 8 * hh;
#pragma unroll
      for (int kd = 0; kd < 8; ++kd) Cf[kd] = *(const GAS bf16x8*)(cp + 16 * kd); }
    __syncthreads();
    { const int t = tid >> 3, part = tid & 7; float s = 0.f;
      const LAS unsigned short* qr = (const LAS unsigned short*)(L + P3_Q + t * P3_PQ) + 16 * part;
#pragma unroll
      for (int j = 0; j < 16; ++j) s += bf2f(qr[j]) * nvS[16 * part + j];
      s += __shfl_xor(s, 1); s += __shfl_xor(s, 2); s += __shfl_xor(s, 4);
      if (part == 0) qnS[t] = s * QSCALE; }
    if (wave < 3) {
        const int si = wave == 2 ? 1 : 0, ti = wave == 0 ? 0 : 1;
        f32x16 x;
#pragma unroll
        for (int i = 0; i < 16; ++i) x[i] = 0.f;
#pragma unroll
        for (int kd = 0; kd < 8; ++kd) {
            const bf16x8 A = *(const LAS bf16x8*)(L + P3_K + (32 * si + l31) * P3_PKK + (16 * kd + 8 * hh) * 2);
            const bf16x8 B = *(const LAS bf16x8*)(L + P3_Q + (32 * ti + l31) * P3_PQ + (16 * kd + 8 * hh) * 2);
            x = MFMA32(A, B, x);
        }
        const int t = 32 * ti + l31; const float bm = bmS[t]; float rsum = 0.f;
#pragma unroll
        for (int g = 0; g < 4; ++g) {
            float p[4];
#pragma unroll
            for (int j = 0; j < 4; ++j) { const int s = 32 * si + 8 * g + 4 * hh + j; const float w = (s <= t) ? __expf(bm + aS[s]) : 0.f; p[j] = x[4 * g + j] * QSCALE * w; rsum += p[j]; }
            *(LAS unsigned long long*)(L + P3_P + t * P3_PP + (32 * si + 8 * g + 4 * hh) * 2) = (unsigned long long)pk2(p[0], p[1]) | ((unsigned long long)pk2(p[2], p[3]) << 32);
        }
        rsum += __shfl_xor(rsum, 32);
        if (hh == 0) atomicAdd((float*)(rsS + t), rsum);
    }
    __syncthreads();
    if (tid < 64) { const float den = aiS[tid] * qnS[tid] + rsS[tid]; ddS[tid] = 1.f / fmaxf(fabsf(den), __expf(-mtS[tid])); }
    bf16x8 Vf[4];
    { const unsigned vimg = (unsigned)(size_t)(L + P3_V);
#pragma unroll
      for (int ks = 0; ks < 4; ++ks) Vf[ks] = tr_frag(tr_addr(vimg, P3_PV, 16 * ks, 32 * wave, lane), tr_addr(vimg, P3_PV, 16 * ks + 4, 32 * wave, lane)); }
    f32x16 n1[2], n2[2];
#pragma unroll
    for (int ti = 0; ti < 2; ++ti) {
#pragma unroll
        for (int i = 0; i < 16; ++i) { n1[ti][i] = 0.f; n2[ti][i] = 0.f; }
#pragma unroll
        for (int kd = 0; kd < 8; ++kd) { const bf16x8 A = *(const LAS bf16x8*)(L + P3_Q + (32 * ti + l31) * P3_PQ + (16 * kd + 8 * hh) * 2); n1[ti] = MFMA32(A, Cf[kd], n1[ti]); }
#pragma unroll
        for (int ks = 0; ks < 2 * (ti + 1); ++ks) { const bf16x8 A = *(const LAS bf16x8*)(L + P3_P + (32 * ti + l31) * P3_PP + (16 * ks + 8 * hh) * 2); n2[ti] = MFMA32(A, Vf[ks], n2[ti]); }
    }
    __syncthreads();
#pragma unroll
    for (int ti = 0; ti < 2; ++ti)
#pragma unroll
        for (int i = 0; i < 16; ++i) { const int t = 32 * ti + crow(i, hh);
            *(LAS float*)(L + P3_H + t * P3_PH + (32 * wave + l31) * 4) = (aiS[t] * QSCALE * n1[ti][i] + n2[ti][i]) * ddS[t]; }
    __syncthreads();
    { const int t = tid >> 3, j = tid & 7; f32x4 hv4[8]; float s = 0.f;
#pragma unroll
      for (int q = 0; q < 8; ++q) { hv4[q] = *(const LAS f32x4*)(L + P3_H + t * P3_PH + (32 * j + 4 * q) * 4); s += (hv4[q].x * hv4[q].x + hv4[q].y * hv4[q].y) + (hv4[q].z * hv4[q].z + hv4[q].w * hv4[q].w); }
      s += __shfl_xor(s, 1); s += __shfl_xor(s, 2); s += __shfl_xor(s, 4);
      const float rr = rsqrtf(s * (1.f / DV) + EPS);
      const bf16* zo = F.Z + (row0 + t) * NZ + ZC_O + h * DV + 32 * j; const float* gp = F.ml_g + h * DV + 32 * j; bf16* yo = F.YC + (row0 + t) * D + DC + h * DV + 32 * j;
#pragma unroll
      for (int q = 0; q < 4; ++q) { float o[8]; unpack8(*(const GAS v4u*)(zo + 8 * q), o);
          const f32x4 g0 = *(const GAS f32x4*)(gp + 8 * q), g1 = *(const GAS f32x4*)(gp + 8 * q + 4); const f32x4 a = hv4[2 * q], bq = hv4[2 * q + 1];
          v4u w; w.x = pk2(sigmoidf_(o[0]) * a.x * rr * g0.x, sigmoidf_(o[1]) * a.y * rr * g0.y); w.y = pk2(sigmoidf_(o[2]) * a.z * rr * g0.z, sigmoidf_(o[3]) * a.w * rr * g0.w);
          w.z = pk2(sigmoidf_(o[4]) * bq.x * rr * g1.x, sigmoidf_(o[5]) * bq.y * rr * g1.y); w.w = pk2(sigmoidf_(o[6]) * bq.z * rr * g1.z, sigmoidf_(o[7]) * bq.w * rr * g1.w);
          *(GAS v4u*)(yo + 8 * q) = w; } }
}
__device__ __forceinline__ void p2_phase(Frame& F, unsigned char* ws, bool w23_later, bool merge_p3, bool defer_state) {
    constexpr int NS = DB * NH, NC = 1152 / NWAVES, NTI = TR_I2 + 2 * TR_I3, NT = NTI / (2 * NWAVES), NP = 512;
    static_assert(NTI % (2 * NWAVES) == 0, "transposition items per group");
    const int nT = w23_later ? NT : 0, nP = merge_p3 ? NP : 0, NQ = NS + NC + nT + nP;
    if (F.G >= 64 && F.vcu < 64) scan_unit(F, F.vcu, ws);
    else if (F.G < 64) { for (int it = F.vcu; it < 64; it += F.G) scan_unit(F, it, ws); }
    unsigned* qh = (unsigned*)(F.ctl + CW_QUEUE);
    volatile LAS unsigned* qs = F.MISC + 16;
    bool acquired = false;
    unsigned nxt = 0;
    if (F.tid == 0) nxt = __hip_atomic_fetch_add(qh, 1u, __ATOMIC_RELAXED, __HIP_MEMORY_SCOPE_AGENT);
    for (;;) {
        __syncthreads();
        if (F.tid == 0) qs[0] = nxt;
        __syncthreads();
        const int i = __builtin_amdgcn_readfirstlane((int)qs[0]);
        asm volatile("" ::: "memory");
        if (i >= NQ) break;
        if (F.tid == 0) nxt = __hip_atomic_fetch_add(qh, 1u, __ATOMIC_RELAXED, __HIP_MEMORY_SCOPE_AGENT);
        Frame G = F; asm volatile("" : "+v"(G.tid), "+v"(G.lane));
        if (i < NS) { if (defer_state) sample_item<false>(G, i); else sample_item<true>(G, i); }
        else if (i < NS + NC) conv_item(G, (i - NS) * NWAVES + F.wave);
        else if (i < NS + NC + nT) { const int g = i - NS - NC; tr_run(G, TR_I1 + g * 2 * NWAVES, TR_I1 + (g + 1) * 2 * NWAVES, F.wave, NWAVES, (LAS float*)(F.lds + RING_OFF + F.wave * 16640)); }
        else {
            if (!acquired) {
                if (F.tid < 16) { unsigned* cw = (unsigned*)(F.ctl + CW_SCAN) + 64 * F.tid; unsigned spins = 0;
                    while (__hip_atomic_load(cw, __ATOMIC_RELAXED, __HIP_MEMORY_SCOPE_AGENT) < 4u) { __builtin_amdgcn_s_sleep(4); if (++spins > (1u << 20)) break; } }
                if (F.wave == 0) { __builtin_amdgcn_fence(__ATOMIC_ACQUIRE, "agent"); asm volatile("s_waitcnt vmcnt(0)" ::: "memory"); }
                __syncthreads(); acquired = true; }
            p3_item(G, i - NS - NC - nT, ws);
        }
    }
    __syncthreads();
}
__device__ __forceinline__ void p3_phase(Frame& F, unsigned char* ws) {
    for (int it = F.vcu; it < 512; it += F.G) p3_item(F, it, ws);
    __syncthreads();
}
struct Args { const float* in[19]; float* out; unsigned char* ws; int ph_lo, ph_hi, li, pad; };
__global__ void __launch_bounds__(NWAVES * 64, 2) mk_fwd(Args args) {
    extern __shared__ __attribute__((aligned(16))) unsigned char lds[];
    Frame F;
    F.lds = (LAS unsigned char*)lds;
    F.MISC = (volatile LAS unsigned*)(F.lds + MISC_OFF);
    F.tid = threadIdx.x; F.lane = F.tid & 63; F.wave = __builtin_amdgcn_readfirstlane(F.tid >> 6);
    F.G = gridDim.x; { const int bx = blockIdx.x; F.vcu = (F.G % 8 == 0) ? (bx % 8) * (F.G / 8) + bx / 8 : bx; }
    unsigned char* ws = args.ws;
    F.ctl = (gu32*)(ws + WS_CTL);
    F.x_p = args.in[0]; F.x_s = args.in[1]; F.st_conv = args.in[2]; F.st_C = args.in[3]; F.st_n = args.in[4]; F.st_m = args.in[5];
    F.g1 = args.in[6]; F.w_in = args.in[7]; F.b_i = args.in[8]; F.b_f = args.in[9]; F.conv_w = args.in[10]; F.conv_g = args.in[11]; F.ml_g = args.in[12];
    F.w_out = args.in[13]; F.g2 = args.in[14]; F.wg = args.in[15]; F.wu = args.in[16]; F.wd = args.in[17]; F.fg = args.in[18]; F.out = args.out;
    F.W1 = (bf16*)(ws + WS_W1); F.W2 = (bf16*)(ws + WS_W2); F.W3 = (bf16*)(ws + WS_W3); F.W4 = (bf16*)(ws + WS_W4);
    F.XN = (bf16*)(ws + WS_A); F.YC = (bf16*)(ws + WS_A); F.Z = (bf16*)(ws + WS_B); F.HB = (bf16*)(ws + WS_B); F.X1b = (bf16*)(ws + WS_C);
    F.gates = (float*)(ws + WS_GATES); F.ssq1 = (float*)(ws + WS_CTL) + CW_SSQ1; F.ssq2 = (float*)(ws + WS_CTL) + CW_SSQ2;
    for (int u = F.tid; u < (LDS_BYTES - LDSCTL_OFF) / 4; u += NWAVES * 64) ((LAS unsigned*)(F.lds + LDSCTL_OFF))[u] = 0u;
    __syncthreads();
    XcdBarrier bar = xcd_barrier_post((unsigned*)(F.ctl + CW_BAR) + args.li * XCD_BAR_WORDS, F.MISC + 8);
    const int lo = args.ph_lo, hi = args.ph_hi;
#define IN(k) (lo <= (k) && (k) < hi)
#ifndef PROBE_PHASE
#define PROBE_PHASE -1
#endif
#ifndef PROBE_MULT
#define PROBE_MULT 4
#endif
    unsigned long long pt0 = (PROBE_PHASE == 0) ? __builtin_amdgcn_s_memrealtime() : 0ull;
#define SEAM(k) do { if (IN(k) && IN((k) + 1)) xcd_barrier(bar); \
        if (PROBE_PHASE >= 0 && blockIdx.x == 0) { if ((k) + 1 == PROBE_PHASE) pt0 = __builtin_amdgcn_s_memrealtime(); \
            if ((k) == PROBE_PHASE) { const unsigned long long t1 = __builtin_amdgcn_s_memrealtime(); while (__builtin_amdgcn_s_memrealtime() - t1 < (unsigned long long)PROBE_MULT * (t1 - pt0)) __builtin_amdgcn_s_sleep(8); } __syncthreads(); } } while (0)

    constexpr bool use_fp8 = FFN2_FP8 != 0;
    const bool w4_later = (F.G == 256) && IN(0) && IN(5);
    const bool w23_later = w4_later && IN(2) && F.G >= 128;
    if (IN(0)) { p0_prologue(F, w4_later, w23_later); } SEAM(0);
    if (IN(1)) {
        pg8::Gemm g{F.XN, F.W1, M, NZ, D}; pg9::StaticOrder S; S.init(M, NZ, F.G, (int)blockIdx.x);
        pg9::EpiZ E{F.Z, NZ};
        pg9::gemm_phase<pg9::EpiZ>(F.lds + RING_OFF, g, S, E);
    } SEAM(1);
    const bool merge_p3 = IN(2) && IN(3);
    const bool defer_state = w4_later && IN(2);
    if (IN(2)) { p2_phase(F, ws, w23_later && F.G >= 128, merge_p3, defer_state); }
    if (merge_p3) { xcd_barrier(bar);
        if (PROBE_PHASE >= 0 && blockIdx.x == 0) { if (PROBE_PHASE == 4) pt0 = __builtin_amdgcn_s_memrealtime();
            if (PROBE_PHASE == 2) { const unsigned long long t1 = __builtin_amdgcn_s_memrealtime(); while (__builtin_amdgcn_s_memrealtime() - t1 < (unsigned long long)PROBE_MULT * (t1 - pt0)) __builtin_amdgcn_s_sleep(8); } __syncthreads(); } }
    else { SEAM(2); if (IN(3)) { p3_phase(F, ws); } SEAM(3); }
    if (IN(4)) {
        pg8::Gemm g{F.YC, F.W2, M, D, D}; pg9::StaticOrder S; S.init(M, D, F.G, (int)blockIdx.x);
        const bool x1_bf16 = (F.G == (M / pg9::BMR) * (D / pg9::BN)) && IN(6);
        pg9::EpiRes E{F.x_p, F.x_s, MP, x1_bf16 ? nullptr : F.out, F.X1b, F.ssq1};
        pg9::gemm_phase<pg9::EpiRes>(F.lds + RING_OFF, g, S, E);
    } SEAM(4);
    if (IN(5)) {
        pg8::Gemm g{F.X1b, F.W3, M, N3, D}; pg9::StaticOrder S; S.init(M, N3, F.G, (int)blockIdx.x);
        if constexpr (use_fp8) { pg9::EpiH8 E{(unsigned char*)F.HB, F.ssq1, (float)(1 << H8_EXP)}; pg9::gemm_phase<pg9::EpiH8>(F.lds + RING_OFF, g, S, E); }
        else { pg9::EpiH E{F.HB, F.ssq1}; pg9::gemm_phase<pg9::EpiH>(F.lds + RING_OFF, g, S, E); }
        if (w4_later && blockIdx.x >= 128) {
            LAS float* scr = (LAS float*)(F.lds + RING_OFF + F.wave * 16640);
            for (int it = ((int)blockIdx.x - 128) * NWAVES + F.wave; it < (FF / 64) * (D / 64); it += 128 * NWAVES) {
                if constexpr (use_fp8) p0_transpose_item_fp8(F.wd, D, FF, D / 64, F.W4, scr, it, F.lane, (float)(1 << W8_EXP));
                else p0_transpose_item(F.wd, D, FF, D / 64, F.W4, 0, nullptr, scr, it, F.lane); }
            if (defer_state) { for (int it = (int)blockIdx.x - 128; it < DB * NH; it += 128) sample_state_item(F, it); }
        }
    } SEAM(5);
    if (IN(6)) {
        pg8::Gemm g{F.HB, F.W4, M, D, use_fp8 ? FF / 2 : FF}; pg9::StaticOrder S; S.init(M, D, F.G, (int)blockIdx.x);
        if (F.G == (M / pg9::BMR) * (D / pg9::BN)) {
            pg9::EpiFinal E{F.out, F.ssq2, (unsigned*)(F.ctl + CW_CNT4), F.fg, IN(4) ? F.X1b : nullptr};
            if constexpr (use_fp8) pg9::gemm_phase<pg9::EpiFinal, true, true, 127 - H8_EXP, 127 - W8_EXP>(F.lds + RING_OFF, g, S, E);
            else pg9::gemm_phase<pg9::EpiFinal>(F.lds + RING_OFF, g, S, E);
        } else if constexpr (!use_fp8) {
            pg9::EpiRes E{F.out, F.out, M, F.out, nullptr, F.ssq2};
            pg9::gemm_phase<pg9::EpiRes>(F.lds + RING_OFF, g, S, E);
        }
    }
    if (F.G != (M / pg9::BMR) * (D / pg9::BN)) { SEAM(6); if (IN(7)) { final_norm_phase(F); } }
    if (PROBE_PHASE == 6 && blockIdx.x == 0) { const unsigned long long t1 = __builtin_amdgcn_s_memrealtime(); while (__builtin_amdgcn_s_memrealtime() - t1 < (unsigned long long)PROBE_MULT * (t1 - pt0)) __builtin_amdgcn_s_sleep(8); }
    if (PROBE_PHASE == 7) { xcd_barrier(bar); SEAM(7); }
#undef IN
#undef SEAM
}

extern "C" void kernel_launch(void* const* d_in, const int* in_sizes, int n_in, void* d_out, int out_size, void* d_ws, size_t ws_size, hipStream_t stream) {
    static int grid = 0;
    if (grid == 0) {
        if (n_in != 19 || (size_t)out_size != O_END || ws_size < WS_END) { fprintf(stderr, "kernel_launch: unexpected shapes: n_in %d out %d ws %zu; nothing launched\n", n_in, out_size, ws_size); grid = -1; return; }
        int dev = 0, cus = 0;
        if (hipGetDevice(&dev) != hipSuccess || hipDeviceGetAttribute(&cus, hipDeviceAttributeMultiprocessorCount, dev) != hipSuccess) { grid = -1; return; }
        if (hipFuncSetAttribute((const void*)mk_fwd, hipFuncAttributeMaxDynamicSharedMemorySize, LDS_BYTES) != hipSuccess) { fprintf(stderr, "kernel_launch: hipFuncSetAttribute failed\n"); grid = -1; return; }
        grid = cus;
        if (FFN2_FP8 && cus != 256) { fprintf(stderr, "kernel_launch: this build needs a 256-CU device (got %d); nothing launched\n", cus); grid = -1; return; }
    }
    if (grid < 0) return;
    unsigned char* ws = (unsigned char*)d_ws; float* out = (float*)d_out;
    (void)hipMemsetAsync(ws + WS_CTL, 0, CTL_ZERO_BYTES, stream);
    Args a{};
    for (int i = 0; i < 19; ++i) a.in[i] = (const float*)d_in[i];
    a.out = out; a.ws = ws;
    a.ph_lo = 0; a.ph_hi = 8; a.li = 0;
    hipLaunchKernelGGL(mk_fwd, dim3(grid), dim3(NWAVES * 64), LDS_BYTES, stream, a);
}
```

```cpp
#include <hip/hip_runtime.h>
#include <cstdio>
#include <cstdint>

constexpr int D = 2048, SEQ = 2048, NB = 4, DB = 128, DS = 8;
constexpr int MP = NB * SEQ, MS = DB * DS, M = MP + MS;
constexpr int DC = 1024, NH = 4, DK = 128, DV = 256;
constexpr int NZ = 6144, NIN = 6152, FF = 5632, N3 = 2 * FF;
constexpr float EPS = 1e-6f;
constexpr float QSCALE = 0.08838834764831845f;
#ifndef FFN2_FP8
#define FFN2_FP8 1
#endif
constexpr int H8_EXP = 3, W8_EXP = 8;
constexpr int ZC_BG = 0, ZC_CG = 1024, ZC_XT = 2048, ZC_Q = 3072, ZC_K = 3584, ZC_V = 4096, ZC_O = 5120;
constexpr size_t O_Y = 0, O_PCONV = 18874368, O_PC = 18882560, O_PN = 19406848, O_PM = 19408896,
                 O_SCONV = 19408912, O_SC = 19671056, O_SN = 36448272, O_SM = 36513808, O_END = 36514320;
constexpr size_t MiB = 1u << 20;
constexpr size_t WS_CTL = 0, CTL_ZERO_BYTES = 1 * MiB;
constexpr size_t WS_W1 = 1 * MiB, WS_W2 = 25 * MiB, WS_W3 = 33 * MiB, WS_W4 = 77 * MiB;
constexpr size_t WS_A = 99 * MiB;
constexpr size_t WS_B = 135 * MiB;
constexpr size_t WS_C = 243 * MiB;
constexpr size_t WS_GATES = WS_C + 36 * MiB;
constexpr size_t WS_END = 283 * MiB;
constexpr int CW_TMO = 0, CW_CODE = 1;
constexpr int CW_BAR = 4096;
constexpr int CW_QUEUE = 30656;
constexpr int CW_SCAN = 30720;
constexpr int CW_CNT4 = 32768;
constexpr int CW_SSQ1 = 65536, CW_SSQ2 = 65536 + 16384;
constexpr int NWAVES = 8;
constexpr int RING_OFF = 0, RING_BYTES = 139264;
constexpr int LDSCTL_OFF = RING_BYTES, MISC_OFF = LDSCTL_OFF + 320;
constexpr int LDS_BYTES = 147456;

namespace pg8 {
#define PG8_LAS __attribute__((address_space(3)))
typedef unsigned short bf16_t;
typedef short bf16x8 __attribute__((ext_vector_type(8)));
typedef float f32x4 __attribute__((ext_vector_type(4)));
typedef unsigned u32x4 __attribute__((ext_vector_type(4)));
constexpr int BM = 256, BK = 64, HALF = 128, HTB = HALF * BK * 2  , STAGE_BYTES = 8 * HTB, NXCD = 8, WGM = 8;

__host__ __device__ __forceinline__ int lds_byte(int r, int c) { const int st = (r >> 4) * 2 + (c >> 5), rr = r & 15, cc = c & 31, ob = rr * 64 + cc * 2; return st * 1024 + (ob ^ (((ob >> 9) & 1) << 5)); }
__host__ __device__ __forceinline__ void stage_rc(int b, int& R, int& C) { const int st = b / 1024, sb = b % 1024, swz = sb ^ (((sb >> 9) & 1) << 5); R = (st >> 1) * 16 + swz / 64; C = (st & 1) * 32 + (swz % 64) / 2; }
__host__ __device__ __forceinline__ int perm32(int rho) { const int n = rho >> 4, i = rho & 15; return 8 * (i >> 2) + 4 * n + (i & 3); }

struct Unit { int pm, pn; };
struct Gemm { const bf16_t* A; const bf16_t* Bt; int M, N, K; };

struct StaticOrder {
    int nM, nN, nwg, G, c;
    __host__ __device__ void init(int M, int N, int G_, int c_) { nM = M / BM; nN = N / BM; nwg = nM * nN; G = G_; c = c_; }
    __host__ __device__ bool next(int i, Unit& u) const {
        const long L = (long)i * G + c; if (L >= nwg) return false;
        int wgid = (int)L; { const int q = nwg / NXCD, r = nwg % NXCD, xcd = wgid % NXCD, off = wgid / NXCD; wgid = (xcd < r ? xcd * (q + 1) : r * (q + 1) + (xcd - r) * q) + off; }
        const int nig = WGM * nN, gid = wgid / nig, fm = gid * WGM, gsz = (nM - fm) < WGM ? (nM - fm) : WGM;
        u.pm = fm + ((wgid % nig) % gsz); u.pn = (wgid % nig) / gsz; return true;
    }
    __device__ __forceinline__ void a_ready(const Unit&) const {}
    __device__ __forceinline__ void done(const Unit&) const {}
};
__device__ __forceinline__ unsigned cvt_pk_bf16(float lo, float hi) { unsigned r; asm volatile("v_cvt_pk_bf16_f32 %0, %1, %2" : "=v"(r) : "v"(lo), "v"(hi)); return r; }
typedef float f32x2 __attribute__((ext_vector_type(2)));
}
namespace pg9 {
using pg8::lds_byte; using pg8::stage_rc; using pg8::perm32; using pg8::cvt_pk_bf16; using pg8::bf16_t; using pg8::bf16x8; using pg8::f32x4; using pg8::u32x4; using pg8::Gemm;
constexpr int BMR = 288, BN = 256, BK = 64, HALF = 128, TH = 96, ATB = TH * BK * 2  , HTB = HALF * BK * 2  , STAGE_BYTES = 6 * ATB + 4 * HTB  , NXCD = 8, WGM = 8;
typedef int v8i __attribute__((ext_vector_type(8))); typedef int v4i __attribute__((ext_vector_type(4)));
__device__ __forceinline__ v8i cat8(bf16x8 lo, bf16x8 hi) { const v4i a = __builtin_bit_cast(v4i, lo), b = __builtin_bit_cast(v4i, hi); return __builtin_shufflevector(a, b, 0, 1, 2, 3, 4, 5, 6, 7); }
struct Unit { int pm, pn; };
struct StaticOrder {
    int nM, nN, nwg, G, c;
    __host__ __device__ void init(int M, int N, int G_, int c_) { nM = M / BMR; nN = N / BN; nwg = nM * nN; G = G_; c = c_; }
    __host__ __device__ bool next(int i, Unit& u) const {
        const long L = (long)i * G + c; if (L >= nwg) return false;
        int wgid = (int)L; { const int q = nwg / NXCD, r = nwg % NXCD, xcd = wgid % NXCD, off = wgid / NXCD; wgid = (xcd < r ? xcd * (q + 1) : r * (q + 1) + (xcd - r) * q) + off; }
        const int nig = WGM * nN, gid = wgid / nig, fm = gid * WGM, gsz = (nM - fm) < WGM ? (nM - fm) : WGM;
        u.pm = fm + ((wgid % nig) % gsz); u.pn = (wgid % nig) / gsz; return true;
    }
};
typedef f32x4 Acc[3][2][3][2];

struct EpiZ {
    bf16_t* O; int ldc;
    __device__ __forceinline__ void operator()(Acc& acc, const Unit& u, int wr, int wc, int fr, int fq) const {
        const int row0 = u.pm * BMR + wr * 144 + fr, col0 = u.pn * BN + wc * 32 + 8 * fq;
#pragma unroll
        for (int ai = 0; ai < 3; ++ai)
#pragma unroll
            for (int m = 0; m < 3; ++m) { bf16_t* rowp = O + (size_t)(row0 + ai * 48 + m * 16) * ldc + col0;
#pragma unroll
                for (int bj = 0; bj < 2; ++bj) { const f32x4 v0 = acc[ai][bj][m][0], v1 = acc[ai][bj][m][1];
                    u32x4 w; w.x = cvt_pk_bf16(v0[0], v0[1]); w.y = cvt_pk_bf16(v0[2], v0[3]); w.z = cvt_pk_bf16(v1[0], v1[1]); w.w = cvt_pk_bf16(v1[2], v1[3]);
                    *(u32x4*)(rowp + bj * HALF) = w; } }
    }
};
struct EpiRes {
    const float* xp; const float* xs; int rows_p; float* out; bf16_t* X1b; float* ssq;
    __device__ __forceinline__ const float* xrow(int row, int col0) const { return (row < rows_p ? xp + (size_t)row * 2048 : xs + (size_t)(row - rows_p) * 2048) + col0; }
    __device__ __forceinline__ void operator()(Acc& acc, const Unit& u, int wr, int wc, int fr, int fq) const {
        const int row0 = u.pm * BMR + wr * 144 + fr, col0 = u.pn * BN + wc * 32 + 8 * fq;
        f32x4 xr[2][4];
#define EPI_LOADX(g) do { const float* p_ = xrow(row0 + ((g) / 3) * 48 + ((g) % 3) * 16, col0); xr[(g) % 2][0] = *(const f32x4*)(p_); xr[(g) % 2][1] = *(const f32x4*)(p_ + 4); xr[(g) % 2][2] = *(const f32x4*)(p_ + HALF); xr[(g) % 2][3] = *(const f32x4*)(p_ + HALF + 4); } while (0)
        EPI_LOADX(0); EPI_LOADX(1);
#pragma unroll
        for (int g = 0; g < 9; ++g) {
            const int ai = g / 3, m = g % 3, row = row0 + ai * 48 + m * 16;
            float* orow = out + (size_t)row * 2048 + col0; float s = 0.f;
            f32x4 v[2][2];
#pragma unroll
            for (int bj = 0; bj < 2; ++bj) { v[bj][0] = acc[ai][bj][m][0] + xr[g % 2][2 * bj]; v[bj][1] = acc[ai][bj][m][1] + xr[g % 2][2 * bj + 1]; }
            asm volatile("" : "+v"(v[0][0]), "+v"(v[0][1]), "+v"(v[1][0]), "+v"(v[1][1]));
            if (g + 2 < 9) EPI_LOADX(g + 2);
#pragma unroll
            for (int bj = 0; bj < 2; ++bj) { const f32x4 v0 = v[bj][0], v1 = v[bj][1];
                if (out) { *(f32x4*)(orow + bj * HALF) = v0; *(f32x4*)(orow + bj * HALF + 4) = v1; }
                s += (v0[0] * v0[0] + v0[1] * v0[1]) + (v0[2] * v0[2] + v0[3] * v0[3]) + (v1[0] * v1[0] + v1[1] * v1[1]) + (v1[2] * v1[2] + v1[3] * v1[3]);
                if (X1b) { u32x4 w; w.x = cvt_pk_bf16(v0[0], v0[1]); w.y = cvt_pk_bf16(v0[2], v0[3]); w.z = cvt_pk_bf16(v1[0], v1[1]); w.w = cvt_pk_bf16(v1[2], v1[3]);
                    *(u32x4*)(X1b + (size_t)row * 2048 + col0 + bj * HALF) = w; } }
            s += __shfl_xor(s, 16); s += __shfl_xor(s, 32);
            if (fq == 0) atomicAdd(ssq + row, s);
        }
#undef EPI_LOADX
    }
};
struct EpiH {
    bf16_t* H; const float* ssq;
    __device__ __forceinline__ void operator()(Acc& acc, const Unit& u, int wr, int wc, int fr, int fq) const {
        const int row0 = u.pm * BMR + wr * 144 + fr, col0 = u.pn * HALF + wc * 32 + 8 * fq;
#pragma unroll
        for (int ai = 0; ai < 3; ++ai)
#pragma unroll
            for (int m = 0; m < 3; ++m) {
                const int row = row0 + ai * 48 + m * 16;
                const float r = rsqrtf(ssq[row] * (1.0f / 2048.0f) + 1e-6f);
                float h[8];
#pragma unroll
                for (int n = 0; n < 2; ++n)
#pragma unroll
                    for (int j = 0; j < 4; ++j) { const float g = acc[ai][0][m][n][j] * r, up = acc[ai][1][m][n][j] * r;
                        h[4 * n + j] = g * __builtin_amdgcn_rcpf(1.0f + __expf(-g)) * up; }
                u32x4 w; w.x = cvt_pk_bf16(h[0], h[1]); w.y = cvt_pk_bf16(h[2], h[3]); w.z = cvt_pk_bf16(h[4], h[5]); w.w = cvt_pk_bf16(h[6], h[7]);
                *(u32x4*)(H + (size_t)row * 5632 + col0) = w;
            }
    }
};

struct EpiH8 {
    unsigned char* H; const float* ssq; float hsc;
    __device__ __forceinline__ void operator()(Acc& acc, const Unit& u, int wr, int wc, int fr, int fq) const {
        const int row0 = u.pm * BMR + wr * 144 + fr, col0 = u.pn * HALF + wc * 32 + 8 * fq;
#pragma unroll
        for (int ai = 0; ai < 3; ++ai)
#pragma unroll
            for (int m = 0; m < 3; ++m) {
                const int row = row0 + ai * 48 + m * 16;
                const float r = rsqrtf(ssq[row] * (1.0f / 2048.0f) + 1e-6f), nr = r * -1.4426950408889634f, rr = r * r * hsc;
                float h[8];
#pragma unroll
                for (int n = 0; n < 2; ++n)
#pragma unroll
                    for (int j = 0; j < 4; j += 2) {
                        const pg8::f32x2 ga = {acc[ai][0][m][n][j], acc[ai][0][m][n][j + 1]}, ua = {acc[ai][1][m][n][j], acc[ai][1][m][n][j + 1]};
                        const pg8::f32x2 e = ga * nr, t = ga * ua * rr;
                        pg8::f32x2 d = {__builtin_amdgcn_exp2f(e.x), __builtin_amdgcn_exp2f(e.y)}; d = d + 1.0f;
                        const pg8::f32x2 q = t * (pg8::f32x2){__builtin_amdgcn_rcpf(d.x), __builtin_amdgcn_rcpf(d.y)};
                        h[4 * n + j] = __builtin_amdgcn_fmed3f(q.x, -448.f, 448.f); h[4 * n + j + 1] = __builtin_amdgcn_fmed3f(q.y, -448.f, 448.f); }
                int w0 = __builtin_amdgcn_cvt_pk_fp8_f32(h[0], h[1], 0, false); w0 = __builtin_amdgcn_cvt_pk_fp8_f32(h[2], h[3], w0, true);
                int w1 = __builtin_amdgcn_cvt_pk_fp8_f32(h[4], h[5], 0, false); w1 = __builtin_amdgcn_cvt_pk_fp8_f32(h[6], h[7], w1, true);
                *(unsigned long long*)(H + (size_t)row * 5632 + col0) = (unsigned long long)(unsigned)w0 | ((unsigned long long)(unsigned)w1 << 32);
            }
    }
};
struct EpiFinal {
    float* out; float* ssq; unsigned* cnt; const float* fg; const bf16_t* x1b;
    __device__ __forceinline__ void operator()(Acc& acc, const Unit& u, int wr, int wc, int fr, int fq) const {
        const int row0 = u.pm * BMR + wr * 144 + fr, col0 = u.pn * BN + wc * 32 + 8 * fq;
        { f32x4 xr[2][4];
#define EPI_LOADX(g) do { const size_t o_ = (size_t)(row0 + ((g) / 3) * 48 + ((g) % 3) * 16) * 2048 + col0; \
            if (x1b) { const u32x4 a_ = *(const u32x4*)(x1b + o_), b_ = *(const u32x4*)(x1b + o_ + HALF); \
                xr[(g) % 2][0] = (f32x4){__uint_as_float(a_.x << 16), __uint_as_float(a_.x & 0xffff0000u), __uint_as_float(a_.y << 16), __uint_as_float(a_.y & 0xffff0000u)}; \
                xr[(g) % 2][1] = (f32x4){__uint_as_float(a_.z << 16), __uint_as_float(a_.z & 0xffff0000u), __uint_as_float(a_.w << 16), __uint_as_float(a_.w & 0xffff0000u)}; \
                xr[(g) % 2][2] = (f32x4){__uint_as_float(b_.x << 16), __uint_as_float(b_.x & 0xffff0000u), __uint_as_float(b_.y << 16), __uint_as_float(b_.y & 0xffff0000u)}; \
                xr[(g) % 2][3] = (f32x4){__uint_as_float(b_.z << 16), __uint_as_float(b_.z & 0xffff0000u), __uint_as_float(b_.w << 16), __uint_as_float(b_.w & 0xffff0000u)}; } \
            else { const float* p_ = out + o_; xr[(g) % 2][0] = *(const f32x4*)(p_); xr[(g) % 2][1] = *(const f32x4*)(p_ + 4); xr[(g) % 2][2] = *(const f32x4*)(p_ + HALF); xr[(g) % 2][3] = *(const f32x4*)(p_ + HALF + 4); } } while (0)
          EPI_LOADX(0); EPI_LOADX(1);
#pragma unroll
          for (int g = 0; g < 9; ++g) {
              const int ai = g / 3, m = g % 3, row = row0 + ai * 48 + m * 16; float s = 0.f;
#pragma unroll
              for (int bj = 0; bj < 2; ++bj) { acc[ai][bj][m][0] += xr[g % 2][2 * bj]; acc[ai][bj][m][1] += xr[g % 2][2 * bj + 1]; }
              asm volatile("" : "+v"(acc[ai][0][m][0]), "+v"(acc[ai][0][m][1]), "+v"(acc[ai][1][m][0]), "+v"(acc[ai][1][m][1]));
              if (g + 2 < 9) EPI_LOADX(g + 2);
#pragma unroll
              for (int bj = 0; bj < 2; ++bj) { const f32x4 v0 = acc[ai][bj][m][0], v1 = acc[ai][bj][m][1];
                  s += (v0[0] * v0[0] + v0[1] * v0[1]) + (v0[2] * v0[2] + v0[3] * v0[3]) + (v1[0] * v1[0] + v1[1] * v1[1]) + (v1[2] * v1[2] + v1[3] * v1[3]); }
              s += __shfl_xor(s, 16); s += __shfl_xor(s, 32);
              if (fq == 0) atomicAdd(ssq + row, s);
          }
#undef EPI_LOADX
        }
        asm volatile("s_waitcnt vmcnt(0)" ::: "memory");
        unsigned* cw = cnt + 64 * u.pm;
        if ((threadIdx.x & 63) == 0) __hip_atomic_fetch_add(cw, 1u, __ATOMIC_RELAXED, __HIP_MEMORY_SCOPE_AGENT);
        { unsigned spins = 0;
          while ((unsigned)__builtin_amdgcn_readfirstlane(__hip_atomic_load(cw, __ATOMIC_RELAXED, __HIP_MEMORY_SCOPE_AGENT)) < 64u) { __builtin_amdgcn_s_sleep(2); if (++spins > (1u << 20)) break; } }
        f32x4 gv[2][2];
#pragma unroll
        for (int bj = 0; bj < 2; ++bj) { gv[bj][0] = *(const f32x4*)(fg + col0 + bj * HALF); gv[bj][1] = *(const f32x4*)(fg + col0 + bj * HALF + 4); }
#pragma unroll
        for (int ai = 0; ai < 3; ++ai)
#pragma unroll
            for (int m = 0; m < 3; ++m) {
                const int row = row0 + ai * 48 + m * 16; float* orow = out + (size_t)row * 2048 + col0;
                const float tot = __hip_atomic_load(ssq + row, __ATOMIC_RELAXED, __HIP_MEMORY_SCOPE_AGENT);
                const float r = rsqrtf(tot * (1.0f / 2048.0f) + 1e-6f);
#pragma unroll
                for (int bj = 0; bj < 2; ++bj) { *(f32x4*)(orow + bj * HALF) = acc[ai][bj][m][0] * r * gv[bj][0]; *(f32x4*)(orow + bj * HALF + 4) = acc[ai][bj][m][1] * r * gv[bj][1]; }
            }
    }
};

template <class Epi, bool ALIGN_EPI = true, bool FP8 = false, int SCA = 127, int SCB = 127>
__device__ __forceinline__ void gemm_phase(PG8_LAS unsigned char* lds, const Gemm g, const StaticOrder& S, const Epi& E) {
    const int tid = threadIdx.x, wid = __builtin_amdgcn_readfirstlane(tid >> 6), lane = tid & 63, wr = wid >> 2, wc = wid & 3, fr = lane & 15, fq = lane >> 4;
    const int K = g.K, nt = K / BK;
    unsigned voffA[2], voffB[2];
#pragma unroll
    for (int i = 0; i < 2; ++i) { const int R = 8 * (wid + 8 * i) + (lane >> 3), C = 8 * ((lane & 7) ^ (R & 7)); const int Ra = 144 * (R / 48) + (R % 48);
        voffA[i] = (unsigned)(Ra * K + C) * 2u;
        voffB[i] = (unsigned)((wid + 8 * i) * (K >> 6)) * 1024u + (unsigned)((lane >> 3) * 128 + (((lane & 7) ^ (lane >> 3)) << 4)); }
    const size_t kstep = (size_t)(BK * 2);
    const size_t kstepB = 1024;
    const size_t hstep = (size_t)HALF * K * 2;
    const size_t thA = (size_t)48 * K * 2;
    const size_t tstepA = (size_t)BMR * K * 2, tstepB = (size_t)BN * K * 2;
    const unsigned ldsw = (unsigned)wid * 1024u;
    const int aoff0 = (wr * 48 + fr) * 128 + ((fq ^ (fr & 7)) << 4), aoff1 = (wr * 48 + fr) * 128 + (((fq + 4) ^ (fr & 7)) << 4);
    const int boff0 = (wc * 32 + fr) * 128 + ((fq ^ (fr & 7)) << 4), boff1 = (wc * 32 + fr) * 128 + (((fq + 4) ^ (fr & 7)) << 4);
#define PG9_SA(b, a) (((b) * 3 + (a)) * ATB)
#define PG9_SB(b, h) (6 * ATB + ((b) * 2 + (h)) * HTB)
#define PG9_STAGE_B(bufoff, gbase) do { _Pragma("unroll") for (int _i = 0; _i < 2; ++_i) \
        __builtin_amdgcn_global_load_lds((const unsigned*)((const char*)(gbase) + voffB[_i]), (PG8_LAS unsigned*)(lds + (bufoff) + ldsw + _i * 8192), 16, 0, 0); } while (0)
#define PG9_STAGE_A(bufoff, gbase) do { __builtin_amdgcn_global_load_lds((const unsigned*)((const char*)(gbase) + voffA[0]), (PG8_LAS unsigned*)(lds + (bufoff) + ldsw), 16, 0, 0); \
        if (wr == 0) __builtin_amdgcn_global_load_lds((const unsigned*)((const char*)(gbase) + voffA[1]), (PG8_LAS unsigned*)(lds + (bufoff) + ldsw + 8192), 16, 0, 0); } while (0)
#define PG9_LDA(dst, b, a) do { _Pragma("unroll") for (int m = 0; m < 3; ++m) { if constexpr (FP8) { dst##8[m] = cat8(*(const PG8_LAS bf16x8*)(lds + PG9_SA(b, a) + aoff0 + m * 2048), *(const PG8_LAS bf16x8*)(lds + PG9_SA(b, a) + aoff1 + m * 2048)); } \
        else { dst[m][0] = *(const PG8_LAS bf16x8*)(lds + PG9_SA(b, a) + aoff0 + m * 2048); dst[m][1] = *(const PG8_LAS bf16x8*)(lds + PG9_SA(b, a) + aoff1 + m * 2048); } } } while (0)
#define PG9_LDB(dst, b, h) do { int _b0 = boff0, _b1 = boff1; asm volatile("" : "+v"(_b0), "+v"(_b1));     \
        _Pragma("unroll") for (int n = 0; n < 2; ++n) { if constexpr (FP8) { dst##8[n] = cat8(*(const PG8_LAS bf16x8*)(lds + PG9_SB(b, h) + _b0 + n * 2048), *(const PG8_LAS bf16x8*)(lds + PG9_SB(b, h) + _b1 + n * 2048)); } \
        else { dst[n][0] = *(const PG8_LAS bf16x8*)(lds + PG9_SB(b, h) + _b0 + n * 2048); dst[n][1] = *(const PG8_LAS bf16x8*)(lds + PG9_SB(b, h) + _b1 + n * 2048); } } } while (0)
#define PG9_MMA(ai, bj, At, Bt) do { __builtin_amdgcn_s_setprio(1); _Pragma("unroll") for (int m = 0; m < 3; ++m) _Pragma("unroll") for (int n = 0; n < 2; ++n) { \
        if constexpr (FP8) { acc[ai][bj][m][n] = __builtin_amdgcn_mfma_scale_f32_16x16x128_f8f6f4(Bt##8[n], At##8[m], acc[ai][bj][m][n], 0, 0, 0, SCB, 0, SCA); } \
        else { _Pragma("unroll") for (int k = 0; k < 2; ++k) acc[ai][bj][m][n] = __builtin_amdgcn_mfma_f32_16x16x32_bf16(Bt[n][k], At[m][k], acc[ai][bj][m][n], 0, 0, 0); } } __builtin_amdgcn_s_setprio(0); } while (0)
#define PG9_WAIT_V(n0, n1) do { if (wr == 0) asm volatile("s_waitcnt vmcnt(" #n0 ")" ::: "memory"); else asm volatile("s_waitcnt vmcnt(" #n1 ")" ::: "memory"); } while (0)
#define PG9_WAIT_L0 asm volatile("s_waitcnt lgkmcnt(0)" ::: "memory")
#define PG9_BAR __builtin_amdgcn_s_barrier()
#define PG9_SCHED __builtin_amdgcn_sched_barrier(0)
#define PG9_PIN(ai) do { if constexpr (FP8) asm volatile("" : "+v"(acc[ai][0][0][0]), "+v"(acc[ai][0][0][1]), "+v"(acc[ai][0][1][0]), "+v"(acc[ai][0][1][1]), "+v"(acc[ai][0][2][0]), "+v"(acc[ai][0][2][1]), \
        "+v"(acc[ai][1][0][0]), "+v"(acc[ai][1][0][1]), "+v"(acc[ai][1][1][0]), "+v"(acc[ai][1][1][1]), "+v"(acc[ai][1][2][0]), "+v"(acc[ai][1][2][1])); } while (0)
#define PG9_SCHED8 do { if constexpr (FP8) __builtin_amdgcn_sched_barrier(0); } while (0)
#define PG9_ZERO() do { _Pragma("unroll") for (int a = 0; a < 3; ++a) _Pragma("unroll") for (int b = 0; b < 2; ++b) _Pragma("unroll") for (int m = 0; m < 3; ++m) _Pragma("unroll") for (int n = 0; n < 2; ++n) acc[a][b][m][n] = (f32x4){0.f, 0.f, 0.f, 0.f}; } while (0)
    Unit cur, nxt; int ui = 0;
    if (!S.next(0, cur)) return;
    Acc acc; PG9_ZERO();
    bf16x8 At[3][2], B0[2][2], B1[2][2];
    v8i At8[3], B08[2], B18[2];
    const char* cA = (const char*)g.A + (size_t)cur.pm * tstepA; const char* cB = (const char*)g.Bt + (size_t)cur.pn * tstepB;
    PG9_STAGE_B(PG9_SB(0, 0), cB); PG9_STAGE_A(PG9_SA(0, 0), cA); PG9_STAGE_B(PG9_SB(0, 1), cB + hstep); PG9_STAGE_A(PG9_SA(0, 1), cA + thA); PG9_STAGE_A(PG9_SA(0, 2), cA + 2 * thA);
    PG9_STAGE_B(PG9_SB(1, 0), cB + kstepB); PG9_STAGE_A(PG9_SA(1, 0), cA + kstep); PG9_STAGE_B(PG9_SB(1, 1), cB + hstep + kstepB); PG9_STAGE_A(PG9_SA(1, 1), cA + thA + kstep);
    if (wr == 1) PG9_BAR;
    PG9_WAIT_V(12, 8); PG9_BAR; PG9_BAR;
    for (;;) {
        const bool has_next = S.next(ui + 1, nxt);
        const char* nA = has_next ? (const char*)g.A + (size_t)nxt.pm * tstepA : cA; const char* nB = has_next ? (const char*)g.Bt + (size_t)nxt.pn * tstepB : cB;
        for (int t = 0; t < nt; t += 2) {
            const bool last = (t == nt - 2);
            const char* a1 = cA + (size_t)(t + 1) * kstep;
            const char* a2 = last ? nA : cA + (size_t)(t + 2) * kstep; const char* b2 = last ? nB : cB + (size_t)(t + 2) * kstepB;
            const char* a3 = a2 + kstep; const char* b3 = b2 + kstepB;
            PG9_LDB(B0, 0, 0); PG9_LDB(B1, 0, 1); PG9_SCHED; PG9_LDA(At, 0, 0); PG9_STAGE_A(PG9_SA(1, 2), a1 + 2 * thA);
            PG9_WAIT_V(12, 8); PG9_WAIT_L0; PG9_BAR; PG9_SCHED8; PG9_MMA(0, 0, At, B0); PG9_MMA(0, 1, At, B1); PG9_PIN(0); PG9_SCHED8; PG9_BAR; PG9_SCHED;
            PG9_LDA(At, 0, 1); PG9_STAGE_B(PG9_SB(0, 0), b2); PG9_STAGE_A(PG9_SA(0, 0), a2);
            PG9_WAIT_V(14, 10); PG9_WAIT_L0; PG9_BAR; PG9_SCHED8; PG9_MMA(1, 0, At, B0); PG9_MMA(1, 1, At, B1); PG9_PIN(1); PG9_SCHED8; PG9_BAR; PG9_SCHED;
            PG9_LDA(At, 0, 2); PG9_STAGE_B(PG9_SB(0, 1), b2 + hstep); PG9_STAGE_A(PG9_SA(0, 1), a2 + thA);
            PG9_WAIT_V(12, 8); PG9_WAIT_L0; PG9_BAR; PG9_SCHED8; PG9_MMA(2, 0, At, B0); PG9_MMA(2, 1, At, B1); PG9_PIN(2); PG9_SCHED8; PG9_BAR; PG9_SCHED;
            PG9_LDB(B0, 1, 0); PG9_LDB(B1, 1, 1); PG9_SCHED; PG9_LDA(At, 1, 0); PG9_STAGE_A(PG9_SA(0, 2), a2 + 2 * thA);
            PG9_WAIT_V(12, 8); PG9_WAIT_L0; PG9_BAR; PG9_SCHED8; PG9_MMA(0, 0, At, B0); PG9_MMA(0, 1, At, B1); PG9_PIN(0); PG9_SCHED8; PG9_BAR; PG9_SCHED;
            PG9_LDA(At, 1, 1); PG9_STAGE_B(PG9_SB(1, 0), b3); PG9_STAGE_A(PG9_SA(1, 0), a3);
            PG9_WAIT_V(14, 10); PG9_WAIT_L0; PG9_BAR; PG9_SCHED8; PG9_MMA(1, 0, At, B0); PG9_MMA(1, 1, At, B1); PG9_PIN(1); PG9_SCHED8; PG9_BAR; PG9_SCHED;
            PG9_LDA(At, 1, 2); PG9_STAGE_B(PG9_SB(1, 1), b3 + hstep); PG9_STAGE_A(PG9_SA(1, 1), a3 + thA);
            PG9_WAIT_V(12, 8); PG9_WAIT_L0; PG9_BAR; PG9_SCHED8; PG9_MMA(2, 0, At, B0); PG9_MMA(2, 1, At, B1); PG9_PIN(2); PG9_SCHED8; PG9_BAR; PG9_SCHED;
        }
        if constexpr (ALIGN_EPI) { if (wr == 0) PG9_BAR; }
        E(acc, cur, wr, wc, fr, fq);
        if (!has_next) break;
        PG9_ZERO();
        cur = nxt; cA = nA; cB = nB; ++ui;
        if constexpr (ALIGN_EPI) { if (wr == 1) PG9_BAR; }
    }
    asm volatile("s_waitcnt vmcnt(0)" ::: "memory");
    if constexpr (!ALIGN_EPI) { if (wr == 0) PG9_BAR; }
    PG9_BAR;
#undef PG9_SA
#undef PG9_SB
#undef PG9_STAGE_A
#undef PG9_STAGE_B
#undef PG9_LDA
#undef PG9_LDB
#undef PG9_MMA
#undef PG9_WAIT_V
#undef PG9_WAIT_L0
#undef PG9_BAR
#undef PG9_SCHED
#undef PG9_SCHED8
#undef PG9_PIN
#undef PG9_ZERO
}
}
#define GAS __attribute__((address_space(1)))
#define LAS __attribute__((address_space(3)))
typedef unsigned short bf16;
typedef unsigned v4u __attribute__((ext_vector_type(4)));
typedef float f32x4 __attribute__((ext_vector_type(4)));
typedef short bf16x8 __attribute__((ext_vector_type(8)));
typedef GAS unsigned gu32;
typedef GAS unsigned long long gu64;
#define RLX_AGENT __ATOMIC_RELAXED, __HIP_MEMORY_SCOPE_AGENT
#define LDS_WAIT() asm volatile("s_waitcnt lgkmcnt(0)" ::: "memory")
#define VM_WAIT() asm volatile("s_waitcnt vmcnt(0)" ::: "memory")
__device__ __forceinline__ unsigned f2bf(float f) { unsigned u = __builtin_bit_cast(unsigned, f); return (u + 0x7fffu + ((u >> 16) & 1u)) >> 16; }
__device__ __forceinline__ unsigned pk2(float lo, float hi) { return f2bf(lo) | (f2bf(hi) << 16); }
__device__ __forceinline__ float bf2f(unsigned b) { return __builtin_bit_cast(float, b << 16); }
__device__ __forceinline__ float wave_sum(float v) {
#pragma unroll
    for (int o = 1; o < 64; o <<= 1) v += __shfl_xor(v, o);
    return v;
}
__device__ __forceinline__ float sigmoidf_(float x) { return 1.f / (1.f + __expf(-x)); }
__device__ __forceinline__ float log_sigmoid(float x) { return fminf(x, 0.f) - log1pf(__expf(-fabsf(x))); }

#define XB_TMO      128
#define XB_XCNT(j)  (256  + 64 * (j))
#define XB_XSUB(j)  (1280 + 64 * (j))
#define XB_XGEN(j)  (2304 + 64 * (j))
#define XB_TOP      3328
#define XB_TOPGEN   3392
#define XCD_BAR_WORDS 3456
#define XB_SPIN_CAP (1u << 18)

__device__ __forceinline__ unsigned xb_ld(unsigned* p)              { return __hip_atomic_load(p, __ATOMIC_RELAXED, __HIP_MEMORY_SCOPE_AGENT); }
__device__ __forceinline__ unsigned xb_add(unsigned* p, unsigned v) { return __hip_atomic_fetch_add(p, v, __ATOMIC_RELAXED, __HIP_MEMORY_SCOPE_AGENT); }
__device__ __forceinline__ unsigned xb_xcc_id() { return (unsigned)__builtin_amdgcn_s_getreg((3 << 11) | 20) & 0xFu; }
#define XB_SPIN(cond, bar) do { unsigned _sp = 0; while (cond) { __builtin_amdgcn_s_sleep(1); \
    if ((++_sp & 255u) == 0u) { if (xb_ld(&(bar)[XB_TMO])) break; if (_sp > XB_SPIN_CAP) { atomicAdd(&(bar)[XB_TMO], 1u); break; } } } } while (0)

struct XcdBarrier {
    unsigned* bar; unsigned x;
    volatile LAS unsigned* st;
};

__device__ __forceinline__ XcdBarrier xcd_barrier_post(unsigned* bar, volatile LAS unsigned* st) {
    XcdBarrier b; b.bar = bar; b.x = xb_xcc_id(); b.st = st;
    if (threadIdx.x == 0) (void)xb_add(&bar[XB_XCNT(b.x)], 1u);
    return b;
}
__device__ __forceinline__ void xcd_barrier_complete(unsigned* bar, unsigned x, unsigned& nloc, unsigned& nx) {
    const unsigned G = gridDim.x * gridDim.y * gridDim.z;
    unsigned sum, cnt, mine, sp = 0u;
    for (;;) {
        sum = 0u; cnt = 0u; mine = 0u;
#pragma unroll
        for (unsigned j = 0; j < 16; ++j) { const unsigned c = xb_ld(&bar[XB_XCNT(j)]); sum += c; cnt += (c > 0u) ? 1u : 0u; mine = (j == x) ? c : mine; }
        if (sum == G) break;
        __builtin_amdgcn_s_sleep(1);
        if ((++sp & 255u) == 0u) { if (xb_ld(&bar[XB_TMO])) break; if (sp > XB_SPIN_CAP) { atomicAdd(&bar[XB_TMO], 1u); break; } }
    }
    nloc = mine > 0u ? mine : 1u; nx = cnt > 0u ? cnt : 1u;
}

__device__ __forceinline__ void xcd_barrier(const XcdBarrier& b) {
    asm volatile("s_waitcnt vmcnt(0)" ::: "memory");
    __syncthreads();
    if (threadIdx.x == 0) {
        unsigned* bar = b.bar;
        __builtin_amdgcn_s_waitcnt(0);
        unsigned nloc = b.st[0], nx = b.st[1];
        if (nloc == 0u) { xcd_barrier_complete(bar, b.x, nloc, nx); b.st[0] = nloc; b.st[1] = nx; }
        const unsigned old = xb_add(&bar[XB_XSUB(b.x)], 1u);
        const unsigned gen = old / nloc;
        if (old + 1u == (gen + 1u) * nloc) {
            __builtin_amdgcn_fence(__ATOMIC_RELEASE, "agent");
            asm volatile("s_waitcnt vmcnt(0)" ::: "memory");
            const unsigned og = xb_add(&bar[XB_TOP], 1u);
            const unsigned tg = og / nx;
            if (og + 1u == (tg + 1u) * nx) xb_add(&bar[XB_TOPGEN], 1u);
            else XB_SPIN(xb_ld(&bar[XB_TOPGEN]) == tg, bar);
            __builtin_amdgcn_fence(__ATOMIC_ACQUIRE, "agent");
            xb_add(&bar[XB_XGEN(b.x)], 1u);
            asm volatile("s_waitcnt vmcnt(0)" ::: "memory");
        } else {
            XB_SPIN(xb_ld(&bar[XB_XGEN(b.x)]) == gen, bar);
            __builtin_amdgcn_fence(__ATOMIC_ACQUIRE, "agent");
            asm volatile("s_waitcnt vmcnt(0)" ::: "memory");
        }
    }
    __syncthreads();
}
struct Frame {
    LAS unsigned char* lds;
    volatile LAS unsigned* MISC;
    gu32* ctl;
    int tid, lane, wave;
    int vcu, G;
    const float *x_p, *x_s, *st_conv, *st_C, *st_n, *st_m, *g1, *w_in, *b_i, *b_f, *conv_w, *conv_g, *ml_g, *w_out, *g2, *wg, *wu, *wd, *fg;
    float* out;
    bf16 *W1, *W2, *W3, *W4, *XN, *YC, *Z, *HB, *X1b;
    float *gates, *ssq1, *ssq2;
};

struct TrItem { const float* W; int ldw, K, nblk; bf16* WT; int mode; const float* kgain; int item; };
__device__ __forceinline__ void p0_tr_load(const TrItem& T, int lane, f32x4 (&v)[16]) {
    const int kb = T.item / T.nblk, nb = T.item % T.nblk, k0 = 64 * kb, n0 = 64 * nb; const int r4 = lane >> 4, c4 = 4 * (lane & 15);
#pragma unroll
    for (int i = 0; i < 16; ++i) v[i] = *(const GAS f32x4*)(T.W + (size_t)(k0 + 4 * i + r4) * T.ldw + n0 + c4);
}
__device__ __forceinline__ void p0_tr_finish(const TrItem& T, int lane, const f32x4 (&v)[16], LAS float* scr) {
    const int kb = T.item / T.nblk, nb = T.item % T.nblk, k0 = 64 * kb, n0 = 64 * nb; const int r4 = lane >> 4, c4 = 4 * (lane & 15);
#pragma unroll
    for (int i = 0; i < 16; ++i) { const int kk = 4 * i + r4; const float g = T.kgain ? T.kgain[k0 + kk] : 1.f; LAS float* d = scr + kk * 65 + c4; d[0] = v[i].x * g; d[1] = v[i].y * g; d[2] = v[i].z * g; d[3] = v[i].w * g; }
    LDS_WAIT(); asm volatile("" ::: "memory");
    const int c = lane & 7;
#pragma unroll
    for (int j = 0; j < 8; ++j) { const int n = (lane >> 3) + 8 * j; const LAS float* s = scr + (8 * c) * 65 + n;
        v4u o; o.x = pk2(s[0 * 65], s[1 * 65]); o.y = pk2(s[2 * 65], s[3 * 65]); o.z = pk2(s[4 * 65], s[5 * 65]); o.w = pk2(s[6 * 65], s[7 * 65]);
        const int jn = n0 + n; int drow = jn; if (T.mode == 1) drow = 256 * (jn >> 7) + (jn & 127); if (T.mode == 2) drow = 256 * (jn >> 7) + 128 + (jn & 127);
        const int x = drow & 31, slot = (drow & ~31) + 16 * ((x >> 2) & 1) + 4 * (x >> 3) + (x & 3);
        *(GAS v4u*)((GAS unsigned char*)T.WT + ((size_t)(slot >> 3) * (T.K >> 6) + (k0 >> 6)) * 1024 + (slot & 7) * 128 + 16 * c) = o; }
    LDS_WAIT(); asm volatile("" ::: "memory");
}
__device__ __forceinline__ void p0_tr_finish_fp8(const TrItem& T, int lane, const f32x4 (&v)[16], LAS float* scr, float wsc) {
    const int kb = T.item / T.nblk, nb = T.item % T.nblk, k0 = 64 * kb, n0 = 64 * nb; const int r4 = lane >> 4, c4 = 4 * (lane & 15);
#pragma unroll
    for (int i = 0; i < 16; ++i) { const int kk = 4 * i + r4; LAS float* d = scr + kk * 65 + c4; d[0] = v[i].x * wsc; d[1] = v[i].y * wsc; d[2] = v[i].z * wsc; d[3] = v[i].w * wsc; }
    LDS_WAIT(); asm volatile("" ::: "memory");
    const int c = lane & 3;
#pragma unroll
    for (int j = 0; j < 4; ++j) { const int n = (lane >> 2) + 16 * j; const LAS float* s = scr + (16 * c) * 65 + n; int w[4];
#pragma unroll
        for (int q = 0; q < 4; ++q) { w[q] = __builtin_amdgcn_cvt_pk_fp8_f32(s[(4 * q) * 65], s[(4 * q + 1) * 65], 0, false); w[q] = __builtin_amdgcn_cvt_pk_fp8_f32(s[(4 * q + 2) * 65], s[(4 * q + 3) * 65], w[q], true); }
        const int drow = n0 + n, x = drow & 31, slot = (drow & ~31) + 16 * ((x >> 2) & 1) + 4 * (x >> 3) + (x & 3);
        v4u o; o.x = (unsigned)w[0]; o.y = (unsigned)w[1]; o.z = (unsigned)w[2]; o.w = (unsigned)w[3];
        *(GAS v4u*)((GAS unsigned char*)T.WT + ((size_t)(slot >> 3) * (T.K >> 7) + (k0 >> 7)) * 1024 + (slot & 7) * 128 + (k0 & 127) + 16 * c) = o; }
    LDS_WAIT(); asm volatile("" ::: "memory");
}
__device__ __forceinline__ void p0_transpose_item_fp8(const float* W, int ldw, int K, int nblk, bf16* WT, LAS float* scr, int item, int lane, float wsc) {
    const TrItem T{W, ldw, K, nblk, WT, 0, nullptr, item}; f32x4 v[16]; p0_tr_load(T, lane, v); p0_tr_finish_fp8(T, lane, v, scr, wsc);
}
__device__ __forceinline__ void p0_transpose_item(const float* W, int ldw, int K, int nblk, bf16* WT, int mode, const float* kgain, LAS float* scr, int item, int lane) {
    const TrItem T{W, ldw, K, nblk, WT, mode, kgain, item}; f32x4 v[16]; p0_tr_load(T, lane, v); p0_tr_finish(T, lane, v, scr);
}
__device__ __forceinline__ void p0_xrow_load(Frame& F, int m, f32x4 (&v)[8]) {
    const float* xr = m < MP ? F.x_p + (size_t)m * D : F.x_s + (size_t)(m - MP) * D;
#pragma unroll
    for (int j = 0; j < 8; ++j) v[j] = *(const GAS f32x4*)(xr + 256 * j + 4 * F.lane);
}
__device__ __forceinline__ void p0_xrow(Frame& F, int m, const LAS float* gwl, const f32x4 (&v)[8], const f32x4 (&g)[8], float bq) {
    const int lane = F.lane; float s = 0.f;
#pragma unroll
    for (int j = 0; j < 8; ++j) s += (v[j].x * v[j].x + v[j].y * v[j].y) + (v[j].z * v[j].z + v[j].w * v[j].w);
    const float r = rsqrtf(wave_sum(s) * (1.f / D) + EPS);
    float ga[8]; pg8::f32x2 ga2[8];
#pragma unroll
    for (int q = 0; q < 8; ++q) ga2[q] = (pg8::f32x2){0.f, 0.f};
#pragma unroll
    for (int j = 0; j < 8; ++j) {
        const int k = 256 * j + 4 * lane;
        const f32x4 xn = v[j] * r * g[j];
        *(GAS unsigned long long*)(F.XN + (size_t)m * D + k) = (unsigned long long)pg8::cvt_pk_bf16(xn.x, xn.y) | ((unsigned long long)pg8::cvt_pk_bf16(xn.z, xn.w) << 32);
        f32x4 w[8];
#pragma unroll
        for (int q = 0; q < 8; ++q) w[q] = *(const LAS f32x4*)(gwl + q * D + k);
        const pg8::f32x2 xlo = {xn.x, xn.y}, xhi = {xn.z, xn.w};
#pragma unroll
        for (int q = 0; q < 8; ++q) { ga2[q] = __builtin_elementwise_fma(xlo, (pg8::f32x2){w[q].x, w[q].y}, ga2[q]); ga2[q] = __builtin_elementwise_fma(xhi, (pg8::f32x2){w[q].z, w[q].w}, ga2[q]); }
    }
#pragma unroll
    for (int q = 0; q < 8; ++q) ga[q] = ga2[q].x + ga2[q].y;
    float k4[4], k2[2], k1;
    { const bool hi = (lane & 32) != 0;
#pragma unroll
      for (int i = 0; i < 4; ++i) { const float recv = __shfl_xor(hi ? ga[i] : ga[4 + i], 32); k4[i] = (hi ? ga[4 + i] : ga[i]) + recv; } }
    { const bool hi = (lane & 16) != 0;
#pragma unroll
      for (int i = 0; i < 2; ++i) { const float recv = __shfl_xor(hi ? k4[i] : k4[2 + i], 16); k2[i] = (hi ? k4[2 + i] : k4[i]) + recv; } }
    { const bool hi = (lane & 8) != 0; const float recv = __shfl_xor(hi ? k2[0] : k2[1], 8); k1 = (hi ? k2[1] : k2[0]) + recv; }
    k1 += __shfl_xor(k1, 4); k1 += __shfl_xor(k1, 2); k1 += __shfl_xor(k1, 1);
    if ((lane & 7) == 0) { const int q = lane >> 3; F.gates[(size_t)m * 8 + q] = q < 4 ? k1 + bq : log_sigmoid(k1 + bq); }
}
constexpr int TR_I1 = (D / 64) * (NZ / 64), TR_I2 = (D / 64) * (D / 64), TR_I3 = (D / 64) * (FF / 64), TR_I4 = (FF / 64) * (D / 64);
__device__ __forceinline__ TrItem tr_make(Frame& F, int it) {
    int r = it;
    if (r < TR_I1) return TrItem{F.w_in, NIN, D, NZ / 64, F.W1, 0, nullptr, r}; r -= TR_I1;
    if (r < TR_I2) return TrItem{F.w_out, D, D, D / 64, F.W2, 0, nullptr, r}; r -= TR_I2;
    if (r < TR_I3) return TrItem{F.wg, FF, D, FF / 64, F.W3, 1, F.g2, r}; r -= TR_I3;
    if (r < TR_I3) return TrItem{F.wu, FF, D, FF / 64, F.W3, 2, F.g2, r}; r -= TR_I3;
    return TrItem{F.wd, D, FF, D / 64, F.W4, 0, nullptr, r};
}
__device__ __forceinline__ void tr_run(Frame& F, int lo, int hi, int first, int stride, LAS float* scr) {
    f32x4 va[16], vb[16]; int it = lo + first; TrItem Ta{}, Tb{};
    if (it < hi) { Ta = tr_make(F, it); p0_tr_load(Ta, F.lane, va); }
    while (it < hi) {
        const int it2 = it + stride;
        if (it2 < hi) { Tb = tr_make(F, it2); p0_tr_load(Tb, F.lane, vb); }
        p0_tr_finish(Ta, F.lane, va, scr);
        if (it2 >= hi) break;
        const int it3 = it2 + stride;
        if (it3 < hi) { Ta = tr_make(F, it3); p0_tr_load(Ta, F.lane, va); }
        p0_tr_finish(Tb, F.lane, vb, scr);
        it = it3;
    }
}
__device__ __forceinline__ void p0_prologue(Frame& F, bool w4_later, bool w23_later) {
    LAS float* scr = (LAS float*)(F.lds + RING_OFF + F.wave * 16640);
    const int gw = F.vcu * NWAVES + F.wave, NGW = F.G * NWAVES;
    constexpr int I_1 = (D / 64) * (NZ / 64), I_2 = (D / 64) * (D / 64), I_3 = (D / 64) * (FF / 64), I_4 = (FF / 64) * (D / 64);
    constexpr int NITEMS = I_1 + I_2 + 2 * I_3 + I_4;
    const int NIT = w23_later ? I_1 : (w4_later ? NITEMS - I_4 : NITEMS);
    tr_run(F, 0, NIT, gw, NGW, scr);
    __syncthreads();
    LAS float* gwl = (LAS float*)(F.lds + RING_OFF);
    for (int k = F.tid; k < D; k += NWAVES * 64) {
        const f32x4 a = *(const GAS f32x4*)(F.w_in + (size_t)k * NIN + NZ), b = *(const GAS f32x4*)(F.w_in + (size_t)k * NIN + NZ + 4);
        gwl[0 * D + k] = a.x; gwl[1 * D + k] = a.y; gwl[2 * D + k] = a.z; gwl[3 * D + k] = a.w; gwl[4 * D + k] = b.x; gwl[5 * D + k] = b.y; gwl[6 * D + k] = b.z; gwl[7 * D + k] = b.w;
    }
    __syncthreads();
    {
        f32x4 g[8];
#pragma unroll
        for (int j = 0; j < 8; ++j) g[j] = *(const GAS f32x4*)(F.g1 + 256 * j + 4 * F.lane);
        const float bq = (F.lane >> 3) < 4 ? F.b_i[F.lane >> 3] : F.b_f[(F.lane >> 3) - 4];
        f32x4 va[8], vb[8]; int m = gw;
        p0_xrow_load(F, m < M ? m : M - 1, va);
        while (m < M) {
            const int m2 = m + NGW;
            p0_xrow_load(F, m2 < M ? m2 : M - 1, vb);
            asm volatile("" ::: "memory");
            p0_xrow(F, m, gwl, va, g, bq);
            if (m2 >= M) break;
            const int m3 = m2 + NGW;
            p0_xrow_load(F, m3 < M ? m3 : M - 1, va);
            asm volatile("" ::: "memory");
            p0_xrow(F, m2, gwl, vb, g, bq);
            m = m3;
        }
    }
    __syncthreads();
}
__device__ __forceinline__ void final_norm_phase(Frame& F) {
    const int gw = F.vcu * NWAVES + F.wave, NGW = F.G * NWAVES;
    for (int m = gw; m < M; m += NGW) {
        const float r = rsqrtf(F.ssq2[m] * (1.f / D) + EPS);
#pragma unroll
        for (int j = 0; j < 8; ++j) { GAS f32x4* p = (GAS f32x4*)(F.out + (size_t)m * D + 256 * j + 4 * F.lane); const f32x4 g = *(const GAS f32x4*)(F.fg + 256 * j + 4 * F.lane); *p = *p * r * g; }
    }
}
__device__ __forceinline__ void unpack8(const v4u w, float (&f)[8]) {
    f[0] = bf2f(w.x & 0xffffu); f[1] = bf2f(w.x >> 16); f[2] = bf2f(w.y & 0xffffu); f[3] = bf2f(w.y >> 16);
    f[4] = bf2f(w.z & 0xffffu); f[5] = bf2f(w.z >> 16); f[6] = bf2f(w.w & 0xffffu); f[7] = bf2f(w.w >> 16);
}
__device__ __forceinline__ void conv_item(Frame& F, int item) {
    const bool prompt = item < 1024;
    const int b = prompt ? (item >> 8) : (item - 1024);
    const int row0 = prompt ? 8 * item : MP + 8 * (item - 1024);
    const int t0 = prompt ? 8 * (item & 255) : 0;
    const bool last_item = prompt ? ((item & 255) == 255) : true;
    const int lane = F.lane;
    float w0[16], w1[16], w2[16], cg_[16], up2[16], up1[16];
#pragma unroll
    for (int p = 0; p < 2; ++p) {
        const int c0 = 8 * lane + 512 * p;
#pragma unroll
        for (int q = 0; q < 2; ++q) {
            const f32x4 a = *(const GAS f32x4*)(F.conv_w + c0 + 4 * q), bb = *(const GAS f32x4*)(F.conv_w + DC + c0 + 4 * q), c = *(const GAS f32x4*)(F.conv_w + 2 * DC + c0 + 4 * q), g = *(const GAS f32x4*)(F.conv_g + c0 + 4 * q);
#pragma unroll
            for (int i = 0; i < 4; ++i) { w0[8 * p + 4 * q + i] = a[i]; w1[8 * p + 4 * q + i] = bb[i]; w2[8 * p + 4 * q + i] = c[i]; cg_[8 * p + 4 * q + i] = g[i]; }
        }
    }
    if (prompt) {
        if (t0 == 0) {
#pragma unroll
            for (int i = 0; i < 16; ++i) { up2[i] = 0.f; up1[i] = 0.f; }
        } else {
#pragma unroll
            for (int p = 0; p < 2; ++p) {
                const int c0 = 8 * lane + 512 * p; float a[8], x[8];
                const bf16* z2 = F.Z + (size_t)(row0 - 2) * NZ; const bf16* z1 = F.Z + (size_t)(row0 - 1) * NZ;
                unpack8(*(const GAS v4u*)(z2 + ZC_CG + c0), a); unpack8(*(const GAS v4u*)(z2 + ZC_XT + c0), x);
#pragma unroll
                for (int i = 0; i < 8; ++i) up2[8 * p + i] = a[i] * x[i];
                unpack8(*(const GAS v4u*)(z1 + ZC_CG + c0), a); unpack8(*(const GAS v4u*)(z1 + ZC_XT + c0), x);
#pragma unroll
                for (int i = 0; i < 8; ++i) up1[8 * p + i] = a[i] * x[i];
            }
        }
    } else {
#pragma unroll
        for (int p = 0; p < 2; ++p) {
            const int c0 = 8 * lane + 512 * p;
#pragma unroll
            for (int q = 0; q < 2; ++q) {
                const f32x4 a = *(const GAS f32x4*)(F.st_conv + ((size_t)b * 2 + 0) * DC + c0 + 4 * q), bb = *(const GAS f32x4*)(F.st_conv + ((size_t)b * 2 + 1) * DC + c0 + 4 * q);
#pragma unroll
                for (int i = 0; i < 4; ++i) { up2[8 * p + 4 * q + i] = a[i]; up1[8 * p + 4 * q + i] = bb[i]; }
            }
        }
    }
#pragma unroll 1
    for (int r = 0; r < 8; ++r) {
        const int row = row0 + r; const bf16* zr = F.Z + (size_t)row * NZ;
        float tt[16]; float ss = 0.f;
#pragma unroll
        for (int p = 0; p < 2; ++p) {
            const int c0 = 8 * lane + 512 * p; float a[8], x[8], g[8];
            unpack8(*(const GAS v4u*)(zr + ZC_CG + c0), a); unpack8(*(const GAS v4u*)(zr + ZC_XT + c0), x); unpack8(*(const GAS v4u*)(zr + ZC_BG + c0), g);
#pragma unroll
            for (int i = 0; i < 8; ++i) { const int ci = 8 * p + i; const float u = a[i] * x[i];
                const float cv = w0[ci] * up2[ci] + w1[ci] * up1[ci] + w2[ci] * u; tt[ci] = g[i] * cv; ss += tt[ci] * tt[ci]; up2[ci] = up1[ci]; up1[ci] = u; }
        }
        const float rr = rsqrtf(wave_sum(ss) * (1.f / DC) + EPS);
#pragma unroll
        for (int p = 0; p < 2; ++p) {
            const int c0 = 8 * lane + 512 * p; v4u o;
            o.x = pk2(tt[8 * p + 0] * rr * cg_[8 * p + 0], tt[8 * p + 1] * rr * cg_[8 * p + 1]); o.y = pk2(tt[8 * p + 2] * rr * cg_[8 * p + 2], tt[8 * p + 3] * rr * cg_[8 * p + 3]);
            o.z = pk2(tt[8 * p + 4] * rr * cg_[8 * p + 4], tt[8 * p + 5] * rr * cg_[8 * p + 5]); o.w = pk2(tt[8 * p + 6] * rr * cg_[8 * p + 6], tt[8 * p + 7] * rr * cg_[8 * p + 7]);
            *(GAS v4u*)(F.YC + (size_t)row * D + c0) = o;
        }
        if (last_item && r >= 6) {
            float* o = F.out + (prompt ? O_PCONV : O_SCONV) + ((size_t)b * 2 + (r - 6)) * DC;
#pragma unroll
            for (int p = 0; p < 2; ++p) { const int c0 = 8 * lane + 512 * p;
                *(GAS f32x4*)(o + c0) = (f32x4){up1[8 * p + 0], up1[8 * p + 1], up1[8 * p + 2], up1[8 * p + 3]}; *(GAS f32x4*)(o + c0 + 4) = (f32x4){up1[8 * p + 4], up1[8 * p + 5], up1[8 * p + 6], up1[8 * p + 7]}; }
        }
    }
}

template <bool WITH_STATE>
__device__ __forceinline__ void sample_item(Frame& F, int item) {
    LAS float* L = (LAS float*)(F.lds + RING_OFF);
    LAS float* qT = L; LAS float* kT = L + 1024; LAS float* kwT = L + 2048; LAS float* qR = L + 3072; LAS float* kR = L + 4128; LAS float* vS = L + 5184; LAS float* accx = L + 7232; LAS float* Sm = L + 23616;
    LAS float* ai = L + 23680; LAS float* dd = L + 23688; LAS float* wk = L + 23696; LAS float* misc = L + 23704; LAS float* n0s = L + 23712; LAS float* red = L + 23840; LAS float* lis = L + 23872; LAS float* lfs = L + 23880;
    const int tid = F.tid, b = item >> 2, h = item & 3, row0 = MP + 8 * b;
    __syncthreads();
    if (tid < 256) { const int isk = tid >> 7, t = (tid >> 4) & 7, c = tid & 15; float f[8];
        unpack8(*(const GAS v4u*)(F.Z + (size_t)(row0 + t) * NZ + (isk ? ZC_K : ZC_Q) + h * DK + 8 * c), f);
        LAS float* T_ = isk ? kT : qT; LAS float* R_ = isk ? kR : qR; const float sc_ = isk ? 1.f : QSCALE;
#pragma unroll
        for (int i = 0; i < 8; ++i) { const float x = f[i] * sc_; T_[(8 * c + i) * 8 + t] = x; R_[t * 132 + 8 * c + i] = x; }
    } else { const int u = tid - 256, t = u >> 5, c = u & 31; float f[8]; unpack8(*(const GAS v4u*)(F.Z + (size_t)(row0 + t) * NZ + ZC_V + h * DV + 8 * c), f);
#pragma unroll
        for (int i = 0; i < 8; ++i) vS[t * 256 + 8 * c + i] = f[i]; }
    if (tid < 8) { lis[tid] = F.gates[(size_t)(row0 + tid) * 8 + h]; lfs[tid] = F.gates[(size_t)(row0 + tid) * 8 + 4 + h]; }
    if (tid >= 64 && tid < 64 + DK) n0s[tid - 64] = F.st_n[(size_t)(b * NH + h) * DK + tid - 64];
    __syncthreads();
    if (F.wave == 0) {
        const int lane = F.lane, t = lane >> 3, s = lane & 7;
        const float m0 = F.st_m[b * NH + h];
        float bc[8]; { float run = 0.f;
#pragma unroll
            for (int i = 0; i < 8; ++i) { run += lfs[i]; bc[i] = run; } }
        float bt = 0.f, bs = 0.f;
#pragma unroll
        for (int i = 0; i < 8; ++i) { bt = (i == t) ? bc[i] : bt; bs = (i == s) ? bc[i] : bs; }
        const float lis_s = lis[s];
        const float dm = (s <= t) ? (bt - bs + lis_s) : -INFINITY;
        float mx = dm; mx = fmaxf(mx, __shfl_xor(mx, 1)); mx = fmaxf(mx, __shfl_xor(mx, 2)); mx = fmaxf(mx, __shfl_xor(mx, 4));
        const float mt = fmaxf(bt + m0, mx);
        const float w = (s <= t) ? __expf(dm - mt) : 0.f;
        const float a_i = __expf(bt + m0 - mt);
        float dot = 0.f, qn = 0.f;
#pragma unroll 8
        for (int d4 = 0; d4 < DK; d4 += 4) { const f32x4 qv = *(const LAS f32x4*)(qR + t * 132 + d4), kv = *(const LAS f32x4*)(kR + s * 132 + d4), nv = *(const LAS f32x4*)(n0s + d4);
            dot += (qv.x * kv.x + qv.y * kv.y) + (qv.z * kv.z + qv.w * kv.w); qn += (qv.x * nv.x + qv.y * nv.y) + (qv.z * nv.z + qv.w * nv.w); }
        const float sv = dot * w;
        float rs = sv; rs += __shfl_xor(rs, 1); rs += __shfl_xor(rs, 2); rs += __shfl_xor(rs, 4);
        const float den = a_i * qn + rs;
        Sm[t * 8 + s] = sv;
        const float bL = bc[7];
        const float gs = bL - bs + lis_s;
        float gm = gs; gm = fmaxf(gm, __shfl_xor(gm, 1)); gm = fmaxf(gm, __shfl_xor(gm, 2)); gm = fmaxf(gm, __shfl_xor(gm, 4));
        const float mnew = fmaxf(bL + m0, gm);
        if (s == 0) { ai[t] = a_i; dd[t] = 1.f / fmaxf(fabsf(den), __expf(-mt)); }
        if (t == 0) wk[s] = __expf(gs - mnew);
        if (lane == 0) { misc[0] = __expf(bL + m0 - mnew); misc[1] = mnew; }
    }
    __syncthreads();
    const float sc = misc[0];
    for (int i = tid; i < 1024; i += NWAVES * 64) kwT[i] = kT[i] * wk[i & 7];
    __syncthreads();
    if (tid < DK) { float nn = sc * n0s[tid];
#pragma unroll
        for (int s = 0; s < 8; ++s) nn += kwT[tid * 8 + s];
        F.out[O_SN + (size_t)(b * NH + h) * DK + tid] = nn; }
    if (tid == 0) F.out[O_SM + b * NH + h] = misc[1];
    { const int e4 = tid & 63, dg = F.wave;
      f32x4 vv[8], acc[8];
#pragma unroll
      for (int s = 0; s < 8; ++s) { vv[s] = *(const LAS f32x4*)(vS + s * 256 + 4 * e4); acc[s] = (f32x4){0.f, 0.f, 0.f, 0.f}; }
      const float* c0p = F.st_C + ((size_t)(b * NH + h) * DK + 16 * dg) * DV + 4 * e4;
      float* c1p = F.out + O_SC + ((size_t)(b * NH + h) * DK + 16 * dg) * DV + 4 * e4;
      {   constexpr int d0 = 0;
          f32x4 c[16];
#pragma unroll
          for (int j = 0; j < 16; ++j) c[j] = *(const GAS f32x4*)(c0p + (size_t)(d0 + j) * DV);
#pragma unroll
          for (int j = 0; j < 16; ++j) {
              const int d = 16 * dg + d0 + j;
              const f32x4 q0 = *(const LAS f32x4*)(qT + d * 8), q1 = *(const LAS f32x4*)(qT + d * 8 + 4), k0 = *(const LAS f32x4*)(kwT + d * 8), k1 = *(const LAS f32x4*)(kwT + d * 8 + 4);
              f32x4 cn = c[j] * sc;
#pragma unroll
              for (int s = 0; s < 4; ++s) { acc[s] += c[j] * q0[s]; acc[4 + s] += c[j] * q1[s]; if (WITH_STATE) { cn += vv[s] * k0[s]; cn += vv[4 + s] * k1[s]; } }
              if (WITH_STATE) *(GAS f32x4*)(c1p + (size_t)(d0 + j) * DV) = cn;
          }
      }
#pragma unroll
      for (int t = 0; t < 8; ++t) *(LAS f32x4*)(accx + (dg * 8 + t) * 256 + 4 * e4) = acc[t];
    }
    __syncthreads();
    { const int e = tid & 255, th = tid >> 8; float hv[4];
#pragma unroll
      for (int tt = 0; tt < 4; ++tt) { const int t = 4 * th + tt; float a = 0.f;
#pragma unroll
          for (int w = 0; w < 8; ++w) a += accx[(w * 8 + t) * 256 + e];
          float num = ai[t] * a;
#pragma unroll
          for (int s = 0; s < 8; ++s) num += Sm[t * 8 + s] * vS[s * 256 + e];
          hv[tt] = num * dd[t]; const float p = wave_sum(hv[tt] * hv[tt]); if (F.lane == 0) red[F.wave * 4 + tt] = p; }
      __syncthreads();
      const float gml = F.ml_g[h * DV + e];
#pragma unroll
      for (int tt = 0; tt < 4; ++tt) { const int t = 4 * th + tt, w0 = 4 * th;
          const float rr = rsqrtf((red[(w0 + 0) * 4 + tt] + red[(w0 + 1) * 4 + tt] + red[(w0 + 2) * 4 + tt] + red[(w0 + 3) * 4 + tt]) * (1.f / DV) + EPS);
          const float o = bf2f(F.Z[(size_t)(row0 + t) * NZ + ZC_O + h * DV + e]);
          F.YC[(size_t)(row0 + t) * D + DC + h * DV + e] = (bf16)f2bf(sigmoidf_(o) * hv[tt] * rr * gml); }
    }
}

__device__ __forceinline__ void sample_state_item(Frame& F, int item) {
    LAS float* L = (LAS float*)(F.lds + RING_OFF);
    LAS float* kT = L; LAS float* kwT = L + 1024; LAS float* vS = L + 2048; LAS float* lis = L + 4096; LAS float* lfs = L + 4104; LAS float* wk = L + 4112; LAS float* misc = L + 4120;
    const int tid = F.tid, b = item >> 2, h = item & 3, row0 = MP + 8 * b;
    const int e4 = tid & 63, dg = F.wave;
    const float* c0p = F.st_C + ((size_t)(b * NH + h) * DK + 16 * dg) * DV + 4 * e4;
    float* c1p = F.out + O_SC + ((size_t)(b * NH + h) * DK + 16 * dg) * DV + 4 * e4;
    f32x4 c[16];
#pragma unroll
    for (int j = 0; j < 16; ++j) c[j] = *(const GAS f32x4*)(c0p + (size_t)j * DV);
    __syncthreads();
    if (tid >= 128 && tid < 256) { const int u = tid - 128, t = u >> 4, cc = u & 15; float f[8]; unpack8(*(const GAS v4u*)(F.Z + (size_t)(row0 + t) * NZ + ZC_K + h * DK + 8 * cc), f);
#pragma unroll
        for (int i = 0; i < 8; ++i) kT[(8 * cc + i) * 8 + t] = f[i];
    } else if (tid >= 256) { const int u = tid - 256, t = u >> 5, cc = u & 31; float f[8]; unpack8(*(const GAS v4u*)(F.Z + (size_t)(row0 + t) * NZ + ZC_V + h * DV + 8 * cc), f);
#pragma unroll
        for (int i = 0; i < 8; ++i) vS[t * 256 + 8 * cc + i] = f[i]; }
    if (tid < 8) { lis[tid] = F.gates[(size_t)(row0 + tid) * 8 + h]; lfs[tid] = F.gates[(size_t)(row0 + tid) * 8 + 4 + h]; }
    __syncthreads();
    if (tid < 8) {
        const float m0 = F.st_m[b * NH + h]; float run = 0.f, bs = 0.f;
#pragma unroll
        for (int i = 0; i < 8; ++i) { run += lfs[i]; bs = (i == tid) ? run : bs; }
        const float bL = run, gs = bL - bs + lis[tid];
        float gm = gs; gm = fmaxf(gm, __shfl_xor(gm, 1)); gm = fmaxf(gm, __shfl_xor(gm, 2)); gm = fmaxf(gm, __shfl_xor(gm, 4));
        const float mnew = fmaxf(bL + m0, gm);
        wk[tid] = __expf(gs - mnew); if (tid == 0) misc[0] = __expf(bL + m0 - mnew);
    }
    __syncthreads();
    const float sc = misc[0];
    for (int i = tid; i < 1024; i += NWAVES * 64) kwT[i] = kT[i] * wk[i & 7];
    __syncthreads();
    f32x4 vv[8];
#pragma unroll
    for (int s = 0; s < 8; ++s) vv[s] = *(const LAS f32x4*)(vS + s * 256 + 4 * e4);
#pragma unroll
    for (int j = 0; j < 16; ++j) {
        const int d = 16 * dg + j;
        const f32x4 k0 = *(const LAS f32x4*)(kwT + d * 8), k1 = *(const LAS f32x4*)(kwT + d * 8 + 4);
        f32x4 cn = c[j] * sc;
#pragma unroll
        for (int s = 0; s < 4; ++s) { cn += vv[s] * k0[s]; cn += vv[4 + s] * k1[s]; }
        *(GAS f32x4*)(c1p + (size_t)j * DV) = cn;
    }
}

typedef short s16x4 __attribute__((ext_vector_type(4)));
typedef float f32x16 __attribute__((ext_vector_type(16)));
#define MFMA32(a, b, c) __builtin_amdgcn_mfma_f32_32x32x16_bf16((a), (b), (c), 0, 0, 0)
__device__ __forceinline__ unsigned tr_addr(unsigned base, int P, int rbase, int C0, int lane) {
    const int h = lane >> 5, blk = (lane >> 4) & 1, q = (lane & 15) >> 2, p = lane & 3;
    return base + (unsigned)((rbase + 8 * h + q) * P + (C0 + 16 * blk + 4 * p) * 2);
}
__device__ __forceinline__ void tr_frag_pair(unsigned a0, unsigned a1, unsigned b0, unsigned b1, bf16x8& A, bf16x8& B) {
    s16x4 x0, x1, y0, y1;
    asm volatile("ds_read_b64_tr_b16 %0, %4\n\tds_read_b64_tr_b16 %1, %5\n\tds_read_b64_tr_b16 %2, %6\n\tds_read_b64_tr_b16 %3, %7\n\ts_waitcnt lgkmcnt(0)"
                 : "=&v"(x0), "=&v"(x1), "=&v"(y0), "=&v"(y1) : "v"(a0), "v"(a1), "v"(b0), "v"(b1) : "memory");
    A = __builtin_shufflevector(x0, x1, 0, 1, 2, 3, 4, 5, 6, 7); B = __builtin_shufflevector(y0, y1, 0, 1, 2, 3, 4, 5, 6, 7);
}
__device__ __forceinline__ bf16x8 tr_frag(unsigned a0, unsigned a1) {
    s16x4 x0, x1;
    asm volatile("ds_read_b64_tr_b16 %0, %2\n\tds_read_b64_tr_b16 %1, %3\n\ts_waitcnt lgkmcnt(0)" : "=&v"(x0), "=&v"(x1) : "v"(a0), "v"(a1) : "memory");
    return __builtin_shufflevector(x0, x1, 0, 1, 2, 3, 4, 5, 6, 7);
}
__device__ __forceinline__ int crow(int reg, int h) { return (reg & 3) + 8 * (reg >> 2) + 4 * h; }

constexpr int SC_PK = 320, SC_PV = 192;
constexpr int SC_KIMG = 0, SC_VIMG = 2 * 64 * SC_PK, SC_WK = SC_VIMG + 2 * 64 * SC_PV, SC_SC = SC_WK + 2048 * 4, SC_BL = SC_SC + 32 * 4, SC_GM = SC_BL + 32 * 4, SC_MST = SC_GM + 32 * 4, SC_NV = SC_MST + 36 * 4, SC_CST = ((SC_NV + 128 * 4 + 15) / 16) * 16, SC_PC = 272, SC_END = SC_CST + 2 * 64 * SC_PC;
constexpr size_t WS_CST = WS_C;
constexpr size_t WS_BCUM = WS_GATES + 1 * MiB;
constexpr size_t WS_MST = WS_BCUM + 256 * 1024;
constexpr size_t WS_NST = WS_MST + 64 * 1024;
static_assert(SC_PK == 320 && SC_PV == 192, "sc_frags hard-codes the row offsets of the two images");
__device__ __forceinline__ void sc_frags(unsigned abase, unsigned bbase, bf16x8 (&A)[4], bf16x8 (&B)[4]) {
    s16x4 x[8], y[8];
    asm volatile("ds_read_b64_tr_b16 %0, %16\n\tds_read_b64_tr_b16 %1, %16 offset:1280\n\tds_read_b64_tr_b16 %8, %17\n\tds_read_b64_tr_b16 %9, %17 offset:768\n\t"
                 "ds_read_b64_tr_b16 %2, %16 offset:5120\n\tds_read_b64_tr_b16 %3, %16 offset:6400\n\tds_read_b64_tr_b16 %10, %17 offset:3072\n\tds_read_b64_tr_b16 %11, %17 offset:3840\n\t"
                 "ds_read_b64_tr_b16 %4, %16 offset:10240\n\tds_read_b64_tr_b16 %5, %16 offset:11520\n\tds_read_b64_tr_b16 %12, %17 offset:6144\n\tds_read_b64_tr_b16 %13, %17 offset:6912\n\t"
                 "ds_read_b64_tr_b16 %6, %16 offset:15360\n\tds_read_b64_tr_b16 %7, %16 offset:16640\n\tds_read_b64_tr_b16 %14, %17 offset:9216\n\tds_read_b64_tr_b16 %15, %17 offset:9984\n\ts_waitcnt lgkmcnt(0)"
                 : "=&v"(x[0]), "=&v"(x[1]), "=&v"(x[2]), "=&v"(x[3]), "=&v"(x[4]), "=&v"(x[5]), "=&v"(x[6]), "=&v"(x[7]),
                   "=&v"(y[0]), "=&v"(y[1]), "=&v"(y[2]), "=&v"(y[3]), "=&v"(y[4]), "=&v"(y[5]), "=&v"(y[6]), "=&v"(y[7])
                 : "v"(abase), "v"(bbase) : "memory");
#pragma unroll
    for (int k = 0; k < 4; ++k) { A[k] = __builtin_shufflevector(x[2 * k], x[2 * k + 1], 0, 1, 2, 3, 4, 5, 6, 7); B[k] = __builtin_shufflevector(y[2 * k], y[2 * k + 1], 0, 1, 2, 3, 4, 5, 6, 7); }
}
__device__ __forceinline__ void scan_unit(Frame& F, int unit, unsigned char* ws) {
    const int bh = unit >> 2, es = unit & 3, b = bh >> 2, h = bh & 3, tid = F.tid, lane = F.lane, wave = F.wave;
    LAS unsigned char* L = F.lds + RING_OFF;
    LAS float* wkS = (LAS float*)(L + SC_WK); LAS float* scS = (LAS float*)(L + SC_SC); LAS float* bLS = (LAS float*)(L + SC_BL); LAS float* gmS = (LAS float*)(L + SC_GM); LAS float* mstS = (LAS float*)(L + SC_MST); LAS float* nvS = (LAS float*)(L + SC_NV);
    float* bcumG = (float*)(ws + WS_BCUM) + (size_t)bh * 2048; float* mstG = (float*)(ws + WS_MST) + (size_t)bh * 64; float* nstG = (float*)(ws + WS_NST) + (size_t)bh * 32 * 128;
    bf16* cstG = (bf16*)(ws + WS_CST) + (size_t)bh * 32 * 256 * 128;
    const size_t rowb = (size_t)b * SEQ;
    __syncthreads();
    for (int cc = 0; cc < 4; ++cc) {
        const int c = 4 * wave + cc; const size_t row = rowb + 64 * c + lane;
        const float li = F.gates[row * 8 + h], lf = F.gates[row * 8 + 4 + h];
        float bsum = lf;
#pragma unroll
        for (int o = 1; o < 64; o <<= 1) { const float t = __shfl_up(bsum, o); if (lane >= o) bsum += t; }
        const float bL = __shfl(bsum, 63);
        const float g = bL - bsum + li;
        float gm = g;
#pragma unroll
        for (int o = 1; o < 64; o <<= 1) gm = fmaxf(gm, __shfl_xor(gm, o));
        wkS[64 * c + lane] = g;
        if (es == 0) bcumG[64 * c + lane] = bsum;
        if (lane == 0) { bLS[c] = bL; gmS[c] = gm; }
    }
    __syncthreads();
    if (tid == 0) { float m = 0.f; mstS[0] = 0.f;
        for (int c = 0; c < 32; ++c) { const float mn = fmaxf(bLS[c] + m, gmS[c]); scS[c] = __expf(bLS[c] + m - mn); m = mn; mstS[c + 1] = mn; } }
    __syncthreads();
    for (int i = tid; i < 2048; i += NWAVES * 64) wkS[i] = __expf(wkS[i] - mstS[(i >> 6) + 1]);
    if (es == 0 && tid < 33) mstG[tid] = mstS[tid];
    if (tid < 128) nvS[tid] = 0.f;
    const int dt = wave & 3, et = wave >> 2, hh = lane >> 5;
    f32x16 acc;
#pragma unroll
    for (int i = 0; i < 16; ++i) acc[i] = 0.f;
    const int kr0 = tid >> 4, kc0 = tid & 15;
    const int vr = tid >> 3, vc = tid & 7;
    const bf16* zk = F.Z + rowb * NZ + ZC_K + h * DK; const bf16* zv = F.Z + rowb * NZ + ZC_V + h * DV + 64 * es;
    v4u rkA0, rkA1, rvA, rkB0, rkB1, rvB, rkC0, rkC1, rvC, rkD0, rkD1, rvD;
#define SC_LOAD(c, rk0, rk1, rv) do { rk0 = *(const GAS v4u*)(zk + (size_t)(64 * (c) + kr0) * NZ + 8 * kc0); rk1 = *(const GAS v4u*)(zk + (size_t)(64 * (c) + kr0 + 32) * NZ + 8 * kc0); \
                        rv = *(const GAS v4u*)(zv + (size_t)(64 * (c) + vr) * NZ + 8 * vc); } while (0)
#define SC_WRITE(c, rk0, rk1, rv) do { LAS unsigned char* kb = L + SC_KIMG + ((c) & 1) * 64 * SC_PK; LAS unsigned char* vb = L + SC_VIMG + ((c) & 1) * 64 * SC_PV; \
                         *(LAS v4u*)(kb + kr0 * SC_PK + 16 * kc0) = rk0; *(LAS v4u*)(kb + (kr0 + 32) * SC_PK + 16 * kc0) = rk1; \
                         float vf[8]; unpack8(rv, vf); const float w_ = wkS[64 * (c) + vr]; v4u o_; o_.x = pk2(vf[0] * w_, vf[1] * w_); o_.y = pk2(vf[2] * w_, vf[3] * w_); o_.z = pk2(vf[4] * w_, vf[5] * w_); o_.w = pk2(vf[6] * w_, vf[7] * w_); \
                         *(LAS v4u*)(vb + vr * SC_PV + 16 * vc) = o_; } while (0)
    const unsigned lbase = (unsigned)(size_t)L;
#define SC_STAGE(cn) do { LAS unsigned char* st_ = L + SC_CST + ((cn) & 1) * 64 * SC_PC + (32 * et + (lane & 31)) * SC_PC + (32 * dt + 4 * hh) * 2; \
        _Pragma("unroll") for (int g = 0; g < 4; ++g) *(LAS unsigned long long*)(st_ + 16 * g) = (unsigned long long)pk2(acc[4 * g], acc[4 * g + 1]) | ((unsigned long long)pk2(acc[4 * g + 2], acc[4 * g + 3]) << 32); } while (0)
#define SC_STEP(c) do { \
        {   \
          _Pragma("unroll") for (int i_ = 0; i_ < 2; ++i_) { const int p_ = tid + 512 * i_, e_ = p_ >> 4, c16 = p_ & 15; \
              *(GAS v4u*)(cstG + ((size_t)(c) * 256 + 64 * es + e_) * 128 + 8 * c16) = *(const LAS v4u*)(L + SC_CST + ((c) & 1) * 64 * SC_PC + e_ * SC_PC + 16 * c16); } } \
        const float sc = scS[c]; \
        _Pragma("unroll") for (int i = 0; i < 16; ++i) acc[i] *= sc; \
        const unsigned kimg = lbase + SC_KIMG + ((c) & 1) * 64 * SC_PK, vimg = lbase + SC_VIMG + ((c) & 1) * 64 * SC_PV; \
        bf16x8 Af[4], Bf[4]; sc_frags(tr_addr(kimg, SC_PK, 0, 32 * dt, lane), tr_addr(vimg, SC_PV, 0, 32 * et, lane), Af, Bf); \
        _Pragma("unroll") for (int ks = 0; ks < 4; ++ks) acc = MFMA32(Af[ks], Bf[ks], acc); \
        if (es == 0 && et == 0) {     \
            float part = 0.f; \
            _Pragma("unroll") for (int ks = 0; ks < 4; ++ks) { const f32x4 w0 = *(const LAS f32x4*)(wkS + 64 * (c) + 16 * ks + 8 * hh), w1 = *(const LAS f32x4*)(wkS + 64 * (c) + 16 * ks + 8 * hh + 4); \
                const v4u kk = __builtin_bit_cast(v4u, Af[ks]); \
                part += (bf2f(kk.x & 0xffffu) * w0.x + bf2f(kk.x >> 16) * w0.y) + (bf2f(kk.y & 0xffffu) * w0.z + bf2f(kk.y >> 16) * w0.w) \
                      + (bf2f(kk.z & 0xffffu) * w1.x + bf2f(kk.z >> 16) * w1.y) + (bf2f(kk.w & 0xffffu) * w1.z + bf2f(kk.w >> 16) * w1.w); } \
            part += __shfl_xor(part, 32); \
            if (hh == 0) { const int d = 32 * dt + (lane & 31); const float nn = nvS[d]; nstG[(c) * 128 + d] = nn; nvS[d] = nn * sc + part; } } \
        SC_STAGE((c) + 1); } while (0)
    SC_LOAD(0, rkA0, rkA1, rvA); SC_LOAD(1, rkB0, rkB1, rvB); SC_LOAD(2, rkC0, rkC1, rvC); SC_LOAD(3, rkD0, rkD1, rvD);
    SC_STAGE(0);
    __syncthreads();
    SC_WRITE(0, rkA0, rkA1, rvA);
#pragma unroll 1
    for (int c = 0; c < 32; c += 4) {
        if (c + 4 < 32) SC_LOAD(c + 4, rkA0, rkA1, rvA);
        __syncthreads();
        SC_STEP(c);
        SC_WRITE(c + 1, rkB0, rkB1, rvB);
        if (c + 5 < 32) SC_LOAD(c + 5, rkB0, rkB1, rvB);
        __syncthreads();
        SC_STEP(c + 1);
        SC_WRITE(c + 2, rkC0, rkC1, rvC);
        if (c + 6 < 32) SC_LOAD(c + 6, rkC0, rkC1, rvC);
        __syncthreads();
        SC_STEP(c + 2);
        SC_WRITE(c + 3, rkD0, rkD1, rvD);
        if (c + 7 < 32) SC_LOAD(c + 7, rkD0, rkD1, rvD);
        __syncthreads();
        SC_STEP(c + 3);
        if (c + 4 < 32) SC_WRITE(c + 4, rkA0, rkA1, rvA);
    }
#undef SC_STEP
#undef SC_STAGE
    __syncthreads();
#undef SC_LOAD
#undef SC_WRITE
    { float* dst = F.out + O_PC + ((size_t)bh * 128 + 32 * dt) * 256 + 64 * es + 32 * et + (lane & 31);
#pragma unroll
      for (int i = 0; i < 16; ++i) dst[(size_t)crow(i, hh) * 256] = acc[i]; }
    if (es == 0 && tid < 128) F.out[O_PN + (size_t)bh * 128 + tid] = nvS[tid];
    if (es == 0 && tid == 0) F.out[O_PM + bh] = mstS[32];
    asm volatile("s_waitcnt vmcnt(0)" ::: "memory");
    __syncthreads();
    if (tid == 0) { __builtin_amdgcn_fence(__ATOMIC_RELEASE, "agent"); asm volatile("s_waitcnt vmcnt(0)" ::: "memory");
        __hip_atomic_fetch_add((unsigned*)(F.ctl + CW_SCAN) + 64 * bh, 1u, __ATOMIC_RELAXED, __HIP_MEMORY_SCOPE_AGENT); }
}
constexpr int P3_PQ = 272, P3_PKK = 272, P3_PV = 576, P3_PP = 144, P3_PH = 1040;
constexpr int P3_Q = 0, P3_K = P3_Q + 64 * P3_PQ, P3_V = P3_K + 64 * P3_PKK, P3_P = P3_V + 64 * P3_PV, P3_H = 0;
constexpr int P3_SM = 81920;
static_assert(P3_P + 64 * P3_PP <= P3_SM && 64 * P3_PH <= P3_SM, "P3 LDS map");
__device__ __forceinline__ void p3_item(Frame& F, int item, unsigned char* ws) {
    const int bh = item >> 5, c = item & 31, b = bh >> 2, h = bh & 3, tid = F.tid, lane = F.lane, wave = F.wave, hh = lane >> 5, l31 = lane & 31;
    LAS unsigned char* L = F.lds + RING_OFF;
    LAS float* sm = (LAS float*)(L + P3_SM); LAS float* bmS = sm; LAS float* aS = sm + 64; LAS float* aiS = sm + 128; LAS float* ddS = sm + 192; LAS float* rsS = sm + 256; LAS float* qnS = sm + 320; LAS float* mtS = sm + 384; LAS float* nvS = sm + 448;
    const size_t row0 = (size_t)b * SEQ + 64 * c;
    const bf16* cst = (const bf16*)(ws + WS_CST) + ((size_t)bh * 32 + c) * 256 * 128;
    __syncthreads();
    { const bf16* zq = F.Z + row0 * NZ + ZC_Q + h * DK; const bf16* zk = F.Z + row0 * NZ + ZC_K + h * DK; const bf16* zv = F.Z + row0 * NZ + ZC_V + h * DV;
#pragma unroll
      for (int i = 0; i < 2; ++i) { const int r = (tid >> 4) + 32 * i, cc = tid & 15;
          *(LAS v4u*)(L + P3_Q + r * P3_PQ + 16 * cc) = *(const GAS v4u*)(zq + (size_t)r * NZ + 8 * cc); *(LAS v4u*)(L + P3_K + r * P3_PKK + 16 * cc) = *(const GAS v4u*)(zk + (size_t)r * NZ + 8 * cc); }
#pragma unroll
      for (int i = 0; i < 4; ++i) { const int r = (tid >> 5) + 16 * i, cc = tid & 31; *(LAS v4u*)(L + P3_V + r * P3_PV + 16 * cc) = *(const GAS v4u*)(zv + (size_t)r * NZ + 8 * cc); } }
    if (wave == 0) {
        const float mc = ((const float*)(ws + WS_MST))[(size_t)bh * 64 + c];
        const float bt = ((const float*)(ws + WS_BCUM))[(size_t)bh * 2048 + 64 * c + lane];
        const float li = F.gates[(row0 + lane) * 8 + h];
        const float a = li - bt; float pm = a;
#pragma unroll
        for (int o = 1; o < 64; o <<= 1) { const float t = __shfl_up(pm, o); if (lane >= o) pm = fmaxf(pm, t); }
        const float mt = bt + fmaxf(mc, pm);
        bmS[lane] = bt - mt; aS[lane] = a; aiS[lane] = __expf(bt + mc - mt); mtS[lane] = mt; rsS[lane] = 0.f;
    }
    if (wave == 1) { const float* np = (const float*)(ws + WS_NST) + ((size_t)bh * 32 + c) * 128; nvS[lane] = np[lane]; nvS[64 + lane] = np[64 + lane]; }
    v4u og[4];
    { const bf16* zo = F.Z + (row0 + (tid >> 3)) * NZ + ZC_O + h * DV + 32 * (tid & 7);
#pragma unroll
      for (int q = 0; q < 4; ++q) og[q] = *(const GAS v4u*)(zo + 8 * q); }
    bf16x8 Cf[8];
    { const bf16* cp = cst + (size_t)(32 * wave + l31) * 128 + 8 * hh;
#pragma unroll
      for (int kd = 0; kd < 8; ++kd) Cf[kd] = *(const GAS bf16x8*)(cp + 16 * kd); }
    __syncthreads();
    { const int t = tid >> 3, part = tid & 7; float s = 0.f;
      const LAS unsigned short* qr = (const LAS unsigned short*)(L + P3_Q + t * P3_PQ) + 16 * part;
#pragma unroll
      for (int j = 0; j < 16; ++j) s += bf2f(qr[j]) * nvS[16 * part + j];
      s += __shfl_xor(s, 1); s += __shfl_xor(s, 2); s += __shfl_xor(s, 4);
      if (part == 0) qnS[t] = s * QSCALE; }
    if (wave < 3) {
        const int si = wave == 2 ? 1 : 0, ti = wave == 0 ? 0 : 1;
        f32x16 x;
#pragma unroll
        for (int i = 0; i < 16; ++i) x[i] = 0.f;
#pragma unroll
        for (int kd = 0; kd < 8; ++kd) {
            const bf16x8 A = *(const LAS bf16x8*)(L + P3_K + (32 * si + l31) * P3_PKK + (16 * kd + 8 * hh) * 2);
            const bf16x8 B = *(const LAS bf16x8*)(L + P3_Q + (32 * ti + l31) * P3_PQ + (16 * kd + 8 * hh) * 2);
            x = MFMA32(A, B, x);
        }
        const int t = 32 * ti + l31; const float bm = bmS[t]; float rsum = 0.f;
#pragma unroll
        for (int g = 0; g < 4; ++g) {
            float p[4];
#pragma unroll
            for (int j = 0; j < 4; ++j) { const int s = 32 * si + 8 * g + 4 * hh + j; const float w = (s <= t) ? __expf(bm + aS[s]) : 0.f; p[j] = x[4 * g + j] * QSCALE * w; rsum += p[j]; }
            *(LAS unsigned long long*)(L + P3_P + t * P3_PP + (32 * si + 8 * g + 4 * hh) * 2) = (unsigned long long)pk2(p[0], p[1]) | ((unsigned long long)pk2(p[2], p[3]) << 32);
        }
        rsum += __shfl_xor(rsum, 32);
        if (hh == 0) atomicAdd((float*)(rsS + t), rsum);
    }
    __syncthreads();
    if (tid < 64) { const float den = aiS[tid] * qnS[tid] + rsS[tid]; ddS[tid] = 1.f / fmaxf(fabsf(den), __expf(-mtS[tid])); }
    bf16x8 Vf[4];
    { const unsigned vimg = (unsigned)(size_t)(L + P3_V);
#pragma unroll
      for (int ks = 0; ks < 4; ++ks) Vf[ks] = tr_frag(tr_addr(vimg, P3_PV, 16 * ks, 32 * wave, lane), tr_addr(vimg, P3_PV, 16 * ks + 4, 32 * wave, lane)); }
    f32x16 n1[2], n2[2];
#pragma unroll
    for (int ti = 0; ti < 2; ++ti) {
#pragma unroll
        for (int i = 0; i < 16; ++i) { n1[ti][i] = 0.f; n2[ti][i] = 0.f; }
#pragma unroll
        for (int kd = 0; kd < 8; ++kd) { const bf16x8 A = *(const LAS bf16x8*)(L + P3_Q + (32 * ti + l31) * P3_PQ + (16 * kd + 8 * hh) * 2); n1[ti] = MFMA32(A, Cf[kd], n1[ti]); }
#pragma unroll
        for (int ks = 0; ks < 2 * (ti + 1); ++ks) { const bf16x8 A = *(const LAS bf16x8*)(L + P3_P + (32 * ti + l31) * P3_PP + (16 * ks + 8 * hh) * 2); n2[ti] = MFMA32(A, Vf[ks], n2[ti]); }
    }
    __syncthreads();
#pragma unroll
    for (int ti = 0; ti < 2; ++ti)
#pragma unroll
        for (int i = 0; i < 16; ++i) { const int t = 32 * ti + crow(i, hh);
            *(LAS float*)(L + P3_H + t * P3_PH + (32 * wave + l31) * 4) = (aiS[t] * QSCALE * n1[ti][i] + n2[ti][i]) * ddS[t]; }
    __syncthreads();
    { const int t = tid >> 3, j = tid & 7; f32x4 hv4[8]; float s = 0.f;
#pragma unroll
      for (int q = 0; q < 8; ++q) { hv4[q] = *(const LAS f32x4*)(L + P3_H + t * P3_PH + (32 * j + 4 * q) * 4); s += (hv4[q].x * hv4[q].x + hv4[q].y * hv4[q].y) + (hv4[q].z * hv4[q].z + hv4[q].w * hv4[q].w); }
      s += __shfl_xor(s, 1); s += __shfl_xor(s, 2); s += __shfl_xor(s, 4);
      const float rr = rsqrtf(s * (1.f / DV) + EPS);
      bf16* yo = F.YC + (row0 + t) * D + DC + h * DV + 32 * j; const float* gp = F.ml_g + h * DV + 32 * j;
#pragma unroll
      for (int q = 0; q < 4; ++q) { float o[8]; unpack8(og[q], o);
          const f32x4 g0 = *(const GAS f32x4*)(gp + 8 * q), g1 = *(const GAS f32x4*)(gp + 8 * q + 4); const f32x4 a = hv4[2 * q], bq = hv4[2 * q + 1];
          v4u w; w.x = pk2(sigmoidf_(o[0]) * a.x * rr * g0.x, sigmoidf_(o[1]) * a.y * rr * g0.y); w.y = pk2(sigmoidf_(o[2]) * a.z * rr * g0.z, sigmoidf_(o[3]) * a.w * rr * g0.w);
          w.z = pk2(sigmoidf_(o[4]) * bq.x * rr * g1.x, sigmoidf_(o[5]) * bq.y * rr * g1.y); w.w = pk2(sigmoidf_(o[6]) * bq.z * rr * g1.z, sigmoidf_(o[7]) * bq.w * rr * g1.w);
          *(GAS v4u*)(yo + 8 * q) = w; } }
}
__device__ __forceinline__ void p2_phase(Frame& F, unsigned char* ws, bool w23_later, bool merge_p3, bool defer_state) {
    constexpr int NS = DB * NH, NC = 1152 / NWAVES, NTI = TR_I2 + 2 * TR_I3, NT = NTI / (2 * NWAVES), NP = 512;
    static_assert(NTI % (2 * NWAVES) == 0, "transposition items per group");
    const int nT = w23_later ? NT : 0, nP = merge_p3 ? NP : 0, NQ = NS + NC + nT + nP;
    if (F.G >= 64 && F.vcu < 64) scan_unit(F, F.vcu, ws);
    else if (F.G < 64) { for (int it = F.vcu; it < 64; it += F.G) scan_unit(F, it, ws); }
    unsigned* qh = (unsigned*)(F.ctl + CW_QUEUE);
    volatile LAS unsigned* qs = F.MISC + 16;
    bool acquired = false;
    unsigned nxt = 0;
    if (F.tid == 0) nxt = __hip_atomic_fetch_add(qh, 1u, __ATOMIC_RELAXED, __HIP_MEMORY_SCOPE_AGENT);
    for (;;) {
        __syncthreads();
        if (F.tid == 0) qs[0] = nxt;
        __syncthreads();
        const int i = __builtin_amdgcn_readfirstlane((int)qs[0]);
        asm volatile("" ::: "memory");
        if (i >= NQ) break;
        if (F.tid == 0) nxt = __hip_atomic_fetch_add(qh, 1u, __ATOMIC_RELAXED, __HIP_MEMORY_SCOPE_AGENT);
        Frame G = F; asm volatile("" : "+v"(G.tid), "+v"(G.lane));
        if (i < NS) { if (defer_state) sample_item<false>(G, i); else sample_item<true>(G, i); }
        else if (i < NS + NC) conv_item(G, (i - NS) * NWAVES + F.wave);
        else if (i < NS + NC + nT) { const int g = i - NS - NC; tr_run(G, TR_I1 + g * 2 * NWAVES, TR_I1 + (g + 1) * 2 * NWAVES, F.wave, NWAVES, (LAS float*)(F.lds + RING_OFF + F.wave * 16640)); }
        else {
            if (!acquired) {
                if (F.tid < 16) { unsigned* cw = (unsigned*)(F.ctl + CW_SCAN) + 64 * F.tid; unsigned spins = 0;
                    while (__hip_atomic_load(cw, __ATOMIC_RELAXED, __HIP_MEMORY_SCOPE_AGENT) < 4u) { __builtin_amdgcn_s_sleep(4); if (++spins > (1u << 20)) break; } }
                if (F.wave == 0) { __builtin_amdgcn_fence(__ATOMIC_ACQUIRE, "agent"); asm volatile("s_waitcnt vmcnt(0)" ::: "memory"); }
                __syncthreads(); acquired = true; }
            p3_item(G, i - NS - NC - nT, ws);
        }
    }
    __syncthreads();
}
__device__ __forceinline__ void p3_phase(Frame& F, unsigned char* ws) {
    for (int it = F.vcu; it < 512; it += F.G) p3_item(F, it, ws);
    __syncthreads();
}
struct Args { const float* in[19]; float* out; unsigned char* ws; int ph_lo, ph_hi, li, pad; };
__global__ void __launch_bounds__(NWAVES * 64, 2) mk_fwd(Args args) {
    extern __shared__ __attribute__((aligned(16))) unsigned char lds[];
    Frame F;
    F.lds = (LAS unsigned char*)lds;
    F.MISC = (volatile LAS unsigned*)(F.lds + MISC_OFF);
    F.tid = threadIdx.x; F.lane = F.tid & 63; F.wave = __builtin_amdgcn_readfirstlane(F.tid >> 6);
    F.G = gridDim.x; { const int bx = blockIdx.x; F.vcu = (F.G % 8 == 0) ? (bx % 8) * (F.G / 8) + bx / 8 : bx; }
    unsigned char* ws = args.ws;
    F.ctl = (gu32*)(ws + WS_CTL);
    F.x_p = args.in[0]; F.x_s = args.in[1]; F.st_conv = args.in[2]; F.st_C = args.in[3]; F.st_n = args.in[4]; F.st_m = args.in[5];
    F.g1 = args.in[6]; F.w_in = args.in[7]; F.b_i = args.in[8]; F.b_f = args.in[9]; F.conv_w = args.in[10]; F.conv_g = args.in[11]; F.ml_g = args.in[12];
    F.w_out = args.in[13]; F.g2 = args.in[14]; F.wg = args.in[15]; F.wu = args.in[16]; F.wd = args.in[17]; F.fg = args.in[18]; F.out = args.out;
    F.W1 = (bf16*)(ws + WS_W1); F.W2 = (bf16*)(ws + WS_W2); F.W3 = (bf16*)(ws + WS_W3); F.W4 = (bf16*)(ws + WS_W4);
    F.XN = (bf16*)(ws + WS_A); F.YC = (bf16*)(ws + WS_A); F.Z = (bf16*)(ws + WS_B); F.HB = (bf16*)(ws + WS_B); F.X1b = (bf16*)(ws + WS_C);
    F.gates = (float*)(ws + WS_GATES); F.ssq1 = (float*)(ws + WS_CTL) + CW_SSQ1; F.ssq2 = (float*)(ws + WS_CTL) + CW_SSQ2;
    for (int u = F.tid; u < (LDS_BYTES - LDSCTL_OFF) / 4; u += NWAVES * 64) ((LAS unsigned*)(F.lds + LDSCTL_OFF))[u] = 0u;
    __syncthreads();
    XcdBarrier bar = xcd_barrier_post((unsigned*)(F.ctl + CW_BAR) + args.li * XCD_BAR_WORDS, F.MISC + 8);
    const int lo = args.ph_lo, hi = args.ph_hi;
#define IN(k) (lo <= (k) && (k) < hi)
#ifndef PROBE_PHASE
#define PROBE_PHASE -1
#endif
#ifndef PROBE_MULT
#define PROBE_MULT 4
#endif
    unsigned long long pt0 = (PROBE_PHASE == 0) ? __builtin_amdgcn_s_memrealtime() : 0ull;
#define SEAM(k) do { if (IN(k) && IN((k) + 1)) xcd_barrier(bar); \
        if (PROBE_PHASE >= 0 && blockIdx.x == 0) { if ((k) + 1 == PROBE_PHASE) pt0 = __builtin_amdgcn_s_memrealtime(); \
            if ((k) == PROBE_PHASE) { const unsigned long long t1 = __builtin_amdgcn_s_memrealtime(); while (__builtin_amdgcn_s_memrealtime() - t1 < (unsigned long long)PROBE_MULT * (t1 - pt0)) __builtin_amdgcn_s_sleep(8); } __syncthreads(); } } while (0)

    constexpr bool use_fp8 = FFN2_FP8 != 0;
    const bool w4_later = (F.G == 256) && IN(0) && IN(5);
    const bool w23_later = w4_later && IN(2) && F.G >= 128;
    if (IN(0)) { p0_prologue(F, w4_later, w23_later); } SEAM(0);
    if (IN(1)) {
        pg8::Gemm g{F.XN, F.W1, M, NZ, D}; pg9::StaticOrder S; S.init(M, NZ, F.G, (int)blockIdx.x);
        pg9::EpiZ E{F.Z, NZ};
        pg9::gemm_phase<pg9::EpiZ>(F.lds + RING_OFF, g, S, E);
    } SEAM(1);
    const bool merge_p3 = IN(2) && IN(3);
    const bool defer_state = w4_later && IN(2);
    if (IN(2)) { p2_phase(F, ws, w23_later && F.G >= 128, merge_p3, defer_state); }
    if (merge_p3) { xcd_barrier(bar);
        if (PROBE_PHASE >= 0 && blockIdx.x == 0) { if (PROBE_PHASE == 4) pt0 = __builtin_amdgcn_s_memrealtime();
            if (PROBE_PHASE == 2) { const unsigned long long t1 = __builtin_amdgcn_s_memrealtime(); while (__builtin_amdgcn_s_memrealtime() - t1 < (unsigned long long)PROBE_MULT * (t1 - pt0)) __builtin_amdgcn_s_sleep(8); } __syncthreads(); } }
    else { SEAM(2); if (IN(3)) { p3_phase(F, ws); } SEAM(3); }
    if (IN(4)) {
        pg8::Gemm g{F.YC, F.W2, M, D, D}; pg9::StaticOrder S; S.init(M, D, F.G, (int)blockIdx.x);
        const bool x1_bf16 = (F.G == (M / pg9::BMR) * (D / pg9::BN)) && IN(6);
        pg9::EpiRes E{F.x_p, F.x_s, MP, x1_bf16 ? nullptr : F.out, F.X1b, F.ssq1};
        pg9::gemm_phase<pg9::EpiRes>(F.lds + RING_OFF, g, S, E);
    } SEAM(4);
    if (IN(5)) {
        pg8::Gemm g{F.X1b, F.W3, M, N3, D}; pg9::StaticOrder S; S.init(M, N3, F.G, (int)blockIdx.x);
        if constexpr (use_fp8) { pg9::EpiH8 E{(unsigned char*)F.HB, F.ssq1, (float)(1 << H8_EXP)}; pg9::gemm_phase<pg9::EpiH8>(F.lds + RING_OFF, g, S, E); }
        else { pg9::EpiH E{F.HB, F.ssq1}; pg9::gemm_phase<pg9::EpiH>(F.lds + RING_OFF, g, S, E); }
        if (w4_later && blockIdx.x >= 128) {
            LAS float* scr = (LAS float*)(F.lds + RING_OFF + F.wave * 16640);
            for (int it = ((int)blockIdx.x - 128) * NWAVES + F.wave; it < (FF / 64) * (D / 64); it += 128 * NWAVES) {
                if constexpr (use_fp8) p0_transpose_item_fp8(F.wd, D, FF, D / 64, F.W4, scr, it, F.lane, (float)(1 << W8_EXP));
                else p0_transpose_item(F.wd, D, FF, D / 64, F.W4, 0, nullptr, scr, it, F.lane); }
            if (defer_state) { for (int it = (int)blockIdx.x - 128; it < DB * NH; it += 128) sample_state_item(F, it); }
        }
    } SEAM(5);
    if (IN(6)) {
        pg8::Gemm g{F.HB, F.W4, M, D, use_fp8 ? FF / 2 : FF}; pg9::StaticOrder S; S.init(M, D, F.G, (int)blockIdx.x);
        if (F.G == (M / pg9::BMR) * (D / pg9::BN)) {
            pg9::EpiFinal E{F.out, F.ssq2, (unsigned*)(F.ctl + CW_CNT4), F.fg, IN(4) ? F.X1b : nullptr};
            if constexpr (use_fp8) pg9::gemm_phase<pg9::EpiFinal, true, true, 127 - H8_EXP, 127 - W8_EXP>(F.lds + RING_OFF, g, S, E);
            else pg9::gemm_phase<pg9::EpiFinal>(F.lds + RING_OFF, g, S, E);
        } else if constexpr (!use_fp8) {
            pg9::EpiRes E{F.out, F.out, M, F.out, nullptr, F.ssq2};
            pg9::gemm_phase<pg9::EpiRes>(F.lds + RING_OFF, g, S, E);
        }
    }
    if (F.G != (M / pg9::BMR) * (D / pg9::BN)) { SEAM(6); if (IN(7)) { final_norm_phase(F); } }
    if (PROBE_PHASE == 6 && blockIdx.x == 0) { const unsigned long long t1 = __builtin_amdgcn_s_memrealtime(); while (__builtin_amdgcn_s_memrealtime() - t1 < (unsigned long long)PROBE_MULT * (t1 - pt0)) __builtin_amdgcn_s_sleep(8); }
    if (PROBE_PHASE == 7) { xcd_barrier(bar); SEAM(7); }
#undef IN
#undef SEAM
}

extern "C" void kernel_launch(void* const* d_in, const int* in_sizes, int n_in, void* d_out, int out_size, void* d_ws, size_t ws_size, hipStream_t stream) {
    static int grid = 0;
    if (grid == 0) {
        if (n_in != 19 || (size_t)out_size != O_END || ws_size < WS_END) { fprintf(stderr, "kernel_launch: unexpected shapes: n_in %d out %d ws %zu; nothing launched\n", n_in, out_size, ws_size); grid = -1; return; }
        int dev = 0, cus = 0;
        if (hipGetDevice(&dev) != hipSuccess || hipDeviceGetAttribute(&cus, hipDeviceAttributeMultiprocessorCount, dev) != hipSuccess) { grid = -1; return; }
        if (hipFuncSetAttribute((const void*)mk_fwd, hipFuncAttributeMaxDynamicSharedMemorySize, LDS_BYTES) != hipSuccess) { fprintf(stderr, "kernel_launch: hipFuncSetAttribute failed\n"); grid = -1; return; }
        grid = cus;
        if (FFN2_FP8 && cus != 256) { fprintf(stderr, "kernel_launch: this build needs a 256-CU device (got %d); nothing launched\n", cus); grid = -1; return; }
    }
    if (grid < 0) return;
    unsigned char* ws = (unsigned char*)d_ws; float* out = (float*)d_out;
    (void)hipMemsetAsync(ws + WS_CTL, 0, CTL_ZERO_BYTES, stream);
    Args a{};
    for (int i = 0; i < 19; ++i) a.in[i] = (const float*)d_in[i];
    a.out = out; a.ws = ws;
    a.ph_lo = 0; a.ph_hi = 8; a.li = 0;
    hipLaunchKernelGGL(mk_fwd, dim3(grid), dim3(NWAVES * 64), LDS_BYTES, stream, a);
}
```

```cpp
#include <hip/hip_runtime.h>
#include <cstdio>
#include <cstdint>

constexpr int D = 2048, SEQ = 2048, NB = 4, DB = 128, DS = 8;
constexpr int MP = NB * SEQ, MS = DB * DS, M = MP + MS;
constexpr int DC = 1024, NH = 4, DK = 128, DV = 256;
constexpr int NZ = 6144, NIN = 6152, FF = 5632, N3 = 2 * FF;
constexpr float EPS = 1e-6f;
constexpr float QSCALE = 0.08838834764831845f;
#ifndef FFN2_FP8
#define FFN2_FP8 1
#endif
constexpr int H8_EXP = 3, W8_EXP = 8;
constexpr int ZC_BG = 0, ZC_CG = 1024, ZC_XT = 2048, ZC_Q = 3072, ZC_K = 3584, ZC_V = 4096, ZC_O = 5120;
constexpr size_t O_Y = 0, O_PCONV = 18874368, O_PC = 18882560, O_PN = 19406848, O_PM = 19408896,
                 O_SCONV = 19408912, O_SC = 19671056, O_SN = 36448272, O_SM = 36513808, O_END = 36514320;
constexpr size_t MiB = 1u << 20;
constexpr size_t WS_CTL = 0, CTL_ZERO_BYTES = 1 * MiB;
constexpr size_t WS_W1 = 1 * MiB, WS_W2 = 25 * MiB, WS_W3 = 33 * MiB, WS_W4 = 77 * MiB;
constexpr size_t WS_A = 99 * MiB;
constexpr size_t WS_B = 135 * MiB;
constexpr size_t WS_C = 243 * MiB;
constexpr size_t WS_GATES = WS_C + 36 * MiB;
constexpr size_t WS_END = 283 * MiB;
constexpr int CW_TMO = 0, CW_CODE = 1;
constexpr int CW_BAR = 4096;
constexpr int CW_QUEUE = 30656;
constexpr int CW_SCAN = 30720;
constexpr int CW_CNT4 = 32768;
constexpr int CW_SSQ1 = 65536, CW_SSQ2 = 65536 + 16384;
constexpr int NWAVES = 8;
constexpr int RING_OFF = 0, RING_BYTES = 139264;
constexpr int LDSCTL_OFF = RING_BYTES, MISC_OFF = LDSCTL_OFF + 320;
constexpr int LDS_BYTES = 147456;

namespace pg8 {
#define PG8_LAS __attribute__((address_space(3)))
typedef unsigned short bf16_t;
typedef short bf16x8 __attribute__((ext_vector_type(8)));
typedef float f32x4 __attribute__((ext_vector_type(4)));
typedef unsigned u32x4 __attribute__((ext_vector_type(4)));
constexpr int BM = 256, BK = 64, HALF = 128, HTB = HALF * BK * 2  , STAGE_BYTES = 8 * HTB, NXCD = 8, WGM = 8;

__host__ __device__ __forceinline__ int lds_byte(int r, int c) { const int st = (r >> 4) * 2 + (c >> 5), rr = r & 15, cc = c & 31, ob = rr * 64 + cc * 2; return st * 1024 + (ob ^ (((ob >> 9) & 1) << 5)); }
__host__ __device__ __forceinline__ void stage_rc(int b, int& R, int& C) { const int st = b / 1024, sb = b % 1024, swz = sb ^ (((sb >> 9) & 1) << 5); R = (st >> 1) * 16 + swz / 64; C = (st & 1) * 32 + (swz % 64) / 2; }
__host__ __device__ __forceinline__ int perm32(int rho) { const int n = rho >> 4, i = rho & 15; return 8 * (i >> 2) + 4 * n + (i & 3); }

struct Unit { int pm, pn; };
struct Gemm { const bf16_t* A; const bf16_t* Bt; int M, N, K; };

struct StaticOrder {
    int nM, nN, nwg, G, c;
    __host__ __device__ void init(int M, int N, int G_, int c_) { nM = M / BM; nN = N / BM; nwg = nM * nN; G = G_; c = c_; }
    __host__ __device__ bool next(int i, Unit& u) const {
        const long L = (long)i * G + c; if (L >= nwg) return false;
        int wgid = (int)L; { const int q = nwg / NXCD, r = nwg % NXCD, xcd = wgid % NXCD, off = wgid / NXCD; wgid = (xcd < r ? xcd * (q + 1) : r * (q + 1) + (xcd - r) * q) + off; }
        const int nig = WGM * nN, gid = wgid / nig, fm = gid * WGM, gsz = (nM - fm) < WGM ? (nM - fm) : WGM;
        u.pm = fm + ((wgid % nig) % gsz); u.pn = (wgid % nig) / gsz; return true;
    }
    __device__ __forceinline__ void a_ready(const Unit&) const {}
    __device__ __forceinline__ void done(const Unit&) const {}
};
__device__ __forceinline__ unsigned cvt_pk_bf16(float lo, float hi) { unsigned r; asm volatile("v_cvt_pk_bf16_f32 %0, %1, %2" : "=v"(r) : "v"(lo), "v"(hi)); return r; }
typedef float f32x2 __attribute__((ext_vector_type(2)));
}
namespace pg9 {
using pg8::lds_byte; using pg8::stage_rc; using pg8::perm32; using pg8::cvt_pk_bf16; using pg8::bf16_t; using pg8::bf16x8; using pg8::f32x4; using pg8::u32x4; using pg8::Gemm;
constexpr int BMR = 288, BN = 256, BK = 64, HALF = 128, TH = 96, ATB = TH * BK * 2  , HTB = HALF * BK * 2  , STAGE_BYTES = 6 * ATB + 4 * HTB  , NXCD = 8, WGM = 8;
typedef int v8i __attribute__((ext_vector_type(8))); typedef int v4i __attribute__((ext_vector_type(4)));
__device__ __forceinline__ v8i cat8(bf16x8 lo, bf16x8 hi) { const v4i a = __builtin_bit_cast(v4i, lo), b = __builtin_bit_cast(v4i, hi); return __builtin_shufflevector(a, b, 0, 1, 2, 3, 4, 5, 6, 7); }
struct Unit { int pm, pn; };
struct StaticOrder {
    int nM, nN, nwg, G, c;
    __host__ __device__ void init(int M, int N, int G_, int c_) { nM = M / BMR; nN = N / BN; nwg = nM * nN; G = G_; c = c_; }
    __host__ __device__ bool next(int i, Unit& u) const {
        const long L = (long)i * G + c; if (L >= nwg) return false;
        int wgid = (int)L; { const int q = nwg / NXCD, r = nwg % NXCD, xcd = wgid % NXCD, off = wgid / NXCD; wgid = (xcd < r ? xcd * (q + 1) : r * (q + 1) + (xcd - r) * q) + off; }
        const int nig = WGM * nN, gid = wgid / nig, fm = gid * WGM, gsz = (nM - fm) < WGM ? (nM - fm) : WGM;
        u.pm = fm + ((wgid % nig) % gsz); u.pn = (wgid % nig) / gsz; return true;
    }
};
typedef f32x4 Acc[3][2][3][2];

struct EpiZ {
    bf16_t* O; int ldc;
    __device__ __forceinline__ void operator()(Acc& acc, const Unit& u, int wr, int wc, int fr, int fq) const {
        const int row0 = u.pm * BMR + wr * 144 + fr, col0 = u.pn * BN + wc * 32 + 8 * fq;
        if (u.pn >= 4 && u.pn < 12) {
            const int colu = 1024 + (u.pn - 4) * HALF + wc * 32 + 8 * fq;
#pragma unroll
            for (int ai = 0; ai < 3; ++ai)
#pragma unroll
                for (int m = 0; m < 3; ++m) { const f32x4 v0 = acc[ai][0][m][0] * acc[ai][1][m][0], v1 = acc[ai][0][m][1] * acc[ai][1][m][1];
                    u32x4 w; w.x = cvt_pk_bf16(v0[0], v0[1]); w.y = cvt_pk_bf16(v0[2], v0[3]); w.z = cvt_pk_bf16(v1[0], v1[1]); w.w = cvt_pk_bf16(v1[2], v1[3]);
                    *(u32x4*)(O + (size_t)(row0 + ai * 48 + m * 16) * ldc + colu) = w; }
            return;
        }
#pragma unroll
        for (int ai = 0; ai < 3; ++ai)
#pragma unroll
            for (int m = 0; m < 3; ++m) { bf16_t* rowp = O + (size_t)(row0 + ai * 48 + m * 16) * ldc + col0;
#pragma unroll
                for (int bj = 0; bj < 2; ++bj) { const f32x4 v0 = acc[ai][bj][m][0], v1 = acc[ai][bj][m][1];
                    u32x4 w; w.x = cvt_pk_bf16(v0[0], v0[1]); w.y = cvt_pk_bf16(v0[2], v0[3]); w.z = cvt_pk_bf16(v1[0], v1[1]); w.w = cvt_pk_bf16(v1[2], v1[3]);
                    *(u32x4*)(rowp + bj * HALF) = w; } }
    }
};
struct EpiRes {
    const float* xp; const float* xs; int rows_p; float* out; bf16_t* X1b; float* ssq;
    __device__ __forceinline__ const float* xrow(int row, int col0) const { return (row < rows_p ? xp + (size_t)row * 2048 : xs + (size_t)(row - rows_p) * 2048) + col0; }
    __device__ __forceinline__ void operator()(Acc& acc, const Unit& u, int wr, int wc, int fr, int fq) const {
        const int row0 = u.pm * BMR + wr * 144 + fr, col0 = u.pn * BN + wc * 32 + 8 * fq;
        f32x4 xr[2][4];
#define EPI_LOADX(g) do { const float* p_ = xrow(row0 + ((g) / 3) * 48 + ((g) % 3) * 16, col0); xr[(g) % 2][0] = *(const f32x4*)(p_); xr[(g) % 2][1] = *(const f32x4*)(p_ + 4); xr[(g) % 2][2] = *(const f32x4*)(p_ + HALF); xr[(g) % 2][3] = *(const f32x4*)(p_ + HALF + 4); } while (0)
        EPI_LOADX(0); EPI_LOADX(1);
#pragma unroll
        for (int g = 0; g < 9; ++g) {
            const int ai = g / 3, m = g % 3, row = row0 + ai * 48 + m * 16;
            float* orow = out + (size_t)row * 2048 + col0; float s = 0.f;
            f32x4 v[2][2];
#pragma unroll
            for (int bj = 0; bj < 2; ++bj) { v[bj][0] = acc[ai][bj][m][0] + xr[g % 2][2 * bj]; v[bj][1] = acc[ai][bj][m][1] + xr[g % 2][2 * bj + 1]; }
            asm volatile("" : "+v"(v[0][0]), "+v"(v[0][1]), "+v"(v[1][0]), "+v"(v[1][1]));
            if (g + 2 < 9) EPI_LOADX(g + 2);
#pragma unroll
            for (int bj = 0; bj < 2; ++bj) { const f32x4 v0 = v[bj][0], v1 = v[bj][1];
                if (out) { *(f32x4*)(orow + bj * HALF) = v0; *(f32x4*)(orow + bj * HALF + 4) = v1; }
                s += (v0[0] * v0[0] + v0[1] * v0[1]) + (v0[2] * v0[2] + v0[3] * v0[3]) + (v1[0] * v1[0] + v1[1] * v1[1]) + (v1[2] * v1[2] + v1[3] * v1[3]);
                if (X1b) { u32x4 w; w.x = cvt_pk_bf16(v0[0], v0[1]); w.y = cvt_pk_bf16(v0[2], v0[3]); w.z = cvt_pk_bf16(v1[0], v1[1]); w.w = cvt_pk_bf16(v1[2], v1[3]);
                    *(u32x4*)(X1b + (size_t)row * 2048 + col0 + bj * HALF) = w; } }
            s += __shfl_xor(s, 16); s += __shfl_xor(s, 32);
            if (fq == 0) atomicAdd(ssq + row, s);
        }
#undef EPI_LOADX
    }
};
struct EpiH {
    bf16_t* H; const float* ssq;
    __device__ __forceinline__ void operator()(Acc& acc, const Unit& u, int wr, int wc, int fr, int fq) const {
        const int row0 = u.pm * BMR + wr * 144 + fr, col0 = u.pn * HALF + wc * 32 + 8 * fq;
#pragma unroll
        for (int ai = 0; ai < 3; ++ai)
#pragma unroll
            for (int m = 0; m < 3; ++m) {
                const int row = row0 + ai * 48 + m * 16;
                const float r = rsqrtf(ssq[row] * (1.0f / 2048.0f) + 1e-6f);
                float h[8];
#pragma unroll
                for (int n = 0; n < 2; ++n)
#pragma unroll
                    for (int j = 0; j < 4; ++j) { const float g = acc[ai][0][m][n][j] * r, up = acc[ai][1][m][n][j] * r;
                        h[4 * n + j] = g * __builtin_amdgcn_rcpf(1.0f + __expf(-g)) * up; }
                u32x4 w; w.x = cvt_pk_bf16(h[0], h[1]); w.y = cvt_pk_bf16(h[2], h[3]); w.z = cvt_pk_bf16(h[4], h[5]); w.w = cvt_pk_bf16(h[6], h[7]);
                *(u32x4*)(H + (size_t)row * 5632 + col0) = w;
            }
    }
};

struct EpiH8 {
    unsigned char* H; const float* ssq; float hsc;
    __device__ __forceinline__ void operator()(Acc& acc, const Unit& u, int wr, int wc, int fr, int fq) const {
        const int row0 = u.pm * BMR + wr * 144 + fr, col0 = u.pn * HALF + wc * 32 + 8 * fq;
#pragma unroll
        for (int ai = 0; ai < 3; ++ai)
#pragma unroll
            for (int m = 0; m < 3; ++m) {
                const int row = row0 + ai * 48 + m * 16;
                const float r = rsqrtf(ssq[row] * (1.0f / 2048.0f) + 1e-6f), nr = r * -1.4426950408889634f, rr = r * r * hsc;
                float h[8];
#pragma unroll
                for (int n = 0; n < 2; ++n)
#pragma unroll
                    for (int j = 0; j < 4; j += 2) {
                        const pg8::f32x2 ga = {acc[ai][0][m][n][j], acc[ai][0][m][n][j + 1]}, ua = {acc[ai][1][m][n][j], acc[ai][1][m][n][j + 1]};
                        const pg8::f32x2 e = ga * nr, t = ga * ua * rr;
                        pg8::f32x2 d = {__builtin_amdgcn_exp2f(e.x), __builtin_amdgcn_exp2f(e.y)}; d = d + 1.0f;
                        const pg8::f32x2 q = t * (pg8::f32x2){__builtin_amdgcn_rcpf(d.x), __builtin_amdgcn_rcpf(d.y)};
                        h[4 * n + j] = __builtin_amdgcn_fmed3f(q.x, -448.f, 448.f); h[4 * n + j + 1] = __builtin_amdgcn_fmed3f(q.y, -448.f, 448.f); }
                int w0 = __builtin_amdgcn_cvt_pk_fp8_f32(h[0], h[1], 0, false); w0 = __builtin_amdgcn_cvt_pk_fp8_f32(h[2], h[3], w0, true);
                int w1 = __builtin_amdgcn_cvt_pk_fp8_f32(h[4], h[5], 0, false); w1 = __builtin_amdgcn_cvt_pk_fp8_f32(h[6], h[7], w1, true);
                *(unsigned long long*)(H + (size_t)row * 5632 + col0) = (unsigned long long)(unsigned)w0 | ((unsigned long long)(unsigned)w1 << 32);
            }
    }
};
struct EpiFinal {
    float* out; float* ssq; unsigned* cnt; const float* fg; const bf16_t* x1b;
    __device__ __forceinline__ void operator()(Acc& acc, const Unit& u, int wr, int wc, int fr, int fq) const {
        const int row0 = u.pm * BMR + wr * 144 + fr, col0 = u.pn * BN + wc * 32 + 8 * fq;
        { f32x4 xr[2][4];
#define EPI_LOADX(g) do { const size_t o_ = (size_t)(row0 + ((g) / 3) * 48 + ((g) % 3) * 16) * 2048 + col0; \
            if (x1b) { const u32x4 a_ = *(const u32x4*)(x1b + o_), b_ = *(const u32x4*)(x1b + o_ + HALF); \
                xr[(g) % 2][0] = (f32x4){__uint_as_float(a_.x << 16), __uint_as_float(a_.x & 0xffff0000u), __uint_as_float(a_.y << 16), __uint_as_float(a_.y & 0xffff0000u)}; \
                xr[(g) % 2][1] = (f32x4){__uint_as_float(a_.z << 16), __uint_as_float(a_.z & 0xffff0000u), __uint_as_float(a_.w << 16), __uint_as_float(a_.w & 0xffff0000u)}; \
                xr[(g) % 2][2] = (f32x4){__uint_as_float(b_.x << 16), __uint_as_float(b_.x & 0xffff0000u), __uint_as_float(b_.y << 16), __uint_as_float(b_.y & 0xffff0000u)}; \
                xr[(g) % 2][3] = (f32x4){__uint_as_float(b_.z << 16), __uint_as_float(b_.z & 0xffff0000u), __uint_as_float(b_.w << 16), __uint_as_float(b_.w & 0xffff0000u)}; } \
            else { const float* p_ = out + o_; xr[(g) % 2][0] = *(const f32x4*)(p_); xr[(g) % 2][1] = *(const f32x4*)(p_ + 4); xr[(g) % 2][2] = *(const f32x4*)(p_ + HALF); xr[(g) % 2][3] = *(const f32x4*)(p_ + HALF + 4); } } while (0)
          EPI_LOADX(0); EPI_LOADX(1);
#pragma unroll
          for (int g = 0; g < 9; ++g) {
              const int ai = g / 3, m = g % 3, row = row0 + ai * 48 + m * 16; float s = 0.f;
#pragma unroll
              for (int bj = 0; bj < 2; ++bj) { acc[ai][bj][m][0] += xr[g % 2][2 * bj]; acc[ai][bj][m][1] += xr[g % 2][2 * bj + 1]; }
              asm volatile("" : "+v"(acc[ai][0][m][0]), "+v"(acc[ai][0][m][1]), "+v"(acc[ai][1][m][0]), "+v"(acc[ai][1][m][1]));
              if (g + 2 < 9) EPI_LOADX(g + 2);
#pragma unroll
              for (int bj = 0; bj < 2; ++bj) { const f32x4 v0 = acc[ai][bj][m][0], v1 = acc[ai][bj][m][1];
                  s += (v0[0] * v0[0] + v0[1] * v0[1]) + (v0[2] * v0[2] + v0[3] * v0[3]) + (v1[0] * v1[0] + v1[1] * v1[1]) + (v1[2] * v1[2] + v1[3] * v1[3]); }
              s += __shfl_xor(s, 16); s += __shfl_xor(s, 32);
              if (fq == 0) atomicAdd(ssq + row, s);
          }
#undef EPI_LOADX
        }
        asm volatile("s_waitcnt vmcnt(0)" ::: "memory");
        unsigned* cw = cnt + 64 * u.pm;
        if ((threadIdx.x & 63) == 0) __hip_atomic_fetch_add(cw, 1u, __ATOMIC_RELAXED, __HIP_MEMORY_SCOPE_AGENT);
        { unsigned spins = 0;
          while ((unsigned)__builtin_amdgcn_readfirstlane(__hip_atomic_load(cw, __ATOMIC_RELAXED, __HIP_MEMORY_SCOPE_AGENT)) < 64u) { __builtin_amdgcn_s_sleep(2); if (++spins > (1u << 20)) break; } }
        f32x4 gv[2][2];
#pragma unroll
        for (int bj = 0; bj < 2; ++bj) { gv[bj][0] = *(const f32x4*)(fg + col0 + bj * HALF); gv[bj][1] = *(const f32x4*)(fg + col0 + bj * HALF + 4); }
#pragma unroll
        for (int ai = 0; ai < 3; ++ai)
#pragma unroll
            for (int m = 0; m < 3; ++m) {
                const int row = row0 + ai * 48 + m * 16; float* orow = out + (size_t)row * 2048 + col0;
                const float tot = __hip_atomic_load(ssq + row, __ATOMIC_RELAXED, __HIP_MEMORY_SCOPE_AGENT);
                const float r = rsqrtf(tot * (1.0f / 2048.0f) + 1e-6f);
#pragma unroll
                for (int bj = 0; bj < 2; ++bj) { *(f32x4*)(orow + bj * HALF) = acc[ai][bj][m][0] * r * gv[bj][0]; *(f32x4*)(orow + bj * HALF + 4) = acc[ai][bj][m][1] * r * gv[bj][1]; }
            }
    }
};

template <class Epi, bool ALIGN_EPI = true, bool FP8 = false, int SCA = 127, int SCB = 127>
__device__ __forceinline__ void gemm_phase(PG8_LAS unsigned char* lds, const Gemm g, const StaticOrder& S, const Epi& E) {
    const int tid = threadIdx.x, wid = __builtin_amdgcn_readfirstlane(tid >> 6), lane = tid & 63, wr = wid >> 2, wc = wid & 3, fr = lane & 15, fq = lane >> 4;
    const int K = g.K, nt = K / BK;
    unsigned voffA[2], voffB[2];
#pragma unroll
    for (int i = 0; i < 2; ++i) { const int R = 8 * (wid + 8 * i) + (lane >> 3), C = 8 * ((lane & 7) ^ (R & 7)); const int Ra = 144 * (R / 48) + (R % 48);
        voffA[i] = (unsigned)(Ra * K + C) * 2u;
        voffB[i] = (unsigned)((wid + 8 * i) * (K >> 6)) * 1024u + (unsigned)((lane >> 3) * 128 + (((lane & 7) ^ (lane >> 3)) << 4)); }
    const size_t kstep = (size_t)(BK * 2);
    const size_t kstepB = 1024;
    const size_t hstep = (size_t)HALF * K * 2;
    const size_t thA = (size_t)48 * K * 2;
    const size_t tstepA = (size_t)BMR * K * 2, tstepB = (size_t)BN * K * 2;
    const unsigned ldsw = (unsigned)wid * 1024u;
    const int aoff0 = (wr * 48 + fr) * 128 + ((fq ^ (fr & 7)) << 4), aoff1 = (wr * 48 + fr) * 128 + (((fq + 4) ^ (fr & 7)) << 4);
    const int boff0 = (wc * 32 + fr) * 128 + ((fq ^ (fr & 7)) << 4), boff1 = (wc * 32 + fr) * 128 + (((fq + 4) ^ (fr & 7)) << 4);
#define PG9_SA(b, a) (((b) * 3 + (a)) * ATB)
#define PG9_SB(b, h) (6 * ATB + ((b) * 2 + (h)) * HTB)
#define PG9_STAGE_B(bufoff, gbase) do { _Pragma("unroll") for (int _i = 0; _i < 2; ++_i) \
        __builtin_amdgcn_global_load_lds((const unsigned*)((const char*)(gbase) + voffB[_i]), (PG8_LAS unsigned*)(lds + (bufoff) + ldsw + _i * 8192), 16, 0, 0); } while (0)
#define PG9_STAGE_A(bufoff, gbase) do { __builtin_amdgcn_global_load_lds((const unsigned*)((const char*)(gbase) + voffA[0]), (PG8_LAS unsigned*)(lds + (bufoff) + ldsw), 16, 0, 0); \
        if (wr == 0) __builtin_amdgcn_global_load_lds((const unsigned*)((const char*)(gbase) + voffA[1]), (PG8_LAS unsigned*)(lds + (bufoff) + ldsw + 8192), 16, 0, 0); } while (0)
#define PG9_LDA(dst, b, a) do { _Pragma("unroll") for (int m = 0; m < 3; ++m) { if constexpr (FP8) { dst##8[m] = cat8(*(const PG8_LAS bf16x8*)(lds + PG9_SA(b, a) + aoff0 + m * 2048), *(const PG8_LAS bf16x8*)(lds + PG9_SA(b, a) + aoff1 + m * 2048)); } \
        else { dst[m][0] = *(const PG8_LAS bf16x8*)(lds + PG9_SA(b, a) + aoff0 + m * 2048); dst[m][1] = *(const PG8_LAS bf16x8*)(lds + PG9_SA(b, a) + aoff1 + m * 2048); } } } while (0)
#define PG9_LDB(dst, b, h) do { int _b0 = boff0, _b1 = boff1; asm volatile("" : "+v"(_b0), "+v"(_b1));     \
        _Pragma("unroll") for (int n = 0; n < 2; ++n) { if constexpr (FP8) { dst##8[n] = cat8(*(const PG8_LAS bf16x8*)(lds + PG9_SB(b, h) + _b0 + n * 2048), *(const PG8_LAS bf16x8*)(lds + PG9_SB(b, h) + _b1 + n * 2048)); } \
        else { dst[n][0] = *(const PG8_LAS bf16x8*)(lds + PG9_SB(b, h) + _b0 + n * 2048); dst[n][1] = *(const PG8_LAS bf16x8*)(lds + PG9_SB(b, h) + _b1 + n * 2048); } } } while (0)
#define PG9_MMA(ai, bj, At, Bt) do { __builtin_amdgcn_s_setprio(1); _Pragma("unroll") for (int m = 0; m < 3; ++m) _Pragma("unroll") for (int n = 0; n < 2; ++n) { \
        if constexpr (FP8) { acc[ai][bj][m][n] = __builtin_amdgcn_mfma_scale_f32_16x16x128_f8f6f4(Bt##8[n], At##8[m], acc[ai][bj][m][n], 0, 0, 0, SCB, 0, SCA); } \
        else { _Pragma("unroll") for (int k = 0; k < 2; ++k) acc[ai][bj][m][n] = __builtin_amdgcn_mfma_f32_16x16x32_bf16(Bt[n][k], At[m][k], acc[ai][bj][m][n], 0, 0, 0); } } __builtin_amdgcn_s_setprio(0); } while (0)
#define PG9_WAIT_V(n0, n1) do { if (wr == 0) asm volatile("s_waitcnt vmcnt(" #n0 ")" ::: "memory"); else asm volatile("s_waitcnt vmcnt(" #n1 ")" ::: "memory"); } while (0)
#define PG9_WAIT_L0 asm volatile("s_waitcnt lgkmcnt(0)" ::: "memory")
#define PG9_BAR __builtin_amdgcn_s_barrier()
#define PG9_SCHED __builtin_amdgcn_sched_barrier(0)
#define PG9_PIN(ai) do { if constexpr (FP8) asm volatile("" : "+v"(acc[ai][0][0][0]), "+v"(acc[ai][0][0][1]), "+v"(acc[ai][0][1][0]), "+v"(acc[ai][0][1][1]), "+v"(acc[ai][0][2][0]), "+v"(acc[ai][0][2][1]), \
        "+v"(acc[ai][1][0][0]), "+v"(acc[ai][1][0][1]), "+v"(acc[ai][1][1][0]), "+v"(acc[ai][1][1][1]), "+v"(acc[ai][1][2][0]), "+v"(acc[ai][1][2][1])); } while (0)
#define PG9_SCHED8 do { if constexpr (FP8) __builtin_amdgcn_sched_barrier(0); } while (0)
#define PG9_ZERO() do { _Pragma("unroll") for (int a = 0; a < 3; ++a) _Pragma("unroll") for (int b = 0; b < 2; ++b) _Pragma("unroll") for (int m = 0; m < 3; ++m) _Pragma("unroll") for (int n = 0; n < 2; ++n) acc[a][b][m][n] = (f32x4){0.f, 0.f, 0.f, 0.f}; } while (0)
    Unit cur, nxt; int ui = 0;
    if (!S.next(0, cur)) return;
    Acc acc; PG9_ZERO();
    bf16x8 At[3][2], B0[2][2], B1[2][2];
    v8i At8[3], B08[2], B18[2];
    const char* cA = (const char*)g.A + (size_t)cur.pm * tstepA; const char* cB = (const char*)g.Bt + (size_t)cur.pn * tstepB;
    PG9_STAGE_B(PG9_SB(0, 0), cB); PG9_STAGE_A(PG9_SA(0, 0), cA); PG9_STAGE_B(PG9_SB(0, 1), cB + hstep); PG9_STAGE_A(PG9_SA(0, 1), cA + thA); PG9_STAGE_A(PG9_SA(0, 2), cA + 2 * thA);
    PG9_STAGE_B(PG9_SB(1, 0), cB + kstepB); PG9_STAGE_A(PG9_SA(1, 0), cA + kstep); PG9_STAGE_B(PG9_SB(1, 1), cB + hstep + kstepB); PG9_STAGE_A(PG9_SA(1, 1), cA + thA + kstep);
    if (wr == 1) PG9_BAR;
    PG9_WAIT_V(12, 8); PG9_BAR; PG9_BAR;
    for (;;) {
        const bool has_next = S.next(ui + 1, nxt);
        const char* nA = has_next ? (const char*)g.A + (size_t)nxt.pm * tstepA : cA; const char* nB = has_next ? (const char*)g.Bt + (size_t)nxt.pn * tstepB : cB;
        for (int t = 0; t < nt; t += 2) {
            const bool last = (t == nt - 2);
            const char* a1 = cA + (size_t)(t + 1) * kstep;
            const char* a2 = last ? nA : cA + (size_t)(t + 2) * kstep; const char* b2 = last ? nB : cB + (size_t)(t + 2) * kstepB;
            const char* a3 = a2 + kstep; const char* b3 = b2 + kstepB;
            PG9_LDB(B0, 0, 0); PG9_LDB(B1, 0, 1); PG9_SCHED; PG9_LDA(At, 0, 0); PG9_STAGE_A(PG9_SA(1, 2), a1 + 2 * thA);
            PG9_WAIT_V(12, 8); PG9_WAIT_L0; PG9_BAR; PG9_SCHED8; PG9_MMA(0, 0, At, B0); PG9_MMA(0, 1, At, B1); PG9_PIN(0); PG9_SCHED8; PG9_BAR; PG9_SCHED;
            PG9_LDA(At, 0, 1); PG9_STAGE_B(PG9_SB(0, 0), b2); PG9_STAGE_A(PG9_SA(0, 0), a2);
            PG9_WAIT_V(14, 10); PG9_WAIT_L0; PG9_BAR; PG9_SCHED8; PG9_MMA(1, 0, At, B0); PG9_MMA(1, 1, At, B1); PG9_PIN(1); PG9_SCHED8; PG9_BAR; PG9_SCHED;
            PG9_LDA(At, 0, 2); PG9_STAGE_B(PG9_SB(0, 1), b2 + hstep); PG9_STAGE_A(PG9_SA(0, 1), a2 + thA);
            PG9_WAIT_V(12, 8); PG9_WAIT_L0; PG9_BAR; PG9_SCHED8; PG9_MMA(2, 0, At, B0); PG9_MMA(2, 1, At, B1); PG9_PIN(2); PG9_SCHED8; PG9_BAR; PG9_SCHED;
            PG9_LDB(B0, 1, 0); PG9_LDB(B1, 1, 1); PG9_SCHED; PG9_LDA(At, 1, 0); PG9_STAGE_A(PG9_SA(0, 2), a2 + 2 * thA);
            PG9_WAIT_V(12, 8); PG9_WAIT_L0; PG9_BAR; PG9_SCHED8; PG9_MMA(0, 0, At, B0); PG9_MMA(0, 1, At, B1); PG9_PIN(0); PG9_SCHED8; PG9_BAR; PG9_SCHED;
            PG9_LDA(At, 1, 1); PG9_STAGE_B(PG9_SB(1, 0), b3); PG9_STAGE_A(PG9_SA(1, 0), a3);
            PG9_WAIT_V(14, 10); PG9_WAIT_L0; PG9_BAR; PG9_SCHED8; PG9_MMA(1, 0, At, B0); PG9_MMA(1, 1, At, B1); PG9_PIN(1); PG9_SCHED8; PG9_BAR; PG9_SCHED;
            PG9_LDA(At, 1, 2); PG9_STAGE_B(PG9_SB(1, 1), b3 + hstep); PG9_STAGE_A(PG9_SA(1, 1), a3 + thA);
            PG9_WAIT_V(12, 8); PG9_WAIT_L0; PG9_BAR; PG9_SCHED8; PG9_MMA(2, 0, At, B0); PG9_MMA(2, 1, At, B1); PG9_PIN(2); PG9_SCHED8; PG9_BAR; PG9_SCHED;
        }
        if constexpr (ALIGN_EPI) { if (wr == 0) PG9_BAR; }
        E(acc, cur, wr, wc, fr, fq);
        if (!has_next) break;
        PG9_ZERO();
        cur = nxt; cA = nA; cB = nB; ++ui;
        if constexpr (ALIGN_EPI) { if (wr == 1) PG9_BAR; }
    }
    asm volatile("s_waitcnt vmcnt(0)" ::: "memory");
    if constexpr (!ALIGN_EPI) { if (wr == 0) PG9_BAR; }
    PG9_BAR;
#undef PG9_SA
#undef PG9_SB
#undef PG9_STAGE_A
#undef PG9_STAGE_B
#undef PG9_LDA
#undef PG9_LDB
#undef PG9_MMA
#undef PG9_WAIT_V
#undef PG9_WAIT_L0
#undef PG9_BAR
#undef PG9_SCHED
#undef PG9_SCHED8
#undef PG9_PIN
#undef PG9_ZERO
}
}
#define GAS __attribute__((address_space(1)))
#define LAS __attribute__((address_space(3)))
typedef unsigned short bf16;
typedef unsigned v4u __attribute__((ext_vector_type(4)));
typedef float f32x4 __attribute__((ext_vector_type(4)));
typedef short bf16x8 __attribute__((ext_vector_type(8)));
typedef GAS unsigned gu32;
typedef GAS unsigned long long gu64;
#define RLX_AGENT __ATOMIC_RELAXED, __HIP_MEMORY_SCOPE_AGENT
#define LDS_WAIT() asm volatile("s_waitcnt lgkmcnt(0)" ::: "memory")
#define VM_WAIT() asm volatile("s_waitcnt vmcnt(0)" ::: "memory")
__device__ __forceinline__ unsigned f2bf(float f) { unsigned u = __builtin_bit_cast(unsigned, f); return (u + 0x7fffu + ((u >> 16) & 1u)) >> 16; }
__device__ __forceinline__ unsigned pk2(float lo, float hi) { return f2bf(lo) | (f2bf(hi) << 16); }
__device__ __forceinline__ float bf2f(unsigned b) { return __builtin_bit_cast(float, b << 16); }
__device__ __forceinline__ float wave_sum(float v) {
#pragma unroll
    for (int o = 1; o < 64; o <<= 1) v += __shfl_xor(v, o);
    return v;
}
__device__ __forceinline__ float sigmoidf_(float x) { return 1.f / (1.f + __expf(-x)); }
__device__ __forceinline__ float log_sigmoid(float x) { return fminf(x, 0.f) - log1pf(__expf(-fabsf(x))); }

#define XB_TMO      128
#define XB_XCNT(j)  (256  + 64 * (j))
#define XB_XSUB(j)  (1280 + 64 * (j))
#define XB_XGEN(j)  (2304 + 64 * (j))
#define XB_TOP      3328
#define XB_TOPGEN   3392
#define XCD_BAR_WORDS 3456
#define XB_SPIN_CAP (1u << 18)

__device__ __forceinline__ unsigned xb_ld(unsigned* p)              { return __hip_atomic_load(p, __ATOMIC_RELAXED, __HIP_MEMORY_SCOPE_AGENT); }
__device__ __forceinline__ unsigned xb_add(unsigned* p, unsigned v) { return __hip_atomic_fetch_add(p, v, __ATOMIC_RELAXED, __HIP_MEMORY_SCOPE_AGENT); }
__device__ __forceinline__ unsigned xb_xcc_id() { return (unsigned)__builtin_amdgcn_s_getreg((3 << 11) | 20) & 0xFu; }
#define XB_SPIN(cond, bar) do { unsigned _sp = 0; while (cond) { __builtin_amdgcn_s_sleep(1); \
    if ((++_sp & 255u) == 0u) { if (xb_ld(&(bar)[XB_TMO])) break; if (_sp > XB_SPIN_CAP) { atomicAdd(&(bar)[XB_TMO], 1u); break; } } } } while (0)

struct XcdBarrier {
    unsigned* bar; unsigned x;
    volatile LAS unsigned* st;
};

__device__ __forceinline__ XcdBarrier xcd_barrier_post(unsigned* bar, volatile LAS unsigned* st) {
    XcdBarrier b; b.bar = bar; b.x = xb_xcc_id(); b.st = st;
    if (threadIdx.x == 0) (void)xb_add(&bar[XB_XCNT(b.x)], 1u);
    return b;
}
__device__ __forceinline__ void xcd_barrier_complete(unsigned* bar, unsigned x, unsigned& nloc, unsigned& nx) {
    const unsigned G = gridDim.x * gridDim.y * gridDim.z;
    unsigned sum, cnt, mine, sp = 0u;
    for (;;) {
        sum = 0u; cnt = 0u; mine = 0u;
#pragma unroll
        for (unsigned j = 0; j < 16; ++j) { const unsigned c = xb_ld(&bar[XB_XCNT(j)]); sum += c; cnt += (c > 0u) ? 1u : 0u; mine = (j == x) ? c : mine; }
        if (sum == G) break;
        __builtin_amdgcn_s_sleep(1);
        if ((++sp & 255u) == 0u) { if (xb_ld(&bar[XB_TMO])) break; if (sp > XB_SPIN_CAP) { atomicAdd(&bar[XB_TMO], 1u); break; } }
    }
    nloc = mine > 0u ? mine : 1u; nx = cnt > 0u ? cnt : 1u;
}

__device__ __forceinline__ void xcd_barrier(const XcdBarrier& b) {
    asm volatile("s_waitcnt vmcnt(0)" ::: "memory");
    __syncthreads();
    if (threadIdx.x == 0) {
        unsigned* bar = b.bar;
        __builtin_amdgcn_s_waitcnt(0);
        unsigned nloc = b.st[0], nx = b.st[1];
        if (nloc == 0u) { xcd_barrier_complete(bar, b.x, nloc, nx); b.st[0] = nloc; b.st[1] = nx; }
        const unsigned old = xb_add(&bar[XB_XSUB(b.x)], 1u);
        const unsigned gen = old / nloc;
        if (old + 1u == (gen + 1u) * nloc) {
            __builtin_amdgcn_fence(__ATOMIC_RELEASE, "agent");
            asm volatile("s_waitcnt vmcnt(0)" ::: "memory");
            const unsigned og = xb_add(&bar[XB_TOP], 1u);
            const unsigned tg = og / nx;
            if (og + 1u == (tg + 1u) * nx) xb_add(&bar[XB_TOPGEN], 1u);
            else XB_SPIN(xb_ld(&bar[XB_TOPGEN]) == tg, bar);
            __builtin_amdgcn_fence(__ATOMIC_ACQUIRE, "agent");
            xb_add(&bar[XB_XGEN(b.x)], 1u);
            asm volatile("s_waitcnt vmcnt(0)" ::: "memory");
        } else {
            XB_SPIN(xb_ld(&bar[XB_XGEN(b.x)]) == gen, bar);
            __builtin_amdgcn_fence(__ATOMIC_ACQUIRE, "agent");
            asm volatile("s_waitcnt vmcnt(0)" ::: "memory");
        }
    }
    __syncthreads();
}
struct Frame {
    LAS unsigned char* lds;
    volatile LAS unsigned* MISC;
    gu32* ctl;
    int tid, lane, wave;
    int vcu, G;
    const float *x_p, *x_s, *st_conv, *st_C, *st_n, *st_m, *g1, *w_in, *b_i, *b_f, *conv_w, *conv_g, *ml_g, *w_out, *g2, *wg, *wu, *wd, *fg;
    float* out;
    bf16 *W1, *W2, *W3, *W4, *XN, *YC, *Z, *HB, *X1b;
    float *gates, *ssq1, *ssq2;
};

struct TrItem { const float* W; int ldw, K, nblk; bf16* WT; int mode; const float* kgain; int item; };
__device__ __forceinline__ void p0_tr_load(const TrItem& T, int lane, f32x4 (&v)[16]) {
    const int kb = T.item / T.nblk, nb = T.item % T.nblk, k0 = 64 * kb, n0 = 64 * nb; const int r4 = lane >> 4, c4 = 4 * (lane & 15);
#pragma unroll
    for (int i = 0; i < 16; ++i) v[i] = *(const GAS f32x4*)(T.W + (size_t)(k0 + 4 * i + r4) * T.ldw + n0 + c4);
}
__device__ __forceinline__ void p0_tr_finish(const TrItem& T, int lane, const f32x4 (&v)[16], LAS float* scr) {
    const int kb = T.item / T.nblk, nb = T.item % T.nblk, k0 = 64 * kb, n0 = 64 * nb; const int r4 = lane >> 4, c4 = 4 * (lane & 15);
#pragma unroll
    for (int i = 0; i < 16; ++i) { const int kk = 4 * i + r4; const float g = T.kgain ? T.kgain[k0 + kk] : 1.f; LAS float* d = scr + kk * 65 + c4; d[0] = v[i].x * g; d[1] = v[i].y * g; d[2] = v[i].z * g; d[3] = v[i].w * g; }
    LDS_WAIT(); asm volatile("" ::: "memory");
    const int c = lane & 7;
#pragma unroll
    for (int j = 0; j < 8; ++j) { const int n = (lane >> 3) + 8 * j; const LAS float* s = scr + (8 * c) * 65 + n;
        v4u o; o.x = pk2(s[0 * 65], s[1 * 65]); o.y = pk2(s[2 * 65], s[3 * 65]); o.z = pk2(s[4 * 65], s[5 * 65]); o.w = pk2(s[6 * 65], s[7 * 65]);
        const int jn = n0 + n; int drow = jn; if (T.mode == 1) drow = 256 * (jn >> 7) + (jn & 127); if (T.mode == 2) drow = 256 * (jn >> 7) + 128 + (jn & 127);
        if (T.mode == 3) {
            if (jn >= ZC_CG && jn < ZC_XT) { const int cc = jn - ZC_CG; drow = ZC_CG + 256 * (cc >> 7) + (cc & 127); }
            else if (jn >= ZC_XT && jn < ZC_Q) { const int cc = jn - ZC_XT; drow = ZC_CG + 256 * (cc >> 7) + 128 + (cc & 127); } }
        const int x = drow & 31, slot = (drow & ~31) + 16 * ((x >> 2) & 1) + 4 * (x >> 3) + (x & 3);
        *(GAS v4u*)((GAS unsigned char*)T.WT + ((size_t)(slot >> 3) * (T.K >> 6) + (k0 >> 6)) * 1024 + (slot & 7) * 128 + 16 * c) = o; }
    LDS_WAIT(); asm volatile("" ::: "memory");
}
__device__ __forceinline__ void p0_tr_finish_fp8(const TrItem& T, int lane, const f32x4 (&v)[16], LAS float* scr, float wsc) {
    const int kb = T.item / T.nblk, nb = T.item % T.nblk, k0 = 64 * kb, n0 = 64 * nb; const int r4 = lane >> 4, c4 = 4 * (lane & 15);
#pragma unroll
    for (int i = 0; i < 16; ++i) { const int kk = 4 * i + r4; LAS float* d = scr + kk * 65 + c4; d[0] = v[i].x * wsc; d[1] = v[i].y * wsc; d[2] = v[i].z * wsc; d[3] = v[i].w * wsc; }
    LDS_WAIT(); asm volatile("" ::: "memory");
    const int c = lane & 3;
#pragma unroll
    for (int j = 0; j < 4; ++j) { const int n = (lane >> 2) + 16 * j; const LAS float* s = scr + (16 * c) * 65 + n; int w[4];
#pragma unroll
        for (int q = 0; q < 4; ++q) { w[q] = __builtin_amdgcn_cvt_pk_fp8_f32(s[(4 * q) * 65], s[(4 * q + 1) * 65], 0, false); w[q] = __builtin_amdgcn_cvt_pk_fp8_f32(s[(4 * q + 2) * 65], s[(4 * q + 3) * 65], w[q], true); }
        const int drow = n0 + n, x = drow & 31, slot = (drow & ~31) + 16 * ((x >> 2) & 1) + 4 * (x >> 3) + (x & 3);
        v4u o; o.x = (unsigned)w[0]; o.y = (unsigned)w[1]; o.z = (unsigned)w[2]; o.w = (unsigned)w[3];
        *(GAS v4u*)((GAS unsigned char*)T.WT + ((size_t)(slot >> 3) * (T.K >> 7) + (k0 >> 7)) * 1024 + (slot & 7) * 128 + (k0 & 127) + 16 * c) = o; }
    LDS_WAIT(); asm volatile("" ::: "memory");
}
__device__ __forceinline__ void p0_transpose_item_fp8(const float* W, int ldw, int K, int nblk, bf16* WT, LAS float* scr, int item, int lane, float wsc) {
    const TrItem T{W, ldw, K, nblk, WT, 0, nullptr, item}; f32x4 v[16]; p0_tr_load(T, lane, v); p0_tr_finish_fp8(T, lane, v, scr, wsc);
}
__device__ __forceinline__ void p0_transpose_item(const float* W, int ldw, int K, int nblk, bf16* WT, int mode, const float* kgain, LAS float* scr, int item, int lane) {
    const TrItem T{W, ldw, K, nblk, WT, mode, kgain, item}; f32x4 v[16]; p0_tr_load(T, lane, v); p0_tr_finish(T, lane, v, scr);
}
__device__ __forceinline__ void p0_xrow_load(Frame& F, int m, f32x4 (&v)[8]) {
    const float* xr = m < MP ? F.x_p + (size_t)m * D : F.x_s + (size_t)(m - MP) * D;
#pragma unroll
    for (int j = 0; j < 8; ++j) v[j] = *(const GAS f32x4*)(xr + 256 * j + 4 * F.lane);
}
__device__ __forceinline__ void p0_xrow(Frame& F, int m, const LAS float* gwl, const f32x4 (&v)[8], const f32x4 (&g)[8], float bq) {
    const int lane = F.lane; float s = 0.f;
#pragma unroll
    for (int j = 0; j < 8; ++j) s += (v[j].x * v[j].x + v[j].y * v[j].y) + (v[j].z * v[j].z + v[j].w * v[j].w);
    const float r = rsqrtf(wave_sum(s) * (1.f / D) + EPS);
    float ga[8]; pg8::f32x2 ga2[8];
#pragma unroll
    for (int q = 0; q < 8; ++q) ga2[q] = (pg8::f32x2){0.f, 0.f};
#pragma unroll
    for (int j = 0; j < 8; ++j) {
        const int k = 256 * j + 4 * lane;
        const f32x4 xn = v[j] * r * g[j];
        *(GAS unsigned long long*)(F.XN + (size_t)m * D + k) = (unsigned long long)pg8::cvt_pk_bf16(xn.x, xn.y) | ((unsigned long long)pg8::cvt_pk_bf16(xn.z, xn.w) << 32);
        f32x4 w[8];
#pragma unroll
        for (int q = 0; q < 8; ++q) w[q] = *(const LAS f32x4*)(gwl + q * D + k);
        const pg8::f32x2 xlo = {xn.x, xn.y}, xhi = {xn.z, xn.w};
#pragma unroll
        for (int q = 0; q < 8; ++q) { ga2[q] = __builtin_elementwise_fma(xlo, (pg8::f32x2){w[q].x, w[q].y}, ga2[q]); ga2[q] = __builtin_elementwise_fma(xhi, (pg8::f32x2){w[q].z, w[q].w}, ga2[q]); }
    }
#pragma unroll
    for (int q = 0; q < 8; ++q) ga[q] = ga2[q].x + ga2[q].y;
    float k4[4], k2[2], k1;
    { const bool hi = (lane & 32) != 0;
#pragma unroll
      for (int i = 0; i < 4; ++i) { const float recv = __shfl_xor(hi ? ga[i] : ga[4 + i], 32); k4[i] = (hi ? ga[4 + i] : ga[i]) + recv; } }
    { const bool hi = (lane & 16) != 0;
#pragma unroll
      for (int i = 0; i < 2; ++i) { const float recv = __shfl_xor(hi ? k4[i] : k4[2 + i], 16); k2[i] = (hi ? k4[2 + i] : k4[i]) + recv; } }
    { const bool hi = (lane & 8) != 0; const float recv = __shfl_xor(hi ? k2[0] : k2[1], 8); k1 = (hi ? k2[1] : k2[0]) + recv; }
    k1 += __shfl_xor(k1, 4); k1 += __shfl_xor(k1, 2); k1 += __shfl_xor(k1, 1);
    if ((lane & 7) == 0) { const int q = lane >> 3; F.gates[(size_t)m * 8 + q] = q < 4 ? k1 + bq : log_sigmoid(k1 + bq); }
}
constexpr int TR_I1 = (D / 64) * (NZ / 64), TR_I2 = (D / 64) * (D / 64), TR_I3 = (D / 64) * (FF / 64), TR_I4 = (FF / 64) * (D / 64);
__device__ __forceinline__ TrItem tr_make(Frame& F, int it) {
    int r = it;
    if (r < TR_I1) return TrItem{F.w_in, NIN, D, NZ / 64, F.W1, 3, nullptr, r}; r -= TR_I1;
    if (r < TR_I2) return TrItem{F.w_out, D, D, D / 64, F.W2, 0, nullptr, r}; r -= TR_I2;
    if (r < TR_I3) return TrItem{F.wg, FF, D, FF / 64, F.W3, 1, F.g2, r}; r -= TR_I3;
    if (r < TR_I3) return TrItem{F.wu, FF, D, FF / 64, F.W3, 2, F.g2, r}; r -= TR_I3;
    return TrItem{F.wd, D, FF, D / 64, F.W4, 0, nullptr, r};
}
__device__ __forceinline__ void tr_run(Frame& F, int lo, int hi, int first, int stride, LAS float* scr) {
    f32x4 va[16], vb[16]; int it = lo + first; TrItem Ta{}, Tb{};
    if (it < hi) { Ta = tr_make(F, it); p0_tr_load(Ta, F.lane, va); }
    while (it < hi) {
        const int it2 = it + stride;
        if (it2 < hi) { Tb = tr_make(F, it2); p0_tr_load(Tb, F.lane, vb); }
        p0_tr_finish(Ta, F.lane, va, scr);
        if (it2 >= hi) break;
        const int it3 = it2 + stride;
        if (it3 < hi) { Ta = tr_make(F, it3); p0_tr_load(Ta, F.lane, va); }
        p0_tr_finish(Tb, F.lane, vb, scr);
        it = it3;
    }
}
__device__ __forceinline__ void p0_prologue(Frame& F, bool w4_later, bool w23_later) {
    LAS float* scr = (LAS float*)(F.lds + RING_OFF + F.wave * 16640);
    const int gw = F.vcu * NWAVES + F.wave, NGW = F.G * NWAVES;
    constexpr int I_1 = (D / 64) * (NZ / 64), I_2 = (D / 64) * (D / 64), I_3 = (D / 64) * (FF / 64), I_4 = (FF / 64) * (D / 64);
    constexpr int NITEMS = I_1 + I_2 + 2 * I_3 + I_4;
    const int NIT = w23_later ? I_1 : (w4_later ? NITEMS - I_4 : NITEMS);
    tr_run(F, 0, NIT, gw, NGW, scr);
    __syncthreads();
    LAS float* gwl = (LAS float*)(F.lds + RING_OFF);
    for (int k = F.tid; k < D; k += NWAVES * 64) {
        const f32x4 a = *(const GAS f32x4*)(F.w_in + (size_t)k * NIN + NZ), b = *(const GAS f32x4*)(F.w_in + (size_t)k * NIN + NZ + 4);
        gwl[0 * D + k] = a.x; gwl[1 * D + k] = a.y; gwl[2 * D + k] = a.z; gwl[3 * D + k] = a.w; gwl[4 * D + k] = b.x; gwl[5 * D + k] = b.y; gwl[6 * D + k] = b.z; gwl[7 * D + k] = b.w;
    }
    __syncthreads();
    {
        f32x4 g[8];
#pragma unroll
        for (int j = 0; j < 8; ++j) g[j] = *(const GAS f32x4*)(F.g1 + 256 * j + 4 * F.lane);
        const float bq = (F.lane >> 3) < 4 ? F.b_i[F.lane >> 3] : F.b_f[(F.lane >> 3) - 4];
        f32x4 va[8], vb[8]; int m = gw;
        p0_xrow_load(F, m < M ? m : M - 1, va);
        while (m < M) {
            const int m2 = m + NGW;
            p0_xrow_load(F, m2 < M ? m2 : M - 1, vb);
            asm volatile("" ::: "memory");
            p0_xrow(F, m, gwl, va, g, bq);
            if (m2 >= M) break;
            const int m3 = m2 + NGW;
            p0_xrow_load(F, m3 < M ? m3 : M - 1, va);
            asm volatile("" ::: "memory");
            p0_xrow(F, m2, gwl, vb, g, bq);
            m = m3;
        }
    }
    __syncthreads();
}
__device__ __forceinline__ void final_norm_phase(Frame& F) {
    const int gw = F.vcu * NWAVES + F.wave, NGW = F.G * NWAVES;
    for (int m = gw; m < M; m += NGW) {
        const float r = rsqrtf(F.ssq2[m] * (1.f / D) + EPS);
#pragma unroll
        for (int j = 0; j < 8; ++j) { GAS f32x4* p = (GAS f32x4*)(F.out + (size_t)m * D + 256 * j + 4 * F.lane); const f32x4 g = *(const GAS f32x4*)(F.fg + 256 * j + 4 * F.lane); *p = *p * r * g; }
    }
}
__device__ __forceinline__ void unpack8(const v4u w, float (&f)[8]) {
    f[0] = bf2f(w.x & 0xffffu); f[1] = bf2f(w.x >> 16); f[2] = bf2f(w.y & 0xffffu); f[3] = bf2f(w.y >> 16);
    f[4] = bf2f(w.z & 0xffffu); f[5] = bf2f(w.z >> 16); f[6] = bf2f(w.w & 0xffffu); f[7] = bf2f(w.w >> 16);
}
__device__ __forceinline__ void conv_item(Frame& F, int item) {
    const bool prompt = item < 1024;
    const int b = prompt ? (item >> 8) : (item - 1024);
    const int row0 = prompt ? 8 * item : MP + 8 * (item - 1024);
    const int t0 = prompt ? 8 * (item & 255) : 0;
    const bool last_item = prompt ? ((item & 255) == 255) : true;
    const int lane = F.lane;
    float w0[16], w1[16], w2[16], cg_[16], up2[16], up1[16];
#pragma unroll
    for (int p = 0; p < 2; ++p) {
        const int c0 = 8 * lane + 512 * p;
#pragma unroll
        for (int q = 0; q < 2; ++q) {
            const f32x4 a = *(const GAS f32x4*)(F.conv_w + c0 + 4 * q), bb = *(const GAS f32x4*)(F.conv_w + DC + c0 + 4 * q), c = *(const GAS f32x4*)(F.conv_w + 2 * DC + c0 + 4 * q), g = *(const GAS f32x4*)(F.conv_g + c0 + 4 * q);
#pragma unroll
            for (int i = 0; i < 4; ++i) { w0[8 * p + 4 * q + i] = a[i]; w1[8 * p + 4 * q + i] = bb[i]; w2[8 * p + 4 * q + i] = c[i]; cg_[8 * p + 4 * q + i] = g[i]; }
        }
    }
    if (prompt) {
        if (t0 == 0) {
#pragma unroll
            for (int i = 0; i < 16; ++i) { up2[i] = 0.f; up1[i] = 0.f; }
        } else {
#pragma unroll
            for (int p = 0; p < 2; ++p) {
                const int c0 = 8 * lane + 512 * p; float a[8];
                const bf16* z2 = F.Z + (size_t)(row0 - 2) * NZ; const bf16* z1 = F.Z + (size_t)(row0 - 1) * NZ;
                unpack8(*(const GAS v4u*)(z2 + ZC_CG + c0), a);
#pragma unroll
                for (int i = 0; i < 8; ++i) up2[8 * p + i] = a[i];
                unpack8(*(const GAS v4u*)(z1 + ZC_CG + c0), a);
#pragma unroll
                for (int i = 0; i < 8; ++i) up1[8 * p + i] = a[i];
            }
        }
    } else {
#pragma unroll
        for (int p = 0; p < 2; ++p) {
            const int c0 = 8 * lane + 512 * p;
#pragma unroll
            for (int q = 0; q < 2; ++q) {
                const f32x4 a = *(const GAS f32x4*)(F.st_conv + ((size_t)b * 2 + 0) * DC + c0 + 4 * q), bb = *(const GAS f32x4*)(F.st_conv + ((size_t)b * 2 + 1) * DC + c0 + 4 * q);
#pragma unroll
                for (int i = 0; i < 4; ++i) { up2[8 * p + 4 * q + i] = a[i]; up1[8 * p + 4 * q + i] = bb[i]; }
            }
        }
    }
#pragma unroll 1
    for (int r = 0; r < 8; ++r) {
        const int row = row0 + r; const bf16* zr = F.Z + (size_t)row * NZ;
        float tt[16]; float ss = 0.f;
#pragma unroll
        for (int p = 0; p < 2; ++p) {
            const int c0 = 8 * lane + 512 * p; float a[8], g[8];
            unpack8(*(const GAS v4u*)(zr + ZC_CG + c0), a); unpack8(*(const GAS v4u*)(zr + ZC_BG + c0), g);
#pragma unroll
            for (int i = 0; i < 8; ++i) { const int ci = 8 * p + i; const float u = a[i];
                const float cv = w0[ci] * up2[ci] + w1[ci] * up1[ci] + w2[ci] * u; tt[ci] = g[i] * cv; ss += tt[ci] * tt[ci]; up2[ci] = up1[ci]; up1[ci] = u; }
        }
        const float rr = rsqrtf(wave_sum(ss) * (1.f / DC) + EPS);
#pragma unroll
        for (int p = 0; p < 2; ++p) {
            const int c0 = 8 * lane + 512 * p; v4u o;
            o.x = pk2(tt[8 * p + 0] * rr * cg_[8 * p + 0], tt[8 * p + 1] * rr * cg_[8 * p + 1]); o.y = pk2(tt[8 * p + 2] * rr * cg_[8 * p + 2], tt[8 * p + 3] * rr * cg_[8 * p + 3]);
            o.z = pk2(tt[8 * p + 4] * rr * cg_[8 * p + 4], tt[8 * p + 5] * rr * cg_[8 * p + 5]); o.w = pk2(tt[8 * p + 6] * rr * cg_[8 * p + 6], tt[8 * p + 7] * rr * cg_[8 * p + 7]);
            *(GAS v4u*)(F.YC + (size_t)row * D + c0) = o;
        }
        if (last_item && r >= 6) {
            float* o = F.out + (prompt ? O_PCONV : O_SCONV) + ((size_t)b * 2 + (r - 6)) * DC;
#pragma unroll
            for (int p = 0; p < 2; ++p) { const int c0 = 8 * lane + 512 * p;
                *(GAS f32x4*)(o + c0) = (f32x4){up1[8 * p + 0], up1[8 * p + 1], up1[8 * p + 2], up1[8 * p + 3]}; *(GAS f32x4*)(o + c0 + 4) = (f32x4){up1[8 * p + 4], up1[8 * p + 5], up1[8 * p + 6], up1[8 * p + 7]}; }
        }
    }
}

template <bool WITH_STATE>
__device__ __forceinline__ void sample_item(Frame& F, int item) {
    LAS float* L = (LAS float*)(F.lds + RING_OFF);
    LAS float* qT = L; LAS float* kT = L + 1024; LAS float* kwT = L + 2048; LAS float* qR = L + 3072; LAS float* kR = L + 4128; LAS float* vS = L + 5184; LAS float* accx = L + 7232; LAS float* Sm = L + 23616;
    LAS float* ai = L + 23680; LAS float* dd = L + 23688; LAS float* wk = L + 23696; LAS float* misc = L + 23704; LAS float* n0s = L + 23712; LAS float* red = L + 23840; LAS float* lis = L + 23872; LAS float* lfs = L + 23880;
    const int tid = F.tid, b = item >> 2, h = item & 3, row0 = MP + 8 * b;
    __syncthreads();
    if (tid < 256) { const int isk = tid >> 7, t = (tid >> 4) & 7, c = tid & 15; float f[8];
        unpack8(*(const GAS v4u*)(F.Z + (size_t)(row0 + t) * NZ + (isk ? ZC_K : ZC_Q) + h * DK + 8 * c), f);
        LAS float* T_ = isk ? kT : qT; LAS float* R_ = isk ? kR : qR; const float sc_ = isk ? 1.f : QSCALE;
#pragma unroll
        for (int i = 0; i < 8; ++i) { const float x = f[i] * sc_; T_[(8 * c + i) * 8 + t] = x; R_[t * 132 + 8 * c + i] = x; }
    } else { const int u = tid - 256, t = u >> 5, c = u & 31; float f[8]; unpack8(*(const GAS v4u*)(F.Z + (size_t)(row0 + t) * NZ + ZC_V + h * DV + 8 * c), f);
#pragma unroll
        for (int i = 0; i < 8; ++i) vS[t * 256 + 8 * c + i] = f[i]; }
    if (tid < 8) { lis[tid] = F.gates[(size_t)(row0 + tid) * 8 + h]; lfs[tid] = F.gates[(size_t)(row0 + tid) * 8 + 4 + h]; }
    if (tid >= 64 && tid < 64 + DK) n0s[tid - 64] = F.st_n[(size_t)(b * NH + h) * DK + tid - 64];
    __syncthreads();
    if (F.wave == 0) {
        const int lane = F.lane, t = lane >> 3, s = lane & 7;
        const float m0 = F.st_m[b * NH + h];
        float bc[8]; { float run = 0.f;
#pragma unroll
            for (int i = 0; i < 8; ++i) { run += lfs[i]; bc[i] = run; } }
        float bt = 0.f, bs = 0.f;
#pragma unroll
        for (int i = 0; i < 8; ++i) { bt = (i == t) ? bc[i] : bt; bs = (i == s) ? bc[i] : bs; }
        const float lis_s = lis[s];
        const float dm = (s <= t) ? (bt - bs + lis_s) : -INFINITY;
        float mx = dm; mx = fmaxf(mx, __shfl_xor(mx, 1)); mx = fmaxf(mx, __shfl_xor(mx, 2)); mx = fmaxf(mx, __shfl_xor(mx, 4));
        const float mt = fmaxf(bt + m0, mx);
        const float w = (s <= t) ? __expf(dm - mt) : 0.f;
        const float a_i = __expf(bt + m0 - mt);
        float dot = 0.f, qn = 0.f;
#pragma unroll 8
        for (int d4 = 0; d4 < DK; d4 += 4) { const f32x4 qv = *(const LAS f32x4*)(qR + t * 132 + d4), kv = *(const LAS f32x4*)(kR + s * 132 + d4), nv = *(const LAS f32x4*)(n0s + d4);
            dot += (qv.x * kv.x + qv.y * kv.y) + (qv.z * kv.z + qv.w * kv.w); qn += (qv.x * nv.x + qv.y * nv.y) + (qv.z * nv.z + qv.w * nv.w); }
        const float sv = dot * w;
        float rs = sv; rs += __shfl_xor(rs, 1); rs += __shfl_xor(rs, 2); rs += __shfl_xor(rs, 4);
        const float den = a_i * qn + rs;
        Sm[t * 8 + s] = sv;
        const float bL = bc[7];
        const float gs = bL - bs + lis_s;
        float gm = gs; gm = fmaxf(gm, __shfl_xor(gm, 1)); gm = fmaxf(gm, __shfl_xor(gm, 2)); gm = fmaxf(gm, __shfl_xor(gm, 4));
        const float mnew = fmaxf(bL + m0, gm);
        if (s == 0) { ai[t] = a_i; dd[t] = 1.f / fmaxf(fabsf(den), __expf(-mt)); }
        if (t == 0) wk[s] = __expf(gs - mnew);
        if (lane == 0) { misc[0] = __expf(bL + m0 - mnew); misc[1] = mnew; }
    }
    __syncthreads();
    const float sc = misc[0];
    for (int i = tid; i < 1024; i += NWAVES * 64) kwT[i] = kT[i] * wk[i & 7];
    __syncthreads();
    if (tid < DK) { float nn = sc * n0s[tid];
#pragma unroll
        for (int s = 0; s < 8; ++s) nn += kwT[tid * 8 + s];
        F.out[O_SN + (size_t)(b * NH + h) * DK + tid] = nn; }
    if (tid == 0) F.out[O_SM + b * NH + h] = misc[1];
    { const int e4 = tid & 63, dg = F.wave;
      f32x4 vv[8], acc[8];
#pragma unroll
      for (int s = 0; s < 8; ++s) { vv[s] = *(const LAS f32x4*)(vS + s * 256 + 4 * e4); acc[s] = (f32x4){0.f, 0.f, 0.f, 0.f}; }
      const float* c0p = F.st_C + ((size_t)(b * NH + h) * DK + 16 * dg) * DV + 4 * e4;
      float* c1p = F.out + O_SC + ((size_t)(b * NH + h) * DK + 16 * dg) * DV + 4 * e4;
      {   constexpr int d0 = 0;
          f32x4 c[16];
#pragma unroll
          for (int j = 0; j < 16; ++j) c[j] = *(const GAS f32x4*)(c0p + (size_t)(d0 + j) * DV);
#pragma unroll
          for (int j = 0; j < 16; ++j) {
              const int d = 16 * dg + d0 + j;
              const f32x4 q0 = *(const LAS f32x4*)(qT + d * 8), q1 = *(const LAS f32x4*)(qT + d * 8 + 4), k0 = *(const LAS f32x4*)(kwT + d * 8), k1 = *(const LAS f32x4*)(kwT + d * 8 + 4);
              f32x4 cn = c[j] * sc;
#pragma unroll
              for (int s = 0; s < 4; ++s) { acc[s] += c[j] * q0[s]; acc[4 + s] += c[j] * q1[s]; if (WITH_STATE) { cn += vv[s] * k0[s]; cn += vv[4 + s] * k1[s]; } }
              if (WITH_STATE) *(GAS f32x4*)(c1p + (size_t)(d0 + j) * DV) = cn;
          }
      }
#pragma unroll
      for (int t = 0; t < 8; ++t) *(LAS f32x4*)(accx + (dg * 8 + t) * 256 + 4 * e4) = acc[t];
    }
    __syncthreads();
    { const int e = tid & 255, th = tid >> 8; float hv[4];
#pragma unroll
      for (int tt = 0; tt < 4; ++tt) { const int t = 4 * th + tt; float a = 0.f;
#pragma unroll
          for (int w = 0; w < 8; ++w) a += accx[(w * 8 + t) * 256 + e];
          float num = ai[t] * a;
#pragma unroll
          for (int s = 0; s < 8; ++s) num += Sm[t * 8 + s] * vS[s * 256 + e];
          hv[tt] = num * dd[t]; const float p = wave_sum(hv[tt] * hv[tt]); if (F.lane == 0) red[F.wave * 4 + tt] = p; }
      __syncthreads();
      const float gml = F.ml_g[h * DV + e];
#pragma unroll
      for (int tt = 0; tt < 4; ++tt) { const int t = 4 * th + tt, w0 = 4 * th;
          const float rr = rsqrtf((red[(w0 + 0) * 4 + tt] + red[(w0 + 1) * 4 + tt] + red[(w0 + 2) * 4 + tt] + red[(w0 + 3) * 4 + tt]) * (1.f / DV) + EPS);
          const float o = bf2f(F.Z[(size_t)(row0 + t) * NZ + ZC_O + h * DV + e]);
          F.YC[(size_t)(row0 + t) * D + DC + h * DV + e] = (bf16)f2bf(sigmoidf_(o) * hv[tt] * rr * gml); }
    }
}

__device__ __forceinline__ void sample_state_item(Frame& F, int item) {
    LAS float* L = (LAS float*)(F.lds + RING_OFF);
    LAS float* kT = L; LAS float* kwT = L + 1024; LAS float* vS = L + 2048; LAS float* lis = L + 4096; LAS float* lfs = L + 4104; LAS float* wk = L + 4112; LAS float* misc = L + 4120;
    const int tid = F.tid, b = item >> 2, h = item & 3, row0 = MP + 8 * b;
    const int e4 = tid & 63, dg = F.wave;
    const float* c0p = F.st_C + ((size_t)(b * NH + h) * DK + 16 * dg) * DV + 4 * e4;
    float* c1p = F.out + O_SC + ((size_t)(b * NH + h) * DK + 16 * dg) * DV + 4 * e4;
    f32x4 c[16];
#pragma unroll
    for (int j = 0; j < 16; ++j) c[j] = *(const GAS f32x4*)(c0p + (size_t)j * DV);
    __syncthreads();
    if (tid >= 128 && tid < 256) { const int u = tid - 128, t = u >> 4, cc = u & 15; float f[8]; unpack8(*(const GAS v4u*)(F.Z + (size_t)(row0 + t) * NZ + ZC_K + h * DK + 8 * cc), f);
#pragma unroll
        for (int i = 0; i < 8; ++i) kT[(8 * cc + i) * 8 + t] = f[i];
    } else if (tid >= 256) { const int u = tid - 256, t = u >> 5, cc = u & 31; float f[8]; unpack8(*(const GAS v4u*)(F.Z + (size_t)(row0 + t) * NZ + ZC_V + h * DV + 8 * cc), f);
#pragma unroll
        for (int i = 0; i < 8; ++i) vS[t * 256 + 8 * cc + i] = f[i]; }
    if (tid < 8) { lis[tid] = F.gates[(size_t)(row0 + tid) * 8 + h]; lfs[tid] = F.gates[(size_t)(row0 + tid) * 8 + 4 + h]; }
    __syncthreads();
    if (tid < 8) {
        const float m0 = F.st_m[b * NH + h]; float run = 0.f, bs = 0.f;
#pragma unroll
        for (int i = 0; i < 8; ++i) { run += lfs[i]; bs = (i == tid) ? run : bs; }
        const float bL = run, gs = bL - bs + lis[tid];
        float gm = gs; gm = fmaxf(gm, __shfl_xor(gm, 1)); gm = fmaxf(gm, __shfl_xor(gm, 2)); gm = fmaxf(gm, __shfl_xor(gm, 4));
        const float mnew = fmaxf(bL + m0, gm);
        wk[tid] = __expf(gs - mnew); if (tid == 0) misc[0] = __expf(bL + m0 - mnew);
    }
    __syncthreads();
    const float sc = misc[0];
    for (int i = tid; i < 1024; i += NWAVES * 64) kwT[i] = kT[i] * wk[i & 7];
    __syncthreads();
    f32x4 vv[8];
#pragma unroll
    for (int s = 0; s < 8; ++s) vv[s] = *(const LAS f32x4*)(vS + s * 256 + 4 * e4);
#pragma unroll
    for (int j = 0; j < 16; ++j) {
        const int d = 16 * dg + j;
        const f32x4 k0 = *(const LAS f32x4*)(kwT + d * 8), k1 = *(const LAS f32x4*)(kwT + d * 8 + 4);
        f32x4 cn = c[j] * sc;
#pragma unroll
        for (int s = 0; s < 4; ++s) { cn += vv[s] * k0[s]; cn += vv[4 + s] * k1[s]; }
        *(GAS f32x4*)(c1p + (size_t)j * DV) = cn;
    }
}

typedef short s16x4 __attribute__((ext_vector_type(4)));
typedef float f32x16 __attribute__((ext_vector_type(16)));
#define MFMA32(a, b, c) __builtin_amdgcn_mfma_f32_32x32x16_bf16((a), (b), (c), 0, 0, 0)
__device__ __forceinline__ unsigned tr_addr(unsigned base, int P, int rbase, int C0, int lane) {
    const int h = lane >> 5, blk = (lane >> 4) & 1, q = (lane & 15) >> 2, p = lane & 3;
    return base + (unsigned)((rbase + 8 * h + q) * P + (C0 + 16 * blk + 4 * p) * 2);
}
__device__ __forceinline__ void tr_frag_pair(unsigned a0, unsigned a1, unsigned b0, unsigned b1, bf16x8& A, bf16x8& B) {
    s16x4 x0, x1, y0, y1;
    asm volatile("ds_read_b64_tr_b16 %0, %4\n\tds_read_b64_tr_b16 %1, %5\n\tds_read_b64_tr_b16 %2, %6\n\tds_read_b64_tr_b16 %3, %7\n\ts_waitcnt lgkmcnt(0)"
                 : "=&v"(x0), "=&v"(x1), "=&v"(y0), "=&v"(y1) : "v"(a0), "v"(a1), "v"(b0), "v"(b1) : "memory");
    A = __builtin_shufflevector(x0, x1, 0, 1, 2, 3, 4, 5, 6, 7); B = __builtin_shufflevector(y0, y1, 0, 1, 2, 3, 4, 5, 6, 7);
}
__device__ __forceinline__ bf16x8 tr_frag(unsigned a0, unsigned a1) {
    s16x4 x0, x1;
    asm volatile("ds_read_b64_tr_b16 %0, %2\n\tds_read_b64_tr_b16 %1, %3\n\ts_waitcnt lgkmcnt(0)" : "=&v"(x0), "=&v"(x1) : "v"(a0), "v"(a1) : "memory");
    return __builtin_shufflevector(x0, x1, 0, 1, 2, 3, 4, 5, 6, 7);
}
__device__ __forceinline__ int crow(int reg, int h) { return (reg & 3) + 8 * (reg >> 2) + 4 * h; }

constexpr int SC_PK = 320, SC_PV = 192;
constexpr int SC_KIMG = 0, SC_VIMG = 2 * 64 * SC_PK, SC_WK = SC_VIMG + 2 * 64 * SC_PV, SC_SC = SC_WK + 2048 * 4, SC_BL = SC_SC + 32 * 4, SC_GM = SC_BL + 32 * 4, SC_MST = SC_GM + 32 * 4, SC_NV = SC_MST + 36 * 4, SC_CST = ((SC_NV + 128 * 4 + 15) / 16) * 16, SC_PC = 272, SC_END = SC_CST + 2 * 64 * SC_PC;
constexpr size_t WS_CST = WS_C;
constexpr size_t WS_BCUM = WS_GATES + 1 * MiB;
constexpr size_t WS_MST = WS_BCUM + 256 * 1024;
constexpr size_t WS_NST = WS_MST + 64 * 1024;
static_assert(SC_PK == 320 && SC_PV == 192, "sc_frags hard-codes the row offsets of the two images");
__device__ __forceinline__ void sc_frags(unsigned abase, unsigned bbase, bf16x8 (&A)[4], bf16x8 (&B)[4]) {
    s16x4 x[8], y[8];
    asm volatile("ds_read_b64_tr_b16 %0, %16\n\tds_read_b64_tr_b16 %1, %16 offset:1280\n\tds_read_b64_tr_b16 %8, %17\n\tds_read_b64_tr_b16 %9, %17 offset:768\n\t"
                 "ds_read_b64_tr_b16 %2, %16 offset:5120\n\tds_read_b64_tr_b16 %3, %16 offset:6400\n\tds_read_b64_tr_b16 %10, %17 offset:3072\n\tds_read_b64_tr_b16 %11, %17 offset:3840\n\t"
                 "ds_read_b64_tr_b16 %4, %16 offset:10240\n\tds_read_b64_tr_b16 %5, %16 offset:11520\n\tds_read_b64_tr_b16 %12, %17 offset:6144\n\tds_read_b64_tr_b16 %13, %17 offset:6912\n\t"
                 "ds_read_b64_tr_b16 %6, %16 offset:15360\n\tds_read_b64_tr_b16 %7, %16 offset:16640\n\tds_read_b64_tr_b16 %14, %17 offset:9216\n\tds_read_b64_tr_b16 %15, %17 offset:9984\n\ts_waitcnt lgkmcnt(0)"
                 : "=&v"(x[0]), "=&v"(x[1]), "=&v"(x[2]), "=&v"(x[3]), "=&v"(x[4]), "=&v"(x[5]), "=&v"(x[6]), "=&v"(x[7]),
                   "=&v"(y[0]), "=&v"(y[1]), "=&v"(y[2]), "=&v"(y[3]), "=&v"(y[4]), "=&v"(y[5]), "=&v"(y[6]), "=&v"(y[7])
                 : "v"(abase), "v"(bbase) : "memory");
#pragma unroll
    for (int k = 0; k < 4; ++k) { A[k] = __builtin_shufflevector(x[2 * k], x[2 * k + 1], 0, 1, 2, 3, 4, 5, 6, 7); B[k] = __builtin_shufflevector(y[2 * k], y[2 * k + 1], 0, 1, 2, 3, 4, 5, 6, 7); }
}
__device__ __forceinline__ void scan_unit(Frame& F, int unit, unsigned char* ws) {
    const int bh = unit >> 2, es = unit & 3, b = bh >> 2, h = bh & 3, tid = F.tid, lane = F.lane, wave = F.wave;
    LAS unsigned char* L = F.lds + RING_OFF;
    LAS float* wkS = (LAS float*)(L + SC_WK); LAS float* scS = (LAS float*)(L + SC_SC); LAS float* bLS = (LAS float*)(L + SC_BL); LAS float* gmS = (LAS float*)(L + SC_GM); LAS float* mstS = (LAS float*)(L + SC_MST); LAS float* nvS = (LAS float*)(L + SC_NV);
    float* bcumG = (float*)(ws + WS_BCUM) + (size_t)bh * 2048; float* mstG = (float*)(ws + WS_MST) + (size_t)bh * 64; float* nstG = (float*)(ws + WS_NST) + (size_t)bh * 32 * 128;
    bf16* cstG = (bf16*)(ws + WS_CST) + (size_t)bh * 32 * 256 * 128;
    const size_t rowb = (size_t)b * SEQ;
    __syncthreads();
    for (int cc = 0; cc < 4; ++cc) {
        const int c = 4 * wave + cc; const size_t row = rowb + 64 * c + lane;
        const float li = F.gates[row * 8 + h], lf = F.gates[row * 8 + 4 + h];
        float bsum = lf;
#pragma unroll
        for (int o = 1; o < 64; o <<= 1) { const float t = __shfl_up(bsum, o); if (lane >= o) bsum += t; }
        const float bL = __shfl(bsum, 63);
        const float g = bL - bsum + li;
        float gm = g;
#pragma unroll
        for (int o = 1; o < 64; o <<= 1) gm = fmaxf(gm, __shfl_xor(gm, o));
        wkS[64 * c + lane] = g;
        if (es == 0) bcumG[64 * c + lane] = bsum;
        if (lane == 0) { bLS[c] = bL; gmS[c] = gm; }
    }
    __syncthreads();
    if (tid == 0) { float m = 0.f; mstS[0] = 0.f;
        for (int c = 0; c < 32; ++c) { const float mn = fmaxf(bLS[c] + m, gmS[c]); scS[c] = __expf(bLS[c] + m - mn); m = mn; mstS[c + 1] = mn; } }
    __syncthreads();
    for (int i = tid; i < 2048; i += NWAVES * 64) wkS[i] = __expf(wkS[i] - mstS[(i >> 6) + 1]);
    if (es == 0 && tid < 33) mstG[tid] = mstS[tid];
    if (tid < 128) nvS[tid] = 0.f;
    const int dt = wave & 3, et = wave >> 2, hh = lane >> 5;
    f32x16 acc;
#pragma unroll
    for (int i = 0; i < 16; ++i) acc[i] = 0.f;
    const int kr0 = tid >> 4, kc0 = tid & 15;
    const int vr = tid >> 3, vc = tid & 7;
    const bf16* zk = F.Z + rowb * NZ + ZC_K + h * DK; const bf16* zv = F.Z + rowb * NZ + ZC_V + h * DV + 64 * es;
    v4u rkA0, rkA1, rvA, rkB0, rkB1, rvB, rkC0, rkC1, rvC, rkD0, rkD1, rvD;
#define SC_LOAD(c, rk0, rk1, rv) do { rk0 = *(const GAS v4u*)(zk + (size_t)(64 * (c) + kr0) * NZ + 8 * kc0); rk1 = *(const GAS v4u*)(zk + (size_t)(64 * (c) + kr0 + 32) * NZ + 8 * kc0); \
                        rv = *(const GAS v4u*)(zv + (size_t)(64 * (c) + vr) * NZ + 8 * vc); } while (0)
#define SC_WRITE(c, rk0, rk1, rv) do { LAS unsigned char* kb = L + SC_KIMG + ((c) & 1) * 64 * SC_PK; LAS unsigned char* vb = L + SC_VIMG + ((c) & 1) * 64 * SC_PV; \
                         *(LAS v4u*)(kb + kr0 * SC_PK + 16 * kc0) = rk0; *(LAS v4u*)(kb + (kr0 + 32) * SC_PK + 16 * kc0) = rk1; \
                         float vf[8]; unpack8(rv, vf); const float w_ = wkS[64 * (c) + vr]; v4u o_; o_.x = pk2(vf[0] * w_, vf[1] * w_); o_.y = pk2(vf[2] * w_, vf[3] * w_); o_.z = pk2(vf[4] * w_, vf[5] * w_); o_.w = pk2(vf[6] * w_, vf[7] * w_); \
                         *(LAS v4u*)(vb + vr * SC_PV + 16 * vc) = o_; } while (0)
    const unsigned lbase = (unsigned)(size_t)L;
#define SC_STAGE(cn) do { LAS unsigned char* st_ = L + SC_CST + ((cn) & 1) * 64 * SC_PC + (32 * et + (lane & 31)) * SC_PC + (32 * dt + 4 * hh) * 2; \
        _Pragma("unroll") for (int g = 0; g < 4; ++g) *(LAS unsigned long long*)(st_ + 16 * g) = (unsigned long long)pk2(acc[4 * g], acc[4 * g + 1]) | ((unsigned long long)pk2(acc[4 * g + 2], acc[4 * g + 3]) << 32); } while (0)
#define SC_STEP(c) do { \
        {   \
          _Pragma("unroll") for (int i_ = 0; i_ < 2; ++i_) { const int p_ = tid + 512 * i_, e_ = p_ >> 4, c16 = p_ & 15; \
              *(GAS v4u*)(cstG + ((size_t)(c) * 256 + 64 * es + e_) * 128 + 8 * c16) = *(const LAS v4u*)(L + SC_CST + ((c) & 1) * 64 * SC_PC + e_ * SC_PC + 16 * c16); } } \
        const float sc = scS[c]; \
        _Pragma("unroll") for (int i = 0; i < 16; ++i) acc[i] *= sc; \
        const unsigned kimg = lbase + SC_KIMG + ((c) & 1) * 64 * SC_PK, vimg = lbase + SC_VIMG + ((c) & 1) * 64 * SC_PV; \
        bf16x8 Af[4], Bf[4]; sc_frags(tr_addr(kimg, SC_PK, 0, 32 * dt, lane), tr_addr(vimg, SC_PV, 0, 32 * et, lane), Af, Bf); \
        _Pragma("unroll") for (int ks = 0; ks < 4; ++ks) acc = MFMA32(Af[ks], Bf[ks], acc); \
        if (es == 0 && et == 0) {     \
            float part = 0.f; \
            _Pragma("unroll") for (int ks = 0; ks < 4; ++ks) { const f32x4 w0 = *(const LAS f32x4*)(wkS + 64 * (c) + 16 * ks + 8 * hh), w1 = *(const LAS f32x4*)(wkS + 64 * (c) + 16 * ks + 8 * hh + 4); \
                const v4u kk = __builtin_bit_cast(v4u, Af[ks]); \
                part += (bf2f(kk.x & 0xffffu) * w0.x + bf2f(kk.x >> 16) * w0.y) + (bf2f(kk.y & 0xffffu) * w0.z + bf2f(kk.y >> 16) * w0.w) \
                      + (bf2f(kk.z & 0xffffu) * w1.x + bf2f(kk.z >> 16) * w1.y) + (bf2f(kk.w & 0xffffu) * w1.z + bf2f(kk.w >> 16) * w1.w); } \
            part += __shfl_xor(part, 32); \
            if (hh == 0) { const int d = 32 * dt + (lane & 31); const float nn = nvS[d]; nstG[(c) * 128 + d] = nn; nvS[d] = nn * sc + part; } } \
        SC_STAGE((c) + 1); } while (0)
    SC_LOAD(0, rkA0, rkA1, rvA); SC_LOAD(1, rkB0, rkB1, rvB); SC_LOAD(2, rkC0, rkC1, rvC); SC_LOAD(3, rkD0, rkD1, rvD);
    SC_STAGE(0);
    __syncthreads();
    SC_WRITE(0, rkA0, rkA1, rvA);
#pragma unroll 1
    for (int c = 0; c < 32; c += 4) {
        if (c + 4 < 32) SC_LOAD(c + 4, rkA0, rkA1, rvA);
        __syncthreads();
        SC_STEP(c);
        SC_WRITE(c + 1, rkB0, rkB1, rvB);
        if (c + 5 < 32) SC_LOAD(c + 5, rkB0, rkB1, rvB);
        __syncthreads();
        SC_STEP(c + 1);
        SC_WRITE(c + 2, rkC0, rkC1, rvC);
        if (c + 6 < 32) SC_LOAD(c + 6, rkC0, rkC1, rvC);
        __syncthreads();
        SC_STEP(c + 2);
        SC_WRITE(c + 3, rkD0, rkD1, rvD);
        if (c + 7 < 32) SC_LOAD(c + 7, rkD0, rkD1, rvD);
        __syncthreads();
        SC_STEP(c + 3);
        if (c + 4 < 32) SC_WRITE(c + 4, rkA0, rkA1, rvA);
    }
#undef SC_STEP
#undef SC_STAGE
    __syncthreads();
#undef SC_LOAD
#undef SC_WRITE
    { float* dst = F.out + O_PC + ((size_t)bh * 128 + 32 * dt) * 256 + 64 * es + 32 * et + (lane & 31);
#pragma unroll
      for (int i = 0; i < 16; ++i) dst[(size_t)crow(i, hh) * 256] = acc[i]; }
    if (es == 0 && tid < 128) F.out[O_PN + (size_t)bh * 128 + tid] = nvS[tid];
    if (es == 0 && tid == 0) F.out[O_PM + bh] = mstS[32];
    asm volatile("s_waitcnt vmcnt(0)" ::: "memory");
    __syncthreads();
    if (tid == 0) { __builtin_amdgcn_fence(__ATOMIC_RELEASE, "agent"); asm volatile("s_waitcnt vmcnt(0)" ::: "memory");
        __hip_atomic_fetch_add((unsigned*)(F.ctl + CW_SCAN) + 64 * bh, 1u, __ATOMIC_RELAXED, __HIP_MEMORY_SCOPE_AGENT); }
}
constexpr int P3_PQ = 272, P3_PKK = 272, P3_PV = 576, P3_PP = 144, P3_PH = 1040;
constexpr int P3_Q = 0, P3_K = P3_Q + 64 * P3_PQ, P3_V = P3_K + 64 * P3_PKK, P3_P = P3_V + 64 * P3_PV, P3_H = 0;
constexpr int P3_SM = 81920;
static_assert(P3_P + 64 * P3_PP <= P3_SM && 64 * P3_PH <= P3_SM, "P3 LDS map");
__device__ __forceinline__ void p3_item(Frame& F, int item, unsigned char* ws) {
    const int bh = item >> 5, c = item & 31, b = bh >> 2, h = bh & 3, tid = F.tid, lane = F.lane, wave = F.wave, hh = lane >> 5, l31 = lane & 31;
    LAS unsigned char* L = F.lds + RING_OFF;
    LAS float* sm = (LAS float*)(L + P3_SM); LAS float* bmS = sm; LAS float* aS = sm + 64; LAS float* aiS = sm + 128; LAS float* ddS = sm + 192; LAS float* rsS = sm + 256; LAS float* qnS = sm + 320; LAS float* mtS = sm + 384; LAS float* nvS = sm + 448;
    const size_t row0 = (size_t)b * SEQ + 64 * c;
    const bf16* cst = (const bf16*)(ws + WS_CST) + ((size_t)bh * 32 + c) * 256 * 128;
    __syncthreads();
    { const bf16* zq = F.Z + row0 * NZ + ZC_Q + h * DK; const bf16* zk = F.Z + row0 * NZ + ZC_K + h * DK; const bf16* zv = F.Z + row0 * NZ + ZC_V + h * DV;
#pragma unroll
      for (int i = 0; i < 2; ++i) { const int r = (tid >> 4) + 32 * i, cc = tid & 15;
          *(LAS v4u*)(L + P3_Q + r * P3_PQ + 16 * cc) = *(const GAS v4u*)(zq + (size_t)r * NZ + 8 * cc); *(LAS v4u*)(L + P3_K + r * P3_PKK + 16 * cc) = *(const GAS v4u*)(zk + (size_t)r * NZ + 8 * cc); }
#pragma unroll
      for (int i = 0; i < 4; ++i) { const int r = (tid >> 5) + 16 * i, cc = tid & 31; *(LAS v4u*)(L + P3_V + r * P3_PV + 16 * cc) = *(const GAS v4u*)(zv + (size_t)r * NZ + 8 * cc); } }
    if (wave == 0) {
        const float mc = ((const float*)(ws + WS_MST))[(size_t)bh * 64 + c];
        const float bt = ((const float*)(ws + WS_BCUM))[(size_t)bh * 2048 + 64 * c + lane];
        const float li = F.gates[(row0 + lane) * 8 + h];
        const float a = li - bt; float pm = a;
#pragma unroll
        for (int o = 1; o < 64; o <<= 1) { const float t = __shfl_up(pm, o); if (lane >= o) pm = fmaxf(pm, t); }
        const float mt = bt + fmaxf(mc, pm);
        bmS[lane] = bt - mt; aS[lane] = a; aiS[lane] = __expf(bt + mc - mt); mtS[lane] = mt; rsS[lane] = 0.f;
    }
    if (wave == 1) { const float* np = (const float*)(ws + WS_NST) + ((size_t)bh * 32 + c) * 128; nvS[lane] = np[lane]; nvS[64 + lane] = np[64 + lane]; }
    v4u og[4];
    { const bf16* zo = F.Z + (row0 + (tid >> 3)) * NZ + ZC_O + h * DV + 32 * (tid & 7);
#pragma unroll
      for (int q = 0; q < 4; ++q) og[q] = *(const GAS v4u*)(zo + 8 * q); }
    bf16x8 Cf[8];
    { const bf16* cp = cst + (size_t)(32 * wave + l31) * 128 + 8 * hh;
#pragma unroll
      for (int kd = 0; kd < 8; ++kd) Cf[kd] = *(const GAS bf16x8*)(cp + 16 * kd); }
    __syncthreads();
    { const int t = tid >> 3, part = tid & 7; float s = 0.f;
      const LAS unsigned short* qr = (const LAS unsigned short*)(L + P3_Q + t * P3_PQ) + 16 * part;
#pragma unroll
      for (int j = 0; j < 16; ++j) s += bf2f(qr[j]) * nvS[16 * part + j];
      s += __shfl_xor(s, 1); s += __shfl_xor(s, 2); s += __shfl_xor(s, 4);
      if (part == 0) qnS[t] = s * QSCALE; }
    if (wave < 3) {
        const int si = wave == 2 ? 1 : 0, ti = wave == 0 ? 0 : 1;
        f32x16 x;
#pragma unroll
        for (int i = 0; i < 16; ++i) x[i] = 0.f;
#pragma unroll
        for (int kd = 0; kd < 8; ++kd) {
            const bf16x8 A = *(const LAS bf16x8*)(L + P3_K + (32 * si + l31) * P3_PKK + (16 * kd + 8 * hh) * 2);
            const bf16x8 B = *(const LAS bf16x8*)(L + P3_Q + (32 * ti + l31) * P3_PQ + (16 * kd + 8 * hh) * 2);
            x = MFMA32(A, B, x);
        }
        const int t = 32 * ti + l31; const float bm = bmS[t]; float rsum = 0.f;
#pragma unroll
        for (int g = 0; g < 4; ++g) {
            float p[4];
#pragma unroll
            for (int j = 0; j < 4; ++j) { const int s = 32 * si + 8 * g + 4 * hh + j; const float w = (s <= t) ? __expf(bm + aS[s]) : 0.f; p[j] = x[4 * g + j] * QSCALE * w; rsum += p[j]; }
            *(LAS unsigned long long*)(L + P3_P + t * P3_PP + (32 * si + 8 * g + 4 * hh) * 2) = (unsigned long long)pk2(p[0], p[1]) | ((unsigned long long)pk2(p[2], p[3]) << 32);
        }
        rsum += __shfl_xor(rsum, 32);
        if (hh == 0) atomicAdd((float*)(rsS + t), rsum);
    }
    __syncthreads();
    if (tid < 64) { const float den = aiS[tid] * qnS[tid] + rsS[tid]; ddS[tid] = 1.f / fmaxf(fabsf(den), __expf(-mtS[tid])); }
    bf16x8 Vf[4];
    { const unsigned vimg = (unsigned)(size_t)(L + P3_V);
#pragma unroll
      for (int ks = 0; ks < 4; ++ks) Vf[ks] = tr_frag(tr_addr(vimg, P3_PV, 16 * ks, 32 * wave, lane), tr_addr(vimg, P3_PV, 16 * ks + 4, 32 * wave, lane)); }
    f32x16 n1[2], n2[2];
#pragma unroll
    for (int ti = 0; ti < 2; ++ti) {
#pragma unroll
        for (int i = 0; i < 16; ++i) { n1[ti][i] = 0.f; n2[ti][i] = 0.f; }
#pragma unroll
        for (int kd = 0; kd < 8; ++kd) { const bf16x8 A = *(const LAS bf16x8*)(L + P3_Q + (32 * ti + l31) * P3_PQ + (16 * kd + 8 * hh) * 2); n1[ti] = MFMA32(A, Cf[kd], n1[ti]); }
#pragma unroll
        for (int ks = 0; ks < 2 * (ti + 1); ++ks) { const bf16x8 A = *(const LAS bf16x8*)(L + P3_P + (32 * ti + l31) * P3_PP + (16 * ks + 8 * hh) * 2); n2[ti] = MFMA32(A, Vf[ks], n2[ti]); }
    }
    __syncthreads();
#pragma unroll
    for (int ti = 0; ti < 2; ++ti)
#pragma unroll
        for (int i = 0; i < 16; ++i) { const int t = 32 * ti + crow(i, hh);
            *(LAS float*)(L + P3_H + t * P3_PH + (32 * wave + l31) * 4) = (aiS[t] * QSCALE * n1[ti][i] + n2[ti][i]) * ddS[t]; }
    __syncthreads();
    { const int t = tid >> 3, j = tid & 7; f32x4 hv4[8]; float s = 0.f;
#pragma unroll
      for (int q = 0; q < 8; ++q) { hv4[q] = *(const LAS f32x4*)(L + P3_H + t * P3_PH + (32 * j + 4 * q) * 4); s += (hv4[q].x * hv4[q].x + hv4[q].y * hv4[q].y) + (hv4[q].z * hv4[q].z + hv4[q].w * hv4[q].w); }
      s += __shfl_xor(s, 1); s += __shfl_xor(s, 2); s += __shfl_xor(s, 4);
      const float rr = rsqrtf(s * (1.f / DV) + EPS);
      bf16* yo = F.YC + (row0 + t) * D + DC + h * DV + 32 * j; const float* gp = F.ml_g + h * DV + 32 * j;
#pragma unroll
      for (int q = 0; q < 4; ++q) { float o[8]; unpack8(og[q], o);
          const f32x4 g0 = *(const GAS f32x4*)(gp + 8 * q), g1 = *(const GAS f32x4*)(gp + 8 * q + 4); const f32x4 a = hv4[2 * q], bq = hv4[2 * q + 1];
          v4u w; w.x = pk2(sigmoidf_(o[0]) * a.x * rr * g0.x, sigmoidf_(o[1]) * a.y * rr * g0.y); w.y = pk2(sigmoidf_(o[2]) * a.z * rr * g0.z, sigmoidf_(o[3]) * a.w * rr * g0.w);
          w.z = pk2(sigmoidf_(o[4]) * bq.x * rr * g1.x, sigmoidf_(o[5]) * bq.y * rr * g1.y); w.w = pk2(sigmoidf_(o[6]) * bq.z * rr * g1.z, sigmoidf_(o[7]) * bq.w * rr * g1.w);
          *(GAS v4u*)(yo + 8 * q) = w; } }
}
__device__ __forceinline__ void p2_phase(Frame& F, unsigned char* ws, bool w23_later, bool merge_p3, bool defer_state) {
    constexpr int NS = DB * NH, NC = 1152 / NWAVES, NTI = TR_I2 + 2 * TR_I3, NT = NTI / (2 * NWAVES), NP = 512;
    static_assert(NTI % (2 * NWAVES) == 0, "transposition items per group");
    const int nT = w23_later ? NT : 0, nP = merge_p3 ? NP : 0, NQ = NS + NC + nT + nP;
    if (F.G >= 64 && F.vcu < 64) scan_unit(F, F.vcu, ws);
    else if (F.G < 64) { for (int it = F.vcu; it < 64; it += F.G) scan_unit(F, it, ws); }
    unsigned* qh = (unsigned*)(F.ctl + CW_QUEUE);
    volatile LAS unsigned* qs = F.MISC + 16;
    bool acquired = false;
    unsigned nxt = 0;
    if (F.tid == 0) nxt = __hip_atomic_fetch_add(qh, 1u, __ATOMIC_RELAXED, __HIP_MEMORY_SCOPE_AGENT);
    for (;;) {
        __syncthreads();
        if (F.tid == 0) qs[0] = nxt;
        __syncthreads();
        const int i = __builtin_amdgcn_readfirstlane((int)qs[0]);
        asm volatile("" ::: "memory");
        if (i >= NQ) break;
        if (F.tid == 0) nxt = __hip_atomic_fetch_add(qh, 1u, __ATOMIC_RELAXED, __HIP_MEMORY_SCOPE_AGENT);
        Frame G = F; asm volatile("" : "+v"(G.tid), "+v"(G.lane));
        if (i < NS) { if (defer_state) sample_item<false>(G, i); else sample_item<true>(G, i); }
        else if (i < NS + NC) conv_item(G, (i - NS) * NWAVES + F.wave);
        else if (i < NS + NC + nT) { const int g = i - NS - NC; tr_run(G, TR_I1 + g * 2 * NWAVES, TR_I1 + (g + 1) * 2 * NWAVES, F.wave, NWAVES, (LAS float*)(F.lds + RING_OFF + F.wave * 16640)); }
        else {
            if (!acquired) {
                if (F.tid < 16) { unsigned* cw = (unsigned*)(F.ctl + CW_SCAN) + 64 * F.tid; unsigned spins = 0;
                    while (__hip_atomic_load(cw, __ATOMIC_RELAXED, __HIP_MEMORY_SCOPE_AGENT) < 4u) { __builtin_amdgcn_s_sleep(4); if (++spins > (1u << 20)) break; } }
                if (F.wave == 0) { __builtin_amdgcn_fence(__ATOMIC_ACQUIRE, "agent"); asm volatile("s_waitcnt vmcnt(0)" ::: "memory"); }
                __syncthreads(); acquired = true; }
            p3_item(G, i - NS - NC - nT, ws);
        }
    }
    __syncthreads();
}
__device__ __forceinline__ void p3_phase(Frame& F, unsigned char* ws) {
    for (int it = F.vcu; it < 512; it += F.G) p3_item(F, it, ws);
    __syncthreads();
}
struct Args { const float* in[19]; float* out; unsigned char* ws; int ph_lo, ph_hi, li, pad; };
__global__ void __launch_bounds__(NWAVES * 64, 2) mk_fwd(Args args) {
    extern __shared__ __attribute__((aligned(16))) unsigned char lds[];
    Frame F;
    F.lds = (LAS unsigned char*)lds;
    F.MISC = (volatile LAS unsigned*)(F.lds + MISC_OFF);
    F.tid = threadIdx.x; F.lane = F.tid & 63; F.wave = __builtin_amdgcn_readfirstlane(F.tid >> 6);
    F.G = gridDim.x; { const int bx = blockIdx.x; F.vcu = (F.G % 8 == 0) ? (bx % 8) * (F.G / 8) + bx / 8 : bx; }
    unsigned char* ws = args.ws;
    F.ctl = (gu32*)(ws + WS_CTL);
    F.x_p = args.in[0]; F.x_s = args.in[1]; F.st_conv = args.in[2]; F.st_C = args.in[3]; F.st_n = args.in[4]; F.st_m = args.in[5];
    F.g1 = args.in[6]; F.w_in = args.in[7]; F.b_i = args.in[8]; F.b_f = args.in[9]; F.conv_w = args.in[10]; F.conv_g = args.in[11]; F.ml_g = args.in[12];
    F.w_out = args.in[13]; F.g2 = args.in[14]; F.wg = args.in[15]; F.wu = args.in[16]; F.wd = args.in[17]; F.fg = args.in[18]; F.out = args.out;
    F.W1 = (bf16*)(ws + WS_W1); F.W2 = (bf16*)(ws + WS_W2); F.W3 = (bf16*)(ws + WS_W3); F.W4 = (bf16*)(ws + WS_W4);
    F.XN = (bf16*)(ws + WS_A); F.YC = (bf16*)(ws + WS_A); F.Z = (bf16*)(ws + WS_B); F.HB = (bf16*)(ws + WS_B); F.X1b = (bf16*)(ws + WS_C);
    F.gates = (float*)(ws + WS_GATES); F.ssq1 = (float*)(ws + WS_CTL) + CW_SSQ1; F.ssq2 = (float*)(ws + WS_CTL) + CW_SSQ2;
    for (int u = F.tid; u < (LDS_BYTES - LDSCTL_OFF) / 4; u += NWAVES * 64) ((LAS unsigned*)(F.lds + LDSCTL_OFF))[u] = 0u;
    __syncthreads();
    XcdBarrier bar = xcd_barrier_post((unsigned*)(F.ctl + CW_BAR) + args.li * XCD_BAR_WORDS, F.MISC + 8);
    const int lo = args.ph_lo, hi = args.ph_hi;
#define IN(k) (lo <= (k) && (k) < hi)
#ifndef PROBE_PHASE
#define PROBE_PHASE -1
#endif
#ifndef PROBE_MULT
#define PROBE_MULT 4
#endif
    unsigned long long pt0 = (PROBE_PHASE == 0) ? __builtin_amdgcn_s_memrealtime() : 0ull;
#define SEAM(k) do { if (IN(k) && IN((k) + 1)) xcd_barrier(bar); \
        if (PROBE_PHASE >= 0 && blockIdx.x == 0) { if ((k) + 1 == PROBE_PHASE) pt0 = __builtin_amdgcn_s_memrealtime(); \
            if ((k) == PROBE_PHASE) { const unsigned long long t1 = __builtin_amdgcn_s_memrealtime(); while (__builtin_amdgcn_s_memrealtime() - t1 < (unsigned long long)PROBE_MULT * (t1 - pt0)) __builtin_amdgcn_s_sleep(8); } __syncthreads(); } } while (0)

    constexpr bool use_fp8 = FFN2_FP8 != 0;
    const bool w4_later = (F.G == 256) && IN(0) && IN(5);
    const bool w23_later = w4_later && IN(2) && F.G >= 128;
    if (IN(0)) { p0_prologue(F, w4_later, w23_later); } SEAM(0);
    if (IN(1)) {
        pg8::Gemm g{F.XN, F.W1, M, NZ, D}; pg9::StaticOrder S; S.init(M, NZ, F.G, (int)blockIdx.x);
        pg9::EpiZ E{F.Z, NZ};
        pg9::gemm_phase<pg9::EpiZ>(F.lds + RING_OFF, g, S, E);
    } SEAM(1);
    const bool merge_p3 = IN(2) && IN(3);
    const bool defer_state = w4_later && IN(2);
    if (IN(2)) { p2_phase(F, ws, w23_later && F.G >= 128, merge_p3, defer_state); }
    if (merge_p3) { xcd_barrier(bar);
        if (PROBE_PHASE >= 0 && blockIdx.x == 0) { if (PROBE_PHASE == 4) pt0 = __builtin_amdgcn_s_memrealtime();
            if (PROBE_PHASE == 2) { const unsigned long long t1 = __builtin_amdgcn_s_memrealtime(); while (__builtin_amdgcn_s_memrealtime() - t1 < (unsigned long long)PROBE_MULT * (t1 - pt0)) __builtin_amdgcn_s_sleep(8); } __syncthreads(); } }
    else { SEAM(2); if (IN(3)) { p3_phase(F, ws); } SEAM(3); }
    if (IN(4)) {
        pg8::Gemm g{F.YC, F.W2, M, D, D}; pg9::StaticOrder S; S.init(M, D, F.G, (int)blockIdx.x);
        const bool x1_bf16 = (F.G == (M / pg9::BMR) * (D / pg9::BN)) && IN(6);
        pg9::EpiRes E{F.x_p, F.x_s, MP, x1_bf16 ? nullptr : F.out, F.X1b, F.ssq1};
        pg9::gemm_phase<pg9::EpiRes>(F.lds + RING_OFF, g, S, E);
    } SEAM(4);
    if (IN(5)) {
        pg8::Gemm g{F.X1b, F.W3, M, N3, D}; pg9::StaticOrder S; S.init(M, N3, F.G, (int)blockIdx.x);
        if constexpr (use_fp8) { pg9::EpiH8 E{(unsigned char*)F.HB, F.ssq1, (float)(1 << H8_EXP)}; pg9::gemm_phase<pg9::EpiH8>(F.lds + RING_OFF, g, S, E); }
        else { pg9::EpiH E{F.HB, F.ssq1}; pg9::gemm_phase<pg9::EpiH>(F.lds + RING_OFF, g, S, E); }
        if (w4_later && blockIdx.x >= 128) {
            LAS float* scr = (LAS float*)(F.lds + RING_OFF + F.wave * 16640);
            for (int it = ((int)blockIdx.x - 128) * NWAVES + F.wave; it < (FF / 64) * (D / 64); it += 128 * NWAVES) {
                if constexpr (use_fp8) p0_transpose_item_fp8(F.wd, D, FF, D / 64, F.W4, scr, it, F.lane, (float)(1 << W8_EXP));
                else p0_transpose_item(F.wd, D, FF, D / 64, F.W4, 0, nullptr, scr, it, F.lane); }
            if (defer_state) { for (int it = (int)blockIdx.x - 128; it < DB * NH; it += 128) sample_state_item(F, it); }
        }
    } SEAM(5);
    if (IN(6)) {
        pg8::Gemm g{F.HB, F.W4, M, D, use_fp8 ? FF / 2 : FF}; pg9::StaticOrder S; S.init(M, D, F.G, (int)blockIdx.x);
        if (F.G == (M / pg9::BMR) * (D / pg9::BN)) {
            pg9::EpiFinal E{F.out, F.ssq2, (unsigned*)(F.ctl + CW_CNT4), F.fg, IN(4) ? F.X1b : nullptr};
            if constexpr (use_fp8) pg9::gemm_phase<pg9::EpiFinal, true, true, 127 - H8_EXP, 127 - W8_EXP>(F.lds + RING_OFF, g, S, E);
            else pg9::gemm_phase<pg9::EpiFinal>(F.lds + RING_OFF, g, S, E);
        } else if constexpr (!use_fp8) {
            pg9::EpiRes E{F.out, F.out, M, F.out, nullptr, F.ssq2};
            pg9::gemm_phase<pg9::EpiRes>(F.lds + RING_OFF, g, S, E);
        }
    }
    if (F.G != (M / pg9::BMR) * (D / pg9::BN)) { SEAM(6); if (IN(7)) { final_norm_phase(F); } }
    if (PROBE_PHASE == 6 && blockIdx.x == 0) { const unsigned long long t1 = __builtin_amdgcn_s_memrealtime(); while (__builtin_amdgcn_s_memrealtime() - t1 < (unsigned long long)PROBE_MULT * (t1 - pt0)) __builtin_amdgcn_s_sleep(8); }
    if (PROBE_PHASE == 7) { xcd_barrier(bar); SEAM(7); }
#undef IN
#undef SEAM
}

extern "C" void kernel_launch(void* const* d_in, const int* in_sizes, int n_in, void* d_out, int out_size, void* d_ws, size_t ws_size, hipStream_t stream) {
    static int grid = 0;
    if (grid == 0) {
        if (n_in != 19 || (size_t)out_size != O_END || ws_size < WS_END) { fprintf(stderr, "kernel_launch: unexpected shapes: n_in %d out %d ws %zu; nothing launched\n", n_in, out_size, ws_size); grid = -1; return; }
        int dev = 0, cus = 0;
        if (hipGetDevice(&dev) != hipSuccess || hipDeviceGetAttribute(&cus, hipDeviceAttributeMultiprocessorCount, dev) != hipSuccess) { grid = -1; return; }
        if (hipFuncSetAttribute((const void*)mk_fwd, hipFuncAttributeMaxDynamicSharedMemorySize, LDS_BYTES) != hipSuccess) { fprintf(stderr, "kernel_launch: hipFuncSetAttribute failed\n"); grid = -1; return; }
        grid = cus;
        if (FFN2_FP8 && cus != 256) { fprintf(stderr, "kernel_launch: this build needs a 256-CU device (got %d); nothing launched\n", cus); grid = -1; return; }
    }
    if (grid < 0) return;
    unsigned char* ws = (unsigned char*)d_ws; float* out = (float*)d_out;
    (void)hipMemsetAsync(ws + WS_CTL, 0, CTL_ZERO_BYTES, stream);
    Args a{};
    for (int i = 0; i < 19; ++i) a.in[i] = (const float*)d_in[i];
    a.out = out; a.ws = ws;
    a.ph_lo = 0; a.ph_hi = 8; a.li = 0;
    hipLaunchKernelGGL(mk_fwd, dim3(grid), dim3(NWAVES * 64), LDS_BYTES, stream, a);
}
```

```cpp
#include <hip/hip_runtime.h>
#include <cstdio>
#include <cstdint>

constexpr int D = 2048, SEQ = 2048, NB = 4, DB = 128, DS = 8;
constexpr int MP = NB * SEQ, MS = DB * DS, M = MP + MS;
constexpr int DC = 1024, NH = 4, DK = 128, DV = 256;
constexpr int NZ = 6144, NIN = 6152, FF = 5632, N3 = 2 * FF;
constexpr float EPS = 1e-6f;
constexpr float QSCALE = 0.08838834764831845f;
#ifndef FFN2_FP8
#define FFN2_FP8 1
#endif
constexpr int H8_EXP = 3, W8_EXP = 8;
constexpr int ZC_BG = 0, ZC_CG = 1024, ZC_XT = 2048, ZC_Q = 3072, ZC_K = 3584, ZC_V = 4096, ZC_O = 5120;
constexpr size_t O_Y = 0, O_PCONV = 18874368, O_PC = 18882560, O_PN = 19406848, O_PM = 19408896,
                 O_SCONV = 19408912, O_SC = 19671056, O_SN = 36448272, O_SM = 36513808, O_END = 36514320;
constexpr size_t MiB = 1u << 20;
constexpr size_t WS_CTL = 0, CTL_ZERO_BYTES = 1 * MiB;
constexpr size_t WS_W1 = 1 * MiB, WS_W2 = 25 * MiB, WS_W3 = 33 * MiB, WS_W4 = 77 * MiB;
constexpr size_t WS_A = 99 * MiB;
constexpr size_t WS_B = 135 * MiB;
constexpr size_t WS_C = 243 * MiB;
constexpr size_t WS_GATES = WS_C + 36 * MiB;
constexpr size_t WS_END = 283 * MiB;
constexpr int CW_TMO = 0, CW_CODE = 1;
constexpr int CW_BAR = 4096;
constexpr int CW_QUEUE = 30656;
constexpr int CW_SCAN = 30720;
constexpr int CW_CNT4 = 32768;
constexpr int CW_SSQ1 = 65536, CW_SSQ2 = 65536 + 16384;
constexpr int NWAVES = 8;
constexpr int RING_OFF = 0, RING_BYTES = 139264;
constexpr int LDSCTL_OFF = RING_BYTES, MISC_OFF = LDSCTL_OFF + 320;
constexpr int MLG_OFF = LDSCTL_OFF + 4096;
constexpr int LDS_BYTES = 147456;

namespace pg8 {
#define PG8_LAS __attribute__((address_space(3)))
typedef unsigned short bf16_t;
typedef short bf16x8 __attribute__((ext_vector_type(8)));
typedef float f32x4 __attribute__((ext_vector_type(4)));
typedef unsigned u32x4 __attribute__((ext_vector_type(4)));
constexpr int BM = 256, BK = 64, HALF = 128, HTB = HALF * BK * 2  , STAGE_BYTES = 8 * HTB, NXCD = 8, WGM = 8;

__host__ __device__ __forceinline__ int lds_byte(int r, int c) { const int st = (r >> 4) * 2 + (c >> 5), rr = r & 15, cc = c & 31, ob = rr * 64 + cc * 2; return st * 1024 + (ob ^ (((ob >> 9) & 1) << 5)); }
__host__ __device__ __forceinline__ void stage_rc(int b, int& R, int& C) { const int st = b / 1024, sb = b % 1024, swz = sb ^ (((sb >> 9) & 1) << 5); R = (st >> 1) * 16 + swz / 64; C = (st & 1) * 32 + (swz % 64) / 2; }
__host__ __device__ __forceinline__ int perm32(int rho) { const int n = rho >> 4, i = rho & 15; return 8 * (i >> 2) + 4 * n + (i & 3); }

struct Unit { int pm, pn; };
struct Gemm { const bf16_t* A; const bf16_t* Bt; int M, N, K; };

struct StaticOrder {
    int nM, nN, nwg, G, c;
    __host__ __device__ void init(int M, int N, int G_, int c_) { nM = M / BM; nN = N / BM; nwg = nM * nN; G = G_; c = c_; }
    __host__ __device__ bool next(int i, Unit& u) const {
        const long L = (long)i * G + c; if (L >= nwg) return false;
        int wgid = (int)L; { const int q = nwg / NXCD, r = nwg % NXCD, xcd = wgid % NXCD, off = wgid / NXCD; wgid = (xcd < r ? xcd * (q + 1) : r * (q + 1) + (xcd - r) * q) + off; }
        const int nig = WGM * nN, gid = wgid / nig, fm = gid * WGM, gsz = (nM - fm) < WGM ? (nM - fm) : WGM;
        u.pm = fm + ((wgid % nig) % gsz); u.pn = (wgid % nig) / gsz; return true;
    }
    __device__ __forceinline__ void a_ready(const Unit&) const {}
    __device__ __forceinline__ void done(const Unit&) const {}
};
__device__ __forceinline__ unsigned cvt_pk_bf16(float lo, float hi) { unsigned r; asm volatile("v_cvt_pk_bf16_f32 %0, %1, %2" : "=v"(r) : "v"(lo), "v"(hi)); return r; }
typedef float f32x2 __attribute__((ext_vector_type(2)));
}
namespace pg9 {
using pg8::lds_byte; using pg8::stage_rc; using pg8::perm32; using pg8::cvt_pk_bf16; using pg8::bf16_t; using pg8::bf16x8; using pg8::f32x4; using pg8::u32x4; using pg8::Gemm;
constexpr int BMR = 288, BN = 256, BK = 64, HALF = 128, TH = 96, ATB = TH * BK * 2  , HTB = HALF * BK * 2  , STAGE_BYTES = 6 * ATB + 4 * HTB  , NXCD = 8, WGM = 8;
typedef int v8i __attribute__((ext_vector_type(8))); typedef int v4i __attribute__((ext_vector_type(4)));
__device__ __forceinline__ v8i cat8(bf16x8 lo, bf16x8 hi) { const v4i a = __builtin_bit_cast(v4i, lo), b = __builtin_bit_cast(v4i, hi); return __builtin_shufflevector(a, b, 0, 1, 2, 3, 4, 5, 6, 7); }
struct Unit { int pm, pn; };
struct StaticOrder {
    int nM, nN, nwg, G, c, swz;
    __host__ __device__ void init(int M, int N, int G_, int c_, int swz_ = 0) { nM = M / BMR; nN = N / BN; nwg = nM * nN; G = G_; c = c_; swz = swz_; }
    __host__ __device__ bool next(int i, Unit& u) const {
        const long L = (long)i * G + c; if (L >= nwg) return false;
        int wgid = (int)L; { const int q = nwg / NXCD, r = nwg % NXCD, xcd = wgid % NXCD, off = wgid / NXCD; wgid = (xcd < r ? xcd * (q + 1) : r * (q + 1) + (xcd - r) * q) + off; }
        const int nig = WGM * nN, gid = wgid / nig, fm = gid * WGM, gsz = (nM - fm) < WGM ? (nM - fm) : WGM;
        u.pm = fm + ((wgid % nig) % gsz); u.pn = (wgid % nig) / gsz; if (swz && u.pn >= 8 && u.pn < 16) u.pn ^= 4; return true;
    }
};
typedef f32x4 Acc[3][2][3][2];

struct EpiZ {
    bf16_t* O; int ldc;
    __device__ __forceinline__ void operator()(Acc& acc, const Unit& u, int wr, int wc, int fr, int fq) const {
        const int row0 = u.pm * BMR + wr * 144 + fr, col0 = u.pn * BN + wc * 32 + 8 * fq;
        if (u.pn >= 4 && u.pn < 12) {
            const int colu = 1024 + (u.pn - 4) * HALF + wc * 32 + 8 * fq;
#pragma unroll
            for (int ai = 0; ai < 3; ++ai)
#pragma unroll
                for (int m = 0; m < 3; ++m) { const f32x4 v0 = acc[ai][0][m][0] * acc[ai][1][m][0], v1 = acc[ai][0][m][1] * acc[ai][1][m][1];
                    u32x4 w; w.x = cvt_pk_bf16(v0[0], v0[1]); w.y = cvt_pk_bf16(v0[2], v0[3]); w.z = cvt_pk_bf16(v1[0], v1[1]); w.w = cvt_pk_bf16(v1[2], v1[3]);
                    *(u32x4*)(O + (size_t)(row0 + ai * 48 + m * 16) * ldc + colu) = w; }
            return;
        }
#pragma unroll
        for (int ai = 0; ai < 3; ++ai)
#pragma unroll
            for (int m = 0; m < 3; ++m) { bf16_t* rowp = O + (size_t)(row0 + ai * 48 + m * 16) * ldc + col0;
#pragma unroll
                for (int bj = 0; bj < 2; ++bj) { const f32x4 v0 = acc[ai][bj][m][0], v1 = acc[ai][bj][m][1];
                    u32x4 w; w.x = cvt_pk_bf16(v0[0], v0[1]); w.y = cvt_pk_bf16(v0[2], v0[3]); w.z = cvt_pk_bf16(v1[0], v1[1]); w.w = cvt_pk_bf16(v1[2], v1[3]);
                    *(u32x4*)(rowp + bj * HALF) = w; } }
    }
};
struct EpiRes {
    const float* xp; const float* xs; int rows_p; float* out; bf16_t* X1b; float* ssq;
    __device__ __forceinline__ const float* xrow(int row, int col0) const { return (row < rows_p ? xp + (size_t)row * 2048 : xs + (size_t)(row - rows_p) * 2048) + col0; }
    __device__ __forceinline__ void operator()(Acc& acc, const Unit& u, int wr, int wc, int fr, int fq) const {
        const int row0 = u.pm * BMR + wr * 144 + fr, col0 = u.pn * BN + wc * 32 + 8 * fq;
        f32x4 xr[2][4];
#define EPI_LOADX(g) do { const float* p_ = xrow(row0 + ((g) / 3) * 48 + ((g) % 3) * 16, col0); xr[(g) % 2][0] = __builtin_nontemporal_load((const f32x4*)(p_)); xr[(g) % 2][1] = __builtin_nontemporal_load((const f32x4*)(p_ + 4)); xr[(g) % 2][2] = __builtin_nontemporal_load((const f32x4*)(p_ + HALF)); xr[(g) % 2][3] = __builtin_nontemporal_load((const f32x4*)(p_ + HALF + 4)); } while (0)
        EPI_LOADX(0); EPI_LOADX(1);
#pragma unroll
        for (int g = 0; g < 9; ++g) {
            const int ai = g / 3, m = g % 3, row = row0 + ai * 48 + m * 16;
            float* orow = out + (size_t)row * 2048 + col0; float s = 0.f;
            f32x4 v[2][2];
#pragma unroll
            for (int bj = 0; bj < 2; ++bj) { v[bj][0] = acc[ai][bj][m][0] + xr[g % 2][2 * bj]; v[bj][1] = acc[ai][bj][m][1] + xr[g % 2][2 * bj + 1]; }
            asm volatile("" : "+v"(v[0][0]), "+v"(v[0][1]), "+v"(v[1][0]), "+v"(v[1][1]));
            if (g + 2 < 9) EPI_LOADX(g + 2);
#pragma unroll
            for (int bj = 0; bj < 2; ++bj) { const f32x4 v0 = v[bj][0], v1 = v[bj][1];
                if (out) { *(f32x4*)(orow + bj * HALF) = v0; *(f32x4*)(orow + bj * HALF + 4) = v1; }
                s += (v0[0] * v0[0] + v0[1] * v0[1]) + (v0[2] * v0[2] + v0[3] * v0[3]) + (v1[0] * v1[0] + v1[1] * v1[1]) + (v1[2] * v1[2] + v1[3] * v1[3]);
                if (X1b) { u32x4 w; w.x = cvt_pk_bf16(v0[0], v0[1]); w.y = cvt_pk_bf16(v0[2], v0[3]); w.z = cvt_pk_bf16(v1[0], v1[1]); w.w = cvt_pk_bf16(v1[2], v1[3]);
                    *(u32x4*)(X1b + (size_t)row * 2048 + col0 + bj * HALF) = w; } }
            s += __shfl_xor(s, 16); s += __shfl_xor(s, 32);
            if (fq == 0) atomicAdd(ssq + row, s);
        }
#undef EPI_LOADX
    }
};
struct EpiH {
    bf16_t* H; const float* ssq;
    __device__ __forceinline__ void operator()(Acc& acc, const Unit& u, int wr, int wc, int fr, int fq) const {
        const int row0 = u.pm * BMR + wr * 144 + fr, col0 = u.pn * HALF + wc * 32 + 8 * fq;
#pragma unroll
        for (int ai = 0; ai < 3; ++ai)
#pragma unroll
            for (int m = 0; m < 3; ++m) {
                const int row = row0 + ai * 48 + m * 16;
                const float r = rsqrtf(ssq[row] * (1.0f / 2048.0f) + 1e-6f);
                float h[8];
#pragma unroll
                for (int n = 0; n < 2; ++n)
#pragma unroll
                    for (int j = 0; j < 4; ++j) { const float g = acc[ai][0][m][n][j] * r, up = acc[ai][1][m][n][j] * r;
                        h[4 * n + j] = g * __builtin_amdgcn_rcpf(1.0f + __expf(-g)) * up; }
                u32x4 w; w.x = cvt_pk_bf16(h[0], h[1]); w.y = cvt_pk_bf16(h[2], h[3]); w.z = cvt_pk_bf16(h[4], h[5]); w.w = cvt_pk_bf16(h[6], h[7]);
                *(u32x4*)(H + (size_t)row * 5632 + col0) = w;
            }
    }
};

struct EpiH8 {
    unsigned char* H; const float* ssq; float hsc;
    __device__ __forceinline__ void operator()(Acc& acc, const Unit& u, int wr, int wc, int fr, int fq) const {
        const int row0 = u.pm * BMR + wr * 144 + fr, col0 = u.pn * HALF + wc * 32 + 8 * fq;
#pragma unroll
        for (int ai = 0; ai < 3; ++ai)
#pragma unroll
            for (int m = 0; m < 3; ++m) {
                const int row = row0 + ai * 48 + m * 16;
                const float r = rsqrtf(ssq[row] * (1.0f / 2048.0f) + 1e-6f), nr = r * -1.4426950408889634f, rr = r * r * hsc;
                float h[8];
#pragma unroll
                for (int n = 0; n < 2; ++n)
#pragma unroll
                    for (int j = 0; j < 4; j += 2) {
                        const pg8::f32x2 ga = {acc[ai][0][m][n][j], acc[ai][0][m][n][j + 1]}, ua = {acc[ai][1][m][n][j], acc[ai][1][m][n][j + 1]};
                        const pg8::f32x2 e = ga * nr, t = ga * ua * rr;
                        pg8::f32x2 d = {__builtin_amdgcn_exp2f(e.x), __builtin_amdgcn_exp2f(e.y)}; d = d + 1.0f;
                        const pg8::f32x2 q = t * (pg8::f32x2){__builtin_amdgcn_rcpf(d.x), __builtin_amdgcn_rcpf(d.y)};
                        h[4 * n + j] = __builtin_amdgcn_fmed3f(q.x, -448.f, 448.f); h[4 * n + j + 1] = __builtin_amdgcn_fmed3f(q.y, -448.f, 448.f); }
                int w0 = __builtin_amdgcn_cvt_pk_fp8_f32(h[0], h[1], 0, false); w0 = __builtin_amdgcn_cvt_pk_fp8_f32(h[2], h[3], w0, true);
                int w1 = __builtin_amdgcn_cvt_pk_fp8_f32(h[4], h[5], 0, false); w1 = __builtin_amdgcn_cvt_pk_fp8_f32(h[6], h[7], w1, true);
                *(unsigned long long*)(H + (size_t)row * 5632 + col0) = (unsigned long long)(unsigned)w0 | ((unsigned long long)(unsigned)w1 << 32);
            }
    }
};
struct EpiFinal {
    float* out; float* ssq; unsigned* cnt; const float* fg; const bf16_t* x1b;
    __device__ __forceinline__ void operator()(Acc& acc, const Unit& u, int wr, int wc, int fr, int fq) const {
        const int row0 = u.pm * BMR + wr * 144 + fr, col0 = u.pn * BN + wc * 32 + 8 * fq;
        { f32x4 xr[2][4];
#define EPI_LOADX(g) do { const size_t o_ = (size_t)(row0 + ((g) / 3) * 48 + ((g) % 3) * 16) * 2048 + col0; \
            if (x1b) { const u32x4 a_ = __builtin_nontemporal_load((const u32x4*)(x1b + o_)), b_ = __builtin_nontemporal_load((const u32x4*)(x1b + o_ + HALF)); \
                xr[(g) % 2][0] = (f32x4){__uint_as_float(a_.x << 16), __uint_as_float(a_.x & 0xffff0000u), __uint_as_float(a_.y << 16), __uint_as_float(a_.y & 0xffff0000u)}; \
                xr[(g) % 2][1] = (f32x4){__uint_as_float(a_.z << 16), __uint_as_float(a_.z & 0xffff0000u), __uint_as_float(a_.w << 16), __uint_as_float(a_.w & 0xffff0000u)}; \
                xr[(g) % 2][2] = (f32x4){__uint_as_float(b_.x << 16), __uint_as_float(b_.x & 0xffff0000u), __uint_as_float(b_.y << 16), __uint_as_float(b_.y & 0xffff0000u)}; \
                xr[(g) % 2][3] = (f32x4){__uint_as_float(b_.z << 16), __uint_as_float(b_.z & 0xffff0000u), __uint_as_float(b_.w << 16), __uint_as_float(b_.w & 0xffff0000u)}; } \
            else { const float* p_ = out + o_; xr[(g) % 2][0] = *(const f32x4*)(p_); xr[(g) % 2][1] = *(const f32x4*)(p_ + 4); xr[(g) % 2][2] = *(const f32x4*)(p_ + HALF); xr[(g) % 2][3] = *(const f32x4*)(p_ + HALF + 4); } } while (0)
          EPI_LOADX(0); EPI_LOADX(1);
#pragma unroll
          for (int g = 0; g < 9; ++g) {
              const int ai = g / 3, m = g % 3, row = row0 + ai * 48 + m * 16; float s = 0.f;
#pragma unroll
              for (int bj = 0; bj < 2; ++bj) { acc[ai][bj][m][0] += xr[g % 2][2 * bj]; acc[ai][bj][m][1] += xr[g % 2][2 * bj + 1]; }
              asm volatile("" : "+v"(acc[ai][0][m][0]), "+v"(acc[ai][0][m][1]), "+v"(acc[ai][1][m][0]), "+v"(acc[ai][1][m][1]));
              if (g + 2 < 9) EPI_LOADX(g + 2);
#pragma unroll
              for (int bj = 0; bj < 2; ++bj) { const f32x4 v0 = acc[ai][bj][m][0], v1 = acc[ai][bj][m][1];
                  s += (v0[0] * v0[0] + v0[1] * v0[1]) + (v0[2] * v0[2] + v0[3] * v0[3]) + (v1[0] * v1[0] + v1[1] * v1[1]) + (v1[2] * v1[2] + v1[3] * v1[3]); }
              s += __shfl_xor(s, 16); s += __shfl_xor(s, 32);
              if (fq == 0) atomicAdd(ssq + row, s);
          }
#undef EPI_LOADX
        }
        asm volatile("s_waitcnt vmcnt(0)" ::: "memory");
        unsigned* cw = cnt + 64 * u.pm;
        if ((threadIdx.x & 63) == 0) __hip_atomic_fetch_add(cw, 1u, __ATOMIC_RELAXED, __HIP_MEMORY_SCOPE_AGENT);
        { unsigned spins = 0;
          while ((unsigned)__builtin_amdgcn_readfirstlane(__hip_atomic_load(cw, __ATOMIC_RELAXED, __HIP_MEMORY_SCOPE_AGENT)) < 64u) { __builtin_amdgcn_s_sleep(2); if (++spins > (1u << 20)) break; } }
        f32x4 gv[2][2];
#pragma unroll
        for (int bj = 0; bj < 2; ++bj) { gv[bj][0] = *(const f32x4*)(fg + col0 + bj * HALF); gv[bj][1] = *(const f32x4*)(fg + col0 + bj * HALF + 4); }
#pragma unroll
        for (int ai = 0; ai < 3; ++ai)
#pragma unroll
            for (int m = 0; m < 3; ++m) {
                const int row = row0 + ai * 48 + m * 16; float* orow = out + (size_t)row * 2048 + col0;
                const float tot = __hip_atomic_load(ssq + row, __ATOMIC_RELAXED, __HIP_MEMORY_SCOPE_AGENT);
                const float r = rsqrtf(tot * (1.0f / 2048.0f) + 1e-6f);
#pragma unroll
                for (int bj = 0; bj < 2; ++bj) { *(f32x4*)(orow + bj * HALF) = acc[ai][bj][m][0] * r * gv[bj][0]; *(f32x4*)(orow + bj * HALF + 4) = acc[ai][bj][m][1] * r * gv[bj][1]; }
            }
    }
};

template <class Epi, bool ALIGN_EPI = true, bool FP8 = false, int SCA = 127, int SCB = 127>
__device__ __forceinline__ void gemm_phase(PG8_LAS unsigned char* lds, const Gemm g, const StaticOrder& S, const Epi& E) {
    const int tid = threadIdx.x, wid = __builtin_amdgcn_readfirstlane(tid >> 6), lane = tid & 63, wr = wid >> 2, wc = wid & 3, fr = lane & 15, fq = lane >> 4;
    const int K = g.K, nt = K / BK;
    unsigned voffA[2], voffB[2];
#pragma unroll
    for (int i = 0; i < 2; ++i) { const int R = 8 * (wid + 8 * i) + (lane >> 3), C = 8 * ((lane & 7) ^ (R & 7)); const int Ra = 144 * (R / 48) + (R % 48);
        voffA[i] = (unsigned)(Ra * K + C) * 2u;
        voffB[i] = (unsigned)((wid + 8 * i) * (K >> 6)) * 1024u + (unsigned)((lane >> 3) * 128 + (((lane & 7) ^ (lane >> 3)) << 4)); }
    const size_t kstep = (size_t)(BK * 2);
    const size_t kstepB = 1024;
    const size_t hstep = (size_t)HALF * K * 2;
    const size_t thA = (size_t)48 * K * 2;
    const size_t tstepA = (size_t)BMR * K * 2, tstepB = (size_t)BN * K * 2;
    const unsigned ldsw = (unsigned)wid * 1024u;
    const int aoff0 = (wr * 48 + fr) * 128 + ((fq ^ (fr & 7)) << 4), aoff1 = (wr * 48 + fr) * 128 + (((fq + 4) ^ (fr & 7)) << 4);
    const int boff0 = (wc * 32 + fr) * 128 + ((fq ^ (fr & 7)) << 4), boff1 = (wc * 32 + fr) * 128 + (((fq + 4) ^ (fr & 7)) << 4);
#define PG9_SA(b, a) (((b) * 3 + (a)) * ATB)
#define PG9_SB(b, h) (6 * ATB + ((b) * 2 + (h)) * HTB)
#define PG9_STAGE_B(bufoff, gbase) do { _Pragma("unroll") for (int _i = 0; _i < 2; ++_i) \
        __builtin_amdgcn_global_load_lds((const unsigned*)((const char*)(gbase) + voffB[_i]), (PG8_LAS unsigned*)(lds + (bufoff) + ldsw + _i * 8192), 16, 0, 0); } while (0)
#define PG9_STAGE_A(bufoff, gbase) do { __builtin_amdgcn_global_load_lds((const unsigned*)((const char*)(gbase) + voffA[0]), (PG8_LAS unsigned*)(lds + (bufoff) + ldsw), 16, 0, FP8 ? 2 : 0); \
        if (wr == 0) __builtin_amdgcn_global_load_lds((const unsigned*)((const char*)(gbase) + voffA[1]), (PG8_LAS unsigned*)(lds + (bufoff) + ldsw + 8192), 16, 0, FP8 ? 2 : 0); } while (0)
#define PG9_LDA(dst, b, a) do { _Pragma("unroll") for (int m = 0; m < 3; ++m) { if constexpr (FP8) { dst##8[m] = cat8(*(const PG8_LAS bf16x8*)(lds + PG9_SA(b, a) + aoff0 + m * 2048), *(const PG8_LAS bf16x8*)(lds + PG9_SA(b, a) + aoff1 + m * 2048)); } \
        else { dst[m][0] = *(const PG8_LAS bf16x8*)(lds + PG9_SA(b, a) + aoff0 + m * 2048); dst[m][1] = *(const PG8_LAS bf16x8*)(lds + PG9_SA(b, a) + aoff1 + m * 2048); } } } while (0)
#define PG9_LDB(dst, b, h) do { int _b0 = boff0, _b1 = boff1; asm volatile("" : "+v"(_b0), "+v"(_b1));     \
        _Pragma("unroll") for (int n = 0; n < 2; ++n) { if constexpr (FP8) { dst##8[n] = cat8(*(const PG8_LAS bf16x8*)(lds + PG9_SB(b, h) + _b0 + n * 2048), *(const PG8_LAS bf16x8*)(lds + PG9_SB(b, h) + _b1 + n * 2048)); } \
        else { dst[n][0] = *(const PG8_LAS bf16x8*)(lds + PG9_SB(b, h) + _b0 + n * 2048); dst[n][1] = *(const PG8_LAS bf16x8*)(lds + PG9_SB(b, h) + _b1 + n * 2048); } } } while (0)
#define PG9_MMA(ai, bj, At, Bt) do { __builtin_amdgcn_s_setprio(1); _Pragma("unroll") for (int m = 0; m < 3; ++m) _Pragma("unroll") for (int n = 0; n < 2; ++n) { \
        if constexpr (FP8) { acc[ai][bj][m][n] = __builtin_amdgcn_mfma_scale_f32_16x16x128_f8f6f4(Bt##8[n], At##8[m], acc[ai][bj][m][n], 0, 0, 0, SCB, 0, SCA); } \
        else { _Pragma("unroll") for (int k = 0; k < 2; ++k) acc[ai][bj][m][n] = __builtin_amdgcn_mfma_f32_16x16x32_bf16(Bt[n][k], At[m][k], acc[ai][bj][m][n], 0, 0, 0); } } __builtin_amdgcn_s_setprio(0); } while (0)
#define PG9_WAIT_V(n0, n1) do { if (wr == 0) asm volatile("s_waitcnt vmcnt(" #n0 ")" ::: "memory"); else asm volatile("s_waitcnt vmcnt(" #n1 ")" ::: "memory"); } while (0)
#define PG9_WAIT_L0 asm volatile("s_waitcnt lgkmcnt(0)" ::: "memory")
#define PG9_BAR __builtin_amdgcn_s_barrier()
#define PG9_SCHED __builtin_amdgcn_sched_barrier(0)
#define PG9_PIN(ai) do { if constexpr (FP8) asm volatile("" : "+v"(acc[ai][0][0][0]), "+v"(acc[ai][0][0][1]), "+v"(acc[ai][0][1][0]), "+v"(acc[ai][0][1][1]), "+v"(acc[ai][0][2][0]), "+v"(acc[ai][0][2][1]), \
        "+v"(acc[ai][1][0][0]), "+v"(acc[ai][1][0][1]), "+v"(acc[ai][1][1][0]), "+v"(acc[ai][1][1][1]), "+v"(acc[ai][1][2][0]), "+v"(acc[ai][1][2][1])); } while (0)
#define PG9_SCHED8 do { if constexpr (FP8) __builtin_amdgcn_sched_barrier(0); } while (0)
#define PG9_ZERO() do { _Pragma("unroll") for (int a = 0; a < 3; ++a) _Pragma("unroll") for (int b = 0; b < 2; ++b) _Pragma("unroll") for (int m = 0; m < 3; ++m) _Pragma("unroll") for (int n = 0; n < 2; ++n) acc[a][b][m][n] = (f32x4){0.f, 0.f, 0.f, 0.f}; } while (0)
    Unit cur, nxt; int ui = 0;
    if (!S.next(0, cur)) return;
    Acc acc; PG9_ZERO();
    bf16x8 At[3][2], B0[2][2], B1[2][2];
    v8i At8[3], B08[2], B18[2];
    const char* cA = (const char*)g.A + (size_t)cur.pm * tstepA; const char* cB = (const char*)g.Bt + (size_t)cur.pn * tstepB;
    PG9_STAGE_B(PG9_SB(0, 0), cB); PG9_STAGE_A(PG9_SA(0, 0), cA); PG9_STAGE_B(PG9_SB(0, 1), cB + hstep); PG9_STAGE_A(PG9_SA(0, 1), cA + thA); PG9_STAGE_A(PG9_SA(0, 2), cA + 2 * thA);
    PG9_STAGE_B(PG9_SB(1, 0), cB + kstepB); PG9_STAGE_A(PG9_SA(1, 0), cA + kstep); PG9_STAGE_B(PG9_SB(1, 1), cB + hstep + kstepB); PG9_STAGE_A(PG9_SA(1, 1), cA + thA + kstep);
    if (wr == 1) PG9_BAR;
    PG9_WAIT_V(12, 8); PG9_BAR; PG9_BAR;
    for (;;) {
        const bool has_next = S.next(ui + 1, nxt);
        const char* nA = has_next ? (const char*)g.A + (size_t)nxt.pm * tstepA : cA; const char* nB = has_next ? (const char*)g.Bt + (size_t)nxt.pn * tstepB : cB;
        for (int t = 0; t < nt; t += 2) {
            const bool last = (t == nt - 2);
            const char* a1 = cA + (size_t)(t + 1) * kstep;
            const char* a2 = last ? nA : cA + (size_t)(t + 2) * kstep; const char* b2 = last ? nB : cB + (size_t)(t + 2) * kstepB;
            const char* a3 = a2 + kstep; const char* b3 = b2 + kstepB;
            PG9_LDB(B0, 0, 0); PG9_LDB(B1, 0, 1); PG9_SCHED; PG9_LDA(At, 0, 0); PG9_STAGE_A(PG9_SA(1, 2), a1 + 2 * thA);
            PG9_WAIT_V(12, 8); PG9_WAIT_L0; PG9_BAR; PG9_SCHED8; PG9_MMA(0, 0, At, B0); PG9_MMA(0, 1, At, B1); PG9_PIN(0); PG9_SCHED8; PG9_BAR; PG9_SCHED;
            PG9_LDA(At, 0, 1); PG9_STAGE_B(PG9_SB(0, 0), b2); PG9_STAGE_A(PG9_SA(0, 0), a2);
            PG9_WAIT_V(14, 10); PG9_WAIT_L0; PG9_BAR; PG9_SCHED8; PG9_MMA(1, 0, At, B0); PG9_MMA(1, 1, At, B1); PG9_PIN(1); PG9_SCHED8; PG9_BAR; PG9_SCHED;
            PG9_LDA(At, 0, 2); PG9_STAGE_B(PG9_SB(0, 1), b2 + hstep); PG9_STAGE_A(PG9_SA(0, 1), a2 + thA);
            PG9_WAIT_V(12, 8); PG9_WAIT_L0; PG9_BAR; PG9_SCHED8; PG9_MMA(2, 0, At, B0); PG9_MMA(2, 1, At, B1); PG9_PIN(2); PG9_SCHED8; PG9_BAR; PG9_SCHED;
            PG9_LDB(B0, 1, 0); PG9_LDB(B1, 1, 1); PG9_SCHED; PG9_LDA(At, 1, 0); PG9_STAGE_A(PG9_SA(0, 2), a2 + 2 * thA);
            PG9_WAIT_V(12, 8); PG9_WAIT_L0; PG9_BAR; PG9_SCHED8; PG9_MMA(0, 0, At, B0); PG9_MMA(0, 1, At, B1); PG9_PIN(0); PG9_SCHED8; PG9_BAR; PG9_SCHED;
            PG9_LDA(At, 1, 1); PG9_STAGE_B(PG9_SB(1, 0), b3); PG9_STAGE_A(PG9_SA(1, 0), a3);
            PG9_WAIT_V(14, 10); PG9_WAIT_L0; PG9_BAR; PG9_SCHED8; PG9_MMA(1, 0, At, B0); PG9_MMA(1, 1, At, B1); PG9_PIN(1); PG9_SCHED8; PG9_BAR; PG9_SCHED;
            PG9_LDA(At, 1, 2); PG9_STAGE_B(PG9_SB(1, 1), b3 + hstep); PG9_STAGE_A(PG9_SA(1, 1), a3 + thA);
            PG9_WAIT_V(12, 8); PG9_WAIT_L0; PG9_BAR; PG9_SCHED8; PG9_MMA(2, 0, At, B0); PG9_MMA(2, 1, At, B1); PG9_PIN(2); PG9_SCHED8; PG9_BAR; PG9_SCHED;
        }
        if constexpr (ALIGN_EPI) { if (wr == 0) PG9_BAR; }
        E(acc, cur, wr, wc, fr, fq);
        if (!has_next) break;
        PG9_ZERO();
        cur = nxt; cA = nA; cB = nB; ++ui;
        if constexpr (ALIGN_EPI) { if (wr == 1) PG9_BAR; }
    }
    asm volatile("s_waitcnt vmcnt(0)" ::: "memory");
    if constexpr (!ALIGN_EPI) { if (wr == 0) PG9_BAR; }
    PG9_BAR;
#undef PG9_SA
#undef PG9_SB
#undef PG9_STAGE_A
#undef PG9_STAGE_B
#undef PG9_LDA
#undef PG9_LDB
#undef PG9_MMA
#undef PG9_WAIT_V
#undef PG9_WAIT_L0
#undef PG9_BAR
#undef PG9_SCHED
#undef PG9_SCHED8
#undef PG9_PIN
#undef PG9_ZERO
}
}
#define GAS __attribute__((address_space(1)))
#define LAS __attribute__((address_space(3)))
typedef unsigned short bf16;
typedef unsigned v4u __attribute__((ext_vector_type(4)));
typedef unsigned v2u __attribute__((ext_vector_type(2)));
typedef float f32x4 __attribute__((ext_vector_type(4)));
typedef short bf16x8 __attribute__((ext_vector_type(8)));
typedef GAS unsigned gu32;
typedef GAS unsigned long long gu64;
#define RLX_AGENT __ATOMIC_RELAXED, __HIP_MEMORY_SCOPE_AGENT
#define LDS_WAIT() asm volatile("s_waitcnt lgkmcnt(0)" ::: "memory")
#define VM_WAIT() asm volatile("s_waitcnt vmcnt(0)" ::: "memory")
__device__ __forceinline__ unsigned f2bf(float f) { unsigned u = __builtin_bit_cast(unsigned, f); return (u + 0x7fffu + ((u >> 16) & 1u)) >> 16; }
__device__ __forceinline__ unsigned pk2(float lo, float hi) { return f2bf(lo) | (f2bf(hi) << 16); }
__device__ __forceinline__ float bf2f(unsigned b) { return __builtin_bit_cast(float, b << 16); }
__device__ __forceinline__ float wave_sum(float v) {
#pragma unroll
    for (int o = 1; o < 64; o <<= 1) v += __shfl_xor(v, o);
    return v;
}
__device__ __forceinline__ float sigmoidf_(float x) { return 1.f / (1.f + __expf(-x)); }
__device__ __forceinline__ float log_sigmoid(float x) { return fminf(x, 0.f) - log1pf(__expf(-fabsf(x))); }

#define XB_TMO      128
#define XB_XCNT(j)  (256  + 64 * (j))
#define XB_XSUB(j)  (1280 + 64 * (j))
#define XB_XGEN(j)  (2304 + 64 * (j))
#define XB_TOP      3328
#define XB_TOPGEN   3392
#define XCD_BAR_WORDS 3456
#define XB_SPIN_CAP (1u << 18)

__device__ __forceinline__ unsigned xb_ld(unsigned* p)              { return __hip_atomic_load(p, __ATOMIC_RELAXED, __HIP_MEMORY_SCOPE_AGENT); }
__device__ __forceinline__ unsigned xb_add(unsigned* p, unsigned v) { return __hip_atomic_fetch_add(p, v, __ATOMIC_RELAXED, __HIP_MEMORY_SCOPE_AGENT); }
__device__ __forceinline__ unsigned xb_xcc_id() { return (unsigned)__builtin_amdgcn_s_getreg((3 << 11) | 20) & 0xFu; }
#define XB_SPIN(cond, bar) do { unsigned _sp = 0; while (cond) { __builtin_amdgcn_s_sleep(1); \
    if ((++_sp & 255u) == 0u) { if (xb_ld(&(bar)[XB_TMO])) break; if (_sp > XB_SPIN_CAP) { atomicAdd(&(bar)[XB_TMO], 1u); break; } } } } while (0)

struct XcdBarrier {
    unsigned* bar; unsigned x;
    volatile LAS unsigned* st;
};

__device__ __forceinline__ XcdBarrier xcd_barrier_post(unsigned* bar, volatile LAS unsigned* st) {
    XcdBarrier b; b.bar = bar; b.x = xb_xcc_id(); b.st = st;
    if (threadIdx.x == 0) (void)xb_add(&bar[XB_XCNT(b.x)], 1u);
    return b;
}
__device__ __forceinline__ void xcd_barrier_complete(unsigned* bar, unsigned x, unsigned& nloc, unsigned& nx) {
    const unsigned G = gridDim.x * gridDim.y * gridDim.z;
    unsigned sum, cnt, mine, sp = 0u;
    for (;;) {
        sum = 0u; cnt = 0u; mine = 0u;
#pragma unroll
        for (unsigned j = 0; j < 16; ++j) { const unsigned c = xb_ld(&bar[XB_XCNT(j)]); sum += c; cnt += (c > 0u) ? 1u : 0u; mine = (j == x) ? c : mine; }
        if (sum == G) break;
        __builtin_amdgcn_s_sleep(1);
        if ((++sp & 255u) == 0u) { if (xb_ld(&bar[XB_TMO])) break; if (sp > XB_SPIN_CAP) { atomicAdd(&bar[XB_TMO], 1u); break; } }
    }
    nloc = mine > 0u ? mine : 1u; nx = cnt > 0u ? cnt : 1u;
}

__device__ __forceinline__ void xcd_barrier(const XcdBarrier& b) {
    asm volatile("s_waitcnt vmcnt(0)" ::: "memory");
    __syncthreads();
    if (threadIdx.x == 0) {
        unsigned* bar = b.bar;
        __builtin_amdgcn_s_waitcnt(0);
        unsigned nloc = b.st[0], nx = b.st[1];
        if (nloc == 0u) { xcd_barrier_complete(bar, b.x, nloc, nx); b.st[0] = nloc; b.st[1] = nx; }
        const unsigned old = xb_add(&bar[XB_XSUB(b.x)], 1u);
        const unsigned gen = old / nloc;
        if (old + 1u == (gen + 1u) * nloc) {
            __builtin_amdgcn_fence(__ATOMIC_RELEASE, "agent");
            asm volatile("s_waitcnt vmcnt(0)" ::: "memory");
            const unsigned og = xb_add(&bar[XB_TOP], 1u);
            const unsigned tg = og / nx;
            if (og + 1u == (tg + 1u) * nx) xb_add(&bar[XB_TOPGEN], 1u);
            else XB_SPIN(xb_ld(&bar[XB_TOPGEN]) == tg, bar);
            __builtin_amdgcn_fence(__ATOMIC_ACQUIRE, "agent");
            xb_add(&bar[XB_XGEN(b.x)], 1u);
            asm volatile("s_waitcnt vmcnt(0)" ::: "memory");
        } else {
            XB_SPIN(xb_ld(&bar[XB_XGEN(b.x)]) == gen, bar);
            __builtin_amdgcn_fence(__ATOMIC_ACQUIRE, "agent");
            asm volatile("s_waitcnt vmcnt(0)" ::: "memory");
        }
    }
    __syncthreads();
}
struct Frame {
    LAS unsigned char* lds;
    volatile LAS unsigned* MISC;
    gu32* ctl;
    int tid, lane, wave;
    int vcu, G;
    const float *x_p, *x_s, *st_conv, *st_C, *st_n, *st_m, *g1, *w_in, *b_i, *b_f, *conv_w, *conv_g, *ml_g, *w_out, *g2, *wg, *wu, *wd, *fg;
    float* out;
    bf16 *W1, *W2, *W3, *W4, *XN, *YC, *Z, *HB, *X1b;
    float *gates, *ssq1, *ssq2;
};

struct TrItem { const float* W; int ldw, K, nblk; bf16* WT; int mode; const float* kgain; int item; };
__device__ __forceinline__ void p0_tr_load(const TrItem& T, int lane, f32x4 (&v)[16]) {
    const int kb = T.item / T.nblk, nb = T.item % T.nblk, k0 = 64 * kb, n0 = 64 * nb; const int r4 = lane >> 4, c4 = 4 * (lane & 15);
#pragma unroll
    for (int i = 0; i < 16; ++i) v[i] = __builtin_nontemporal_load((const GAS f32x4*)(T.W + (size_t)(k0 + 4 * i + r4) * T.ldw + n0 + c4));
}
__device__ __forceinline__ void p0_tr_finish(const TrItem& T, int lane, const f32x4 (&v)[16], LAS float* scr) {
    const int kb = T.item / T.nblk, nb = T.item % T.nblk, k0 = 64 * kb, n0 = 64 * nb; const int r4 = lane >> 4, c4 = 4 * (lane & 15);
#pragma unroll
    for (int i = 0; i < 16; ++i) { const int kk = 4 * i + r4; const float g = T.kgain ? T.kgain[k0 + kk] : 1.f; LAS float* d = scr + kk * 65 + c4; d[0] = v[i].x * g; d[1] = v[i].y * g; d[2] = v[i].z * g; d[3] = v[i].w * g; }
    LDS_WAIT(); asm volatile("" ::: "memory");
    const int c = lane & 7;
#pragma unroll
    for (int j = 0; j < 8; ++j) { const int n = (lane >> 3) + 8 * j; const LAS float* s = scr + (8 * c) * 65 + n;
        v4u o; o.x = pk2(s[0 * 65], s[1 * 65]); o.y = pk2(s[2 * 65], s[3 * 65]); o.z = pk2(s[4 * 65], s[5 * 65]); o.w = pk2(s[6 * 65], s[7 * 65]);
        const int jn = n0 + n; int drow = jn; if (T.mode == 1) drow = 256 * (jn >> 7) + (jn & 127); if (T.mode == 2) drow = 256 * (jn >> 7) + 128 + (jn & 127);
        if (T.mode == 3) {
            if (jn >= ZC_CG && jn < ZC_XT) { const int cc = jn - ZC_CG; drow = ZC_CG + 256 * (cc >> 7) + (cc & 127); }
            else if (jn >= ZC_XT && jn < ZC_Q) { const int cc = jn - ZC_XT; drow = ZC_CG + 256 * (cc >> 7) + 128 + (cc & 127); } }
        const int x = drow & 31, slot = (drow & ~31) + 16 * ((x >> 2) & 1) + 4 * (x >> 3) + (x & 3);
        *(GAS v4u*)((GAS unsigned char*)T.WT + ((size_t)(slot >> 3) * (T.K >> 6) + (k0 >> 6)) * 1024 + (slot & 7) * 128 + 16 * c) = o; }
    LDS_WAIT(); asm volatile("" ::: "memory");
}
__device__ __forceinline__ void p0_tr_finish_fp8(const TrItem& T, int lane, const f32x4 (&v)[16], LAS float* scr, float wsc) {
    const int kb = T.item / T.nblk, nb = T.item % T.nblk, k0 = 64 * kb, n0 = 64 * nb; const int r4 = lane >> 4, c4 = 4 * (lane & 15);
#pragma unroll
    for (int i = 0; i < 16; ++i) { const int kk = 4 * i + r4; LAS float* d = scr + kk * 65 + c4; d[0] = v[i].x * wsc; d[1] = v[i].y * wsc; d[2] = v[i].z * wsc; d[3] = v[i].w * wsc; }
    LDS_WAIT(); asm volatile("" ::: "memory");
    const int c = lane & 3;
#pragma unroll
    for (int j = 0; j < 4; ++j) { const int n = (lane >> 2) + 16 * j; const LAS float* s = scr + (16 * c) * 65 + n; int w[4];
#pragma unroll
        for (int q = 0; q < 4; ++q) { w[q] = __builtin_amdgcn_cvt_pk_fp8_f32(s[(4 * q) * 65], s[(4 * q + 1) * 65], 0, false); w[q] = __builtin_amdgcn_cvt_pk_fp8_f32(s[(4 * q + 2) * 65], s[(4 * q + 3) * 65], w[q], true); }
        const int drow = n0 + n, x = drow & 31, slot = (drow & ~31) + 16 * ((x >> 2) & 1) + 4 * (x >> 3) + (x & 3);
        v4u o; o.x = (unsigned)w[0]; o.y = (unsigned)w[1]; o.z = (unsigned)w[2]; o.w = (unsigned)w[3];
        *(GAS v4u*)((GAS unsigned char*)T.WT + ((size_t)(slot >> 3) * (T.K >> 7) + (k0 >> 7)) * 1024 + (slot & 7) * 128 + (k0 & 127) + 16 * c) = o; }
    LDS_WAIT(); asm volatile("" ::: "memory");
}
__device__ __forceinline__ void p0_transpose_item_fp8(const float* W, int ldw, int K, int nblk, bf16* WT, LAS float* scr, int item, int lane, float wsc) {
    const TrItem T{W, ldw, K, nblk, WT, 0, nullptr, item}; f32x4 v[16]; p0_tr_load(T, lane, v); p0_tr_finish_fp8(T, lane, v, scr, wsc);
}
__device__ __forceinline__ void p0_transpose_item(const float* W, int ldw, int K, int nblk, bf16* WT, int mode, const float* kgain, LAS float* scr, int item, int lane) {
    const TrItem T{W, ldw, K, nblk, WT, mode, kgain, item}; f32x4 v[16]; p0_tr_load(T, lane, v); p0_tr_finish(T, lane, v, scr);
}
__device__ __forceinline__ void p0_xrow_load(Frame& F, int m, f32x4 (&v)[8]) {
    const float* xr = m < MP ? F.x_p + (size_t)m * D : F.x_s + (size_t)(m - MP) * D;
#pragma unroll
    for (int j = 0; j < 8; ++j) v[j] = __builtin_nontemporal_load((const GAS f32x4*)(xr + 256 * j + 4 * F.lane));
}
__device__ __forceinline__ void p0_xrow(Frame& F, int m, const LAS float* gwl, const f32x4 (&v)[8], const f32x4 (&g)[8], float bq) {
    const int lane = F.lane; float s = 0.f;
#pragma unroll
    for (int j = 0; j < 8; ++j) s += (v[j].x * v[j].x + v[j].y * v[j].y) + (v[j].z * v[j].z + v[j].w * v[j].w);
    const float r = rsqrtf(wave_sum(s) * (1.f / D) + EPS);
    float ga[8]; pg8::f32x2 ga2[8];
#pragma unroll
    for (int q = 0; q < 8; ++q) ga2[q] = (pg8::f32x2){0.f, 0.f};
#pragma unroll
    for (int j = 0; j < 8; ++j) {
        const int k = 256 * j + 4 * lane;
        const f32x4 xn = v[j] * r * g[j];
        *(GAS unsigned long long*)(F.XN + (size_t)m * D + k) = (unsigned long long)pg8::cvt_pk_bf16(xn.x, xn.y) | ((unsigned long long)pg8::cvt_pk_bf16(xn.z, xn.w) << 32);
        f32x4 w[8];
#pragma unroll
        for (int q = 0; q < 8; ++q) w[q] = *(const LAS f32x4*)(gwl + q * D + k);
        const pg8::f32x2 xlo = {xn.x, xn.y}, xhi = {xn.z, xn.w};
#pragma unroll
        for (int q = 0; q < 8; ++q) { ga2[q] = __builtin_elementwise_fma(xlo, (pg8::f32x2){w[q].x, w[q].y}, ga2[q]); ga2[q] = __builtin_elementwise_fma(xhi, (pg8::f32x2){w[q].z, w[q].w}, ga2[q]); }
    }
#pragma unroll
    for (int q = 0; q < 8; ++q) ga[q] = ga2[q].x + ga2[q].y;
    float k4[4], k2[2], k1;
    { const bool hi = (lane & 32) != 0;
#pragma unroll
      for (int i = 0; i < 4; ++i) { const float recv = __shfl_xor(hi ? ga[i] : ga[4 + i], 32); k4[i] = (hi ? ga[4 + i] : ga[i]) + recv; } }
    { const bool hi = (lane & 16) != 0;
#pragma unroll
      for (int i = 0; i < 2; ++i) { const float recv = __shfl_xor(hi ? k4[i] : k4[2 + i], 16); k2[i] = (hi ? k4[2 + i] : k4[i]) + recv; } }
    { const bool hi = (lane & 8) != 0; const float recv = __shfl_xor(hi ? k2[0] : k2[1], 8); k1 = (hi ? k2[1] : k2[0]) + recv; }
    k1 += __shfl_xor(k1, 4); k1 += __shfl_xor(k1, 2); k1 += __shfl_xor(k1, 1);
    if ((lane & 7) == 0) { const int q = lane >> 3; F.gates[(size_t)m * 8 + q] = q < 4 ? k1 + bq : log_sigmoid(k1 + bq); }
}
constexpr int TR_I1 = (D / 64) * (NZ / 64), TR_I2 = (D / 64) * (D / 64), TR_I3 = (D / 64) * (FF / 64), TR_I4 = (FF / 64) * (D / 64);
__device__ __forceinline__ TrItem tr_make(Frame& F, int it) {
    int r = it;
    if (r < TR_I1) return TrItem{F.w_in, NIN, D, NZ / 64, F.W1, 3, nullptr, r}; r -= TR_I1;
    if (r < TR_I2) return TrItem{F.w_out, D, D, D / 64, F.W2, 0, nullptr, r}; r -= TR_I2;
    if (r < TR_I3) return TrItem{F.wg, FF, D, FF / 64, F.W3, 1, F.g2, r}; r -= TR_I3;
    if (r < TR_I3) return TrItem{F.wu, FF, D, FF / 64, F.W3, 2, F.g2, r}; r -= TR_I3;
    return TrItem{F.wd, D, FF, D / 64, F.W4, 0, nullptr, r};
}
__device__ __forceinline__ void tr_run(Frame& F, int lo, int hi, int first, int stride, LAS float* scr) {
    f32x4 va[16], vb[16]; int it = lo + first; TrItem Ta{}, Tb{};
    if (it < hi) { Ta = tr_make(F, it); p0_tr_load(Ta, F.lane, va); }
    while (it < hi) {
        const int it2 = it + stride;
        if (it2 < hi) { Tb = tr_make(F, it2); p0_tr_load(Tb, F.lane, vb); }
        p0_tr_finish(Ta, F.lane, va, scr);
        if (it2 >= hi) break;
        const int it3 = it2 + stride;
        if (it3 < hi) { Ta = tr_make(F, it3); p0_tr_load(Ta, F.lane, va); }
        p0_tr_finish(Tb, F.lane, vb, scr);
        it = it3;
    }
}
__device__ __forceinline__ void p0_prologue(Frame& F, bool w4_later, bool w23_later) {
    LAS float* scr = (LAS float*)(F.lds + RING_OFF + F.wave * 16640);
    const int gw = F.vcu * NWAVES + F.wave, NGW = F.G * NWAVES;
    constexpr int I_1 = (D / 64) * (NZ / 64), I_2 = (D / 64) * (D / 64), I_3 = (D / 64) * (FF / 64), I_4 = (FF / 64) * (D / 64);
    constexpr int NITEMS = I_1 + I_2 + 2 * I_3 + I_4;
    const int NIT = w23_later ? I_1 : (w4_later ? NITEMS - I_4 : NITEMS);
    tr_run(F, 0, NIT, gw, NGW, scr);
    __syncthreads();
    LAS float* gwl = (LAS float*)(F.lds + RING_OFF);
    for (int k = F.tid; k < D; k += NWAVES * 64) {
        const f32x4 a = *(const GAS f32x4*)(F.w_in + (size_t)k * NIN + NZ), b = *(const GAS f32x4*)(F.w_in + (size_t)k * NIN + NZ + 4);
        gwl[0 * D + k] = a.x; gwl[1 * D + k] = a.y; gwl[2 * D + k] = a.z; gwl[3 * D + k] = a.w; gwl[4 * D + k] = b.x; gwl[5 * D + k] = b.y; gwl[6 * D + k] = b.z; gwl[7 * D + k] = b.w;
    }
    __syncthreads();
    {
        f32x4 g[8];
#pragma unroll
        for (int j = 0; j < 8; ++j) g[j] = *(const GAS f32x4*)(F.g1 + 256 * j + 4 * F.lane);
        const float bq = (F.lane >> 3) < 4 ? F.b_i[F.lane >> 3] : F.b_f[(F.lane >> 3) - 4];
        const int rot = NIT % NGW;
        f32x4 va[8], vb[8]; int m = gw >= rot ? gw - rot : gw - rot + NGW;
        p0_xrow_load(F, m < M ? m : M - 1, va);
        while (m < M) {
            const int m2 = m + NGW;
            p0_xrow_load(F, m2 < M ? m2 : M - 1, vb);
            asm volatile("" ::: "memory");
            p0_xrow(F, m, gwl, va, g, bq);
            if (m2 >= M) break;
            const int m3 = m2 + NGW;
            p0_xrow_load(F, m3 < M ? m3 : M - 1, va);
            asm volatile("" ::: "memory");
            p0_xrow(F, m2, gwl, vb, g, bq);
            m = m3;
        }
    }
    __syncthreads();
}
__device__ __forceinline__ void final_norm_phase(Frame& F) {
    const int gw = F.vcu * NWAVES + F.wave, NGW = F.G * NWAVES;
    for (int m = gw; m < M; m += NGW) {
        const float r = rsqrtf(F.ssq2[m] * (1.f / D) + EPS);
#pragma unroll
        for (int j = 0; j < 8; ++j) { GAS f32x4* p = (GAS f32x4*)(F.out + (size_t)m * D + 256 * j + 4 * F.lane); const f32x4 g = *(const GAS f32x4*)(F.fg + 256 * j + 4 * F.lane); *p = *p * r * g; }
    }
}
__device__ __forceinline__ void unpack8(const v4u w, float (&f)[8]) {
    f[0] = bf2f(w.x & 0xffffu); f[1] = bf2f(w.x >> 16); f[2] = bf2f(w.y & 0xffffu); f[3] = bf2f(w.y >> 16);
    f[4] = bf2f(w.z & 0xffffu); f[5] = bf2f(w.z >> 16); f[6] = bf2f(w.w & 0xffffu); f[7] = bf2f(w.w >> 16);
}
__device__ __forceinline__ void conv_item(Frame& F, int item) {
    const bool prompt = item < 1024;
    const int b = prompt ? (item >> 8) : (item - 1024);
    const int row0 = prompt ? 8 * item : MP + 8 * (item - 1024);
    const int t0 = prompt ? 8 * (item & 255) : 0;
    const bool last_item = prompt ? ((item & 255) == 255) : true;
    const int lane = F.lane;
    float w0[16], w1[16], w2[16], cg_[16], up2[16], up1[16];
#pragma unroll
    for (int p = 0; p < 2; ++p) {
        const int c0 = 8 * lane + 512 * p;
#pragma unroll
        for (int q = 0; q < 2; ++q) {
            const f32x4 a = *(const GAS f32x4*)(F.conv_w + c0 + 4 * q), bb = *(const GAS f32x4*)(F.conv_w + DC + c0 + 4 * q), c = *(const GAS f32x4*)(F.conv_w + 2 * DC + c0 + 4 * q), g = *(const GAS f32x4*)(F.conv_g + c0 + 4 * q);
#pragma unroll
            for (int i = 0; i < 4; ++i) { w0[8 * p + 4 * q + i] = a[i]; w1[8 * p + 4 * q + i] = bb[i]; w2[8 * p + 4 * q + i] = c[i]; cg_[8 * p + 4 * q + i] = g[i]; }
        }
    }
    if (prompt) {
        if (t0 == 0) {
#pragma unroll
            for (int i = 0; i < 16; ++i) { up2[i] = 0.f; up1[i] = 0.f; }
        } else {
#pragma unroll
            for (int p = 0; p < 2; ++p) {
                const int c0 = 8 * lane + 512 * p; float a[8];
                const bf16* z2 = F.Z + (size_t)(row0 - 2) * NZ; const bf16* z1 = F.Z + (size_t)(row0 - 1) * NZ;
                unpack8(*(const GAS v4u*)(z2 + ZC_CG + c0), a);
#pragma unroll
                for (int i = 0; i < 8; ++i) up2[8 * p + i] = a[i];
                unpack8(*(const GAS v4u*)(z1 + ZC_CG + c0), a);
#pragma unroll
                for (int i = 0; i < 8; ++i) up1[8 * p + i] = a[i];
            }
        }
    } else {
#pragma unroll
        for (int p = 0; p < 2; ++p) {
            const int c0 = 8 * lane + 512 * p;
#pragma unroll
            for (int q = 0; q < 2; ++q) {
                const f32x4 a = *(const GAS f32x4*)(F.st_conv + ((size_t)b * 2 + 0) * DC + c0 + 4 * q), bb = *(const GAS f32x4*)(F.st_conv + ((size_t)b * 2 + 1) * DC + c0 + 4 * q);
#pragma unroll
                for (int i = 0; i < 4; ++i) { up2[8 * p + 4 * q + i] = a[i]; up1[8 * p + 4 * q + i] = bb[i]; }
            }
        }
    }
    v4u ub[4][2], gb[4][2];
#pragma unroll
    for (int r = 0; r < 4; ++r)
#pragma unroll
        for (int p = 0; p < 2; ++p) { const bf16* zr = F.Z + (size_t)(row0 + r) * NZ + 8 * lane + 512 * p; ub[r][p] = *(const GAS v4u*)(zr + ZC_CG); gb[r][p] = *(const GAS v4u*)(zr + ZC_BG); }
#pragma unroll
    for (int r = 0; r < 8; ++r) {
        const int row = row0 + r;
        float tt[16]; float ss = 0.f;
        v4u ua[2], ga[2];
#pragma unroll
        for (int p = 0; p < 2; ++p) { ua[p] = ub[r & 3][p]; ga[p] = gb[r & 3][p]; }
        if (r + 4 < 8) {
#pragma unroll
            for (int p = 0; p < 2; ++p) { const bf16* zr = F.Z + (size_t)(row0 + r + 4) * NZ + 8 * lane + 512 * p; ub[r & 3][p] = *(const GAS v4u*)(zr + ZC_CG); gb[r & 3][p] = *(const GAS v4u*)(zr + ZC_BG); }
        }
#pragma unroll
        for (int p = 0; p < 2; ++p) {
            const int c0 = 8 * lane + 512 * p; float a[8], g[8];
            unpack8(ua[p], a); unpack8(ga[p], g);
#pragma unroll
            for (int i = 0; i < 8; ++i) { const int ci = 8 * p + i; const float u = a[i];
                const float cv = w0[ci] * up2[ci] + w1[ci] * up1[ci] + w2[ci] * u; tt[ci] = g[i] * cv; ss += tt[ci] * tt[ci]; up2[ci] = up1[ci]; up1[ci] = u; }
        }
        const float rr = rsqrtf(wave_sum(ss) * (1.f / DC) + EPS);
#pragma unroll
        for (int p = 0; p < 2; ++p) {
            const int c0 = 8 * lane + 512 * p; v4u o;
            o.x = pk2(tt[8 * p + 0] * rr * cg_[8 * p + 0], tt[8 * p + 1] * rr * cg_[8 * p + 1]); o.y = pk2(tt[8 * p + 2] * rr * cg_[8 * p + 2], tt[8 * p + 3] * rr * cg_[8 * p + 3]);
            o.z = pk2(tt[8 * p + 4] * rr * cg_[8 * p + 4], tt[8 * p + 5] * rr * cg_[8 * p + 5]); o.w = pk2(tt[8 * p + 6] * rr * cg_[8 * p + 6], tt[8 * p + 7] * rr * cg_[8 * p + 7]);
            *(GAS v4u*)(F.YC + (size_t)row * D + c0) = o;
        }
        if (last_item && r >= 6) {
            float* o = F.out + (prompt ? O_PCONV : O_SCONV) + ((size_t)b * 2 + (r - 6)) * DC;
#pragma unroll
            for (int p = 0; p < 2; ++p) { const int c0 = 8 * lane + 512 * p;
                *(GAS f32x4*)(o + c0) = (f32x4){up1[8 * p + 0], up1[8 * p + 1], up1[8 * p + 2], up1[8 * p + 3]}; *(GAS f32x4*)(o + c0 + 4) = (f32x4){up1[8 * p + 4], up1[8 * p + 5], up1[8 * p + 6], up1[8 * p + 7]}; }
        }
    }
}

template <bool WITH_STATE>
__device__ __forceinline__ void sample_item(Frame& F, int item) {
    LAS float* L = (LAS float*)(F.lds + RING_OFF);
    LAS float* qT = L; LAS float* kT = L + 1024; LAS float* kwT = L + 2048; LAS float* qR = L + 3072; LAS float* kR = L + 4128; LAS float* vS = L + 5184; LAS float* accx = L + 7232; LAS float* Sm = L + 23616;
    LAS float* ai = L + 23680; LAS float* dd = L + 23688; LAS float* wk = L + 23696; LAS float* misc = L + 23704; LAS float* n0s = L + 23712; LAS float* red = L + 23840; LAS float* lis = L + 23872; LAS float* lfs = L + 23880;
    const int tid = F.tid, b = item >> 2, h = item & 3, row0 = MP + 8 * b;
    v4u zin; float gli = 0.f, glf = 0.f, n0v = 0.f;
    if (tid < 256) { const int isk = tid >> 7, t = (tid >> 4) & 7, c = tid & 15; zin = *(const GAS v4u*)(F.Z + (size_t)(row0 + t) * NZ + (isk ? ZC_K : ZC_Q) + h * DK + 8 * c); }
    else { const int u = tid - 256, t = u >> 5, c = u & 31; zin = *(const GAS v4u*)(F.Z + (size_t)(row0 + t) * NZ + ZC_V + h * DV + 8 * c); }
    if (tid < 8) { gli = F.gates[(size_t)(row0 + tid) * 8 + h]; glf = F.gates[(size_t)(row0 + tid) * 8 + 4 + h]; }
    if (tid >= 64 && tid < 64 + DK) n0v = F.st_n[(size_t)(b * NH + h) * DK + tid - 64];
    const float m0 = F.st_m[b * NH + h];
    const float* c0p = F.st_C + ((size_t)(b * NH + h) * DK + 16 * F.wave) * DV + 4 * (tid & 63);
    f32x4 c[16];
#pragma unroll
    for (int j = 0; j < 16; ++j) c[j] = __builtin_nontemporal_load((const GAS f32x4*)(c0p + (size_t)j * DV));
    const f32x4 gml4 = *(const GAS f32x4*)(F.ml_g + h * DV + 4 * (tid & 63));
    const v2u ob2 = *(const GAS v2u*)(F.Z + (size_t)(row0 + F.wave) * NZ + ZC_O + h * DV + 4 * (tid & 63));
    __syncthreads();
    if (tid < 256) { const int isk = tid >> 7, t = (tid >> 4) & 7, c = tid & 15; float f[8];
        unpack8(zin, f);
        LAS float* T_ = isk ? kT : qT; LAS float* R_ = isk ? kR : qR; const float sc_ = isk ? 1.f : QSCALE;
#pragma unroll
        for (int i = 0; i < 8; ++i) { const float x = f[i] * sc_; T_[(8 * c + i) * 8 + t] = x; R_[t * 132 + 8 * c + i] = x; }
    } else { const int u = tid - 256, t = u >> 5, c = u & 31; float f[8]; unpack8(zin, f);
#pragma unroll
        for (int i = 0; i < 8; ++i) vS[t * 256 + 8 * c + i] = f[i]; }
    if (tid < 8) { lis[tid] = gli; lfs[tid] = glf; }
    if (tid >= 64 && tid < 64 + DK) n0s[tid - 64] = n0v;
    __syncthreads();
    if (F.wave == 0) {
        const int lane = F.lane, t = lane >> 3, s = lane & 7;
        float bc[8]; { float run = 0.f;
#pragma unroll
            for (int i = 0; i < 8; ++i) { run += lfs[i]; bc[i] = run; } }
        float bt = 0.f, bs = 0.f;
#pragma unroll
        for (int i = 0; i < 8; ++i) { bt = (i == t) ? bc[i] : bt; bs = (i == s) ? bc[i] : bs; }
        const float lis_s = lis[s];
        const float dm = (s <= t) ? (bt - bs + lis_s) : -INFINITY;
        float mx = dm; mx = fmaxf(mx, __shfl_xor(mx, 1)); mx = fmaxf(mx, __shfl_xor(mx, 2)); mx = fmaxf(mx, __shfl_xor(mx, 4));
        const float mt = fmaxf(bt + m0, mx);
        const float w = (s <= t) ? __expf(dm - mt) : 0.f;
        const float a_i = __expf(bt + m0 - mt);
        float dot = 0.f, qn = 0.f;
#pragma unroll 8
        for (int d4 = 0; d4 < DK; d4 += 4) { const f32x4 qv = *(const LAS f32x4*)(qR + t * 132 + d4), kv = *(const LAS f32x4*)(kR + s * 132 + d4), nv = *(const LAS f32x4*)(n0s + d4);
            dot += (qv.x * kv.x + qv.y * kv.y) + (qv.z * kv.z + qv.w * kv.w); qn += (qv.x * nv.x + qv.y * nv.y) + (qv.z * nv.z + qv.w * nv.w); }
        const float sv = dot * w;
        float rs = sv; rs += __shfl_xor(rs, 1); rs += __shfl_xor(rs, 2); rs += __shfl_xor(rs, 4);
        const float den = a_i * qn + rs;
        Sm[t * 8 + s] = sv;
        const float bL = bc[7];
        const float gs = bL - bs + lis_s;
        float gm = gs; gm = fmaxf(gm, __shfl_xor(gm, 1)); gm = fmaxf(gm, __shfl_xor(gm, 2)); gm = fmaxf(gm, __shfl_xor(gm, 4));
        const float mnew = fmaxf(bL + m0, gm);
        if (s == 0) { ai[t] = a_i; dd[t] = 1.f / fmaxf(fabsf(den), __expf(-mt)); }
        if (t == 0) wk[s] = __expf(gs - mnew);
        if (lane == 0) { misc[0] = __expf(bL + m0 - mnew); misc[1] = mnew; }
    }
    __syncthreads();
    const float sc = misc[0];
    for (int i = tid; i < 1024; i += NWAVES * 64) kwT[i] = kT[i] * wk[i & 7];
    __syncthreads();
    if (tid < DK) { float nn = sc * n0s[tid];
#pragma unroll
        for (int s = 0; s < 8; ++s) nn += kwT[tid * 8 + s];
        F.out[O_SN + (size_t)(b * NH + h) * DK + tid] = nn; }
    if (tid == 0) F.out[O_SM + b * NH + h] = misc[1];
    { const int e4 = tid & 63, dg = F.wave;
      f32x4 vv[8], acc[8];
#pragma unroll
      for (int s = 0; s < 8; ++s) { vv[s] = *(const LAS f32x4*)(vS + s * 256 + 4 * e4); acc[s] = (f32x4){0.f, 0.f, 0.f, 0.f}; }
      float* c1p = F.out + O_SC + ((size_t)(b * NH + h) * DK + 16 * dg) * DV + 4 * e4;
      {   constexpr int d0 = 0;
#pragma unroll
          for (int j = 0; j < 16; ++j) {
              const int d = 16 * dg + d0 + j;
              const f32x4 q0 = *(const LAS f32x4*)(qT + d * 8), q1 = *(const LAS f32x4*)(qT + d * 8 + 4), k0 = *(const LAS f32x4*)(kwT + d * 8), k1 = *(const LAS f32x4*)(kwT + d * 8 + 4);
              f32x4 cn = c[j] * sc;
#pragma unroll
              for (int s = 0; s < 4; ++s) { acc[s] += c[j] * q0[s]; acc[4 + s] += c[j] * q1[s]; if (WITH_STATE) { cn += vv[s] * k0[s]; cn += vv[4 + s] * k1[s]; } }
              if (WITH_STATE) *(GAS f32x4*)(c1p + (size_t)(d0 + j) * DV) = cn;
          }
      }
#pragma unroll
      for (int t = 0; t < 8; ++t) *(LAS f32x4*)(accx + (dg * 8 + t) * 256 + 4 * e4) = acc[t];
    }
    __syncthreads();
    { const int t = F.wave, e4 = tid & 63; f32x4 a = {0.f, 0.f, 0.f, 0.f};
#pragma unroll
      for (int w = 0; w < 8; ++w) a += *(const LAS f32x4*)(accx + (w * 8 + t) * 256 + 4 * e4);
      f32x4 num = a * ai[t];
#pragma unroll
      for (int s2 = 0; s2 < 8; ++s2) num += *(const LAS f32x4*)(vS + s2 * 256 + 4 * e4) * Sm[t * 8 + s2];
      const f32x4 hv = num * dd[t];
      const float rr = rsqrtf(wave_sum((hv.x * hv.x + hv.y * hv.y) + (hv.z * hv.z + hv.w * hv.w)) * (1.f / DV) + EPS);
      const float o0 = bf2f(ob2.x & 0xffffu), o1 = bf2f(ob2.x >> 16), o2 = bf2f(ob2.y & 0xffffu), o3 = bf2f(ob2.y >> 16);
      v2u w2; w2.x = pk2(sigmoidf_(o0) * hv.x * rr * gml4.x, sigmoidf_(o1) * hv.y * rr * gml4.y); w2.y = pk2(sigmoidf_(o2) * hv.z * rr * gml4.z, sigmoidf_(o3) * hv.w * rr * gml4.w);
      *(GAS v2u*)(F.YC + (size_t)(row0 + t) * D + DC + h * DV + 4 * e4) = w2;
    }
}

__device__ __forceinline__ void sample_state_item(Frame& F, int item) {
    LAS float* L = (LAS float*)(F.lds + RING_OFF);
    LAS float* kT = L; LAS float* kwT = L + 1024; LAS float* vS = L + 2048; LAS float* lis = L + 4096; LAS float* lfs = L + 4104; LAS float* wk = L + 4112; LAS float* misc = L + 4120;
    const int tid = F.tid, b = item >> 2, h = item & 3, row0 = MP + 8 * b;
    const int e4 = tid & 63, dg = F.wave;
    const float* c0p = F.st_C + ((size_t)(b * NH + h) * DK + 16 * dg) * DV + 4 * e4;
    float* c1p = F.out + O_SC + ((size_t)(b * NH + h) * DK + 16 * dg) * DV + 4 * e4;
    f32x4 c[16];
#pragma unroll
    for (int j = 0; j < 16; ++j) c[j] = __builtin_nontemporal_load((const GAS f32x4*)(c0p + (size_t)j * DV));
    __syncthreads();
    if (tid >= 128 && tid < 256) { const int u = tid - 128, t = u >> 4, cc = u & 15; float f[8]; unpack8(*(const GAS v4u*)(F.Z + (size_t)(row0 + t) * NZ + ZC_K + h * DK + 8 * cc), f);
#pragma unroll
        for (int i = 0; i < 8; ++i) kT[(8 * cc + i) * 8 + t] = f[i];
    } else if (tid >= 256) { const int u = tid - 256, t = u >> 5, cc = u & 31; float f[8]; unpack8(*(const GAS v4u*)(F.Z + (size_t)(row0 + t) * NZ + ZC_V + h * DV + 8 * cc), f);
#pragma unroll
        for (int i = 0; i < 8; ++i) vS[t * 256 + 8 * cc + i] = f[i]; }
    if (tid < 8) { lis[tid] = F.gates[(size_t)(row0 + tid) * 8 + h]; lfs[tid] = F.gates[(size_t)(row0 + tid) * 8 + 4 + h]; }
    __syncthreads();
    if (tid < 8) {
        const float m0 = F.st_m[b * NH + h]; float run = 0.f, bs = 0.f;
#pragma unroll
        for (int i = 0; i < 8; ++i) { run += lfs[i]; bs = (i == tid) ? run : bs; }
        const float bL = run, gs = bL - bs + lis[tid];
        float gm = gs; gm = fmaxf(gm, __shfl_xor(gm, 1)); gm = fmaxf(gm, __shfl_xor(gm, 2)); gm = fmaxf(gm, __shfl_xor(gm, 4));
        const float mnew = fmaxf(bL + m0, gm);
        wk[tid] = __expf(gs - mnew); if (tid == 0) misc[0] = __expf(bL + m0 - mnew);
    }
    __syncthreads();
    const float sc = misc[0];
    for (int i = tid; i < 1024; i += NWAVES * 64) kwT[i] = kT[i] * wk[i & 7];
    __syncthreads();
    f32x4 vv[8];
#pragma unroll
    for (int s = 0; s < 8; ++s) vv[s] = *(const LAS f32x4*)(vS + s * 256 + 4 * e4);
#pragma unroll
    for (int j = 0; j < 16; ++j) {
        const int d = 16 * dg + j;
        const f32x4 k0 = *(const LAS f32x4*)(kwT + d * 8), k1 = *(const LAS f32x4*)(kwT + d * 8 + 4);
        f32x4 cn = c[j] * sc;
#pragma unroll
        for (int s = 0; s < 4; ++s) { cn += vv[s] * k0[s]; cn += vv[4 + s] * k1[s]; }
        __builtin_nontemporal_store(cn, (GAS f32x4*)(c1p + (size_t)j * DV));
    }
}

typedef short s16x4 __attribute__((ext_vector_type(4)));
typedef float f32x16 __attribute__((ext_vector_type(16)));
#define MFMA32(a, b, c) __builtin_amdgcn_mfma_f32_32x32x16_bf16((a), (b), (c), 0, 0, 0)
__device__ __forceinline__ unsigned tr_addr(unsigned base, int P, int rbase, int C0, int lane) {
    const int h = lane >> 5, blk = (lane >> 4) & 1, q = (lane & 15) >> 2, p = lane & 3;
    return base + (unsigned)((rbase + 8 * h + q) * P + (C0 + 16 * blk + 4 * p) * 2);
}
__device__ __forceinline__ void tr_frag_pair(unsigned a0, unsigned a1, unsigned b0, unsigned b1, bf16x8& A, bf16x8& B) {
    s16x4 x0, x1, y0, y1;
    asm volatile("ds_read_b64_tr_b16 %0, %4\n\tds_read_b64_tr_b16 %1, %5\n\tds_read_b64_tr_b16 %2, %6\n\tds_read_b64_tr_b16 %3, %7\n\ts_waitcnt lgkmcnt(0)"
                 : "=&v"(x0), "=&v"(x1), "=&v"(y0), "=&v"(y1) : "v"(a0), "v"(a1), "v"(b0), "v"(b1) : "memory");
    A = __builtin_shufflevector(x0, x1, 0, 1, 2, 3, 4, 5, 6, 7); B = __builtin_shufflevector(y0, y1, 0, 1, 2, 3, 4, 5, 6, 7);
}
__device__ __forceinline__ bf16x8 tr_frag(unsigned a0, unsigned a1) {
    s16x4 x0, x1;
    asm volatile("ds_read_b64_tr_b16 %0, %2\n\tds_read_b64_tr_b16 %1, %3\n\ts_waitcnt lgkmcnt(0)" : "=&v"(x0), "=&v"(x1) : "v"(a0), "v"(a1) : "memory");
    return __builtin_shufflevector(x0, x1, 0, 1, 2, 3, 4, 5, 6, 7);
}
__device__ __forceinline__ int crow(int reg, int h) { return (reg & 3) + 8 * (reg >> 2) + 4 * h; }

constexpr int SC_PK = 320, SC_PV = 192;
constexpr int SC_KIMG = 0, SC_VIMG = 2 * 64 * SC_PK, SC_WK = SC_VIMG + 2 * 64 * SC_PV, SC_SC = SC_WK + 2048 * 4, SC_BL = SC_SC + 32 * 4, SC_GM = SC_BL + 32 * 4, SC_MST = SC_GM + 32 * 4, SC_NV = SC_MST + 36 * 4, SC_CST = ((SC_NV + 128 * 4 + 15) / 16) * 16, SC_PC = 272, SC_END = SC_CST + 2 * 64 * SC_PC;
constexpr size_t WS_CST = WS_C;
constexpr size_t WS_BCUM = WS_GATES + 1 * MiB;
constexpr size_t WS_MST = WS_BCUM + 256 * 1024;
constexpr size_t WS_NST = WS_MST + 64 * 1024;
static_assert(SC_PK == 320 && SC_PV == 192, "sc_frags hard-codes the row offsets of the two images");
__device__ __forceinline__ void sc_frags(unsigned abase, unsigned bbase, bf16x8 (&A)[4], bf16x8 (&B)[4]) {
    s16x4 x[8], y[8];
    asm volatile("ds_read_b64_tr_b16 %0, %16\n\tds_read_b64_tr_b16 %1, %16 offset:1280\n\tds_read_b64_tr_b16 %8, %17\n\tds_read_b64_tr_b16 %9, %17 offset:768\n\t"
                 "ds_read_b64_tr_b16 %2, %16 offset:5120\n\tds_read_b64_tr_b16 %3, %16 offset:6400\n\tds_read_b64_tr_b16 %10, %17 offset:3072\n\tds_read_b64_tr_b16 %11, %17 offset:3840\n\t"
                 "ds_read_b64_tr_b16 %4, %16 offset:10240\n\tds_read_b64_tr_b16 %5, %16 offset:11520\n\tds_read_b64_tr_b16 %12, %17 offset:6144\n\tds_read_b64_tr_b16 %13, %17 offset:6912\n\t"
                 "ds_read_b64_tr_b16 %6, %16 offset:15360\n\tds_read_b64_tr_b16 %7, %16 offset:16640\n\tds_read_b64_tr_b16 %14, %17 offset:9216\n\tds_read_b64_tr_b16 %15, %17 offset:9984\n\ts_waitcnt lgkmcnt(0)"
                 : "=&v"(x[0]), "=&v"(x[1]), "=&v"(x[2]), "=&v"(x[3]), "=&v"(x[4]), "=&v"(x[5]), "=&v"(x[6]), "=&v"(x[7]),
                   "=&v"(y[0]), "=&v"(y[1]), "=&v"(y[2]), "=&v"(y[3]), "=&v"(y[4]), "=&v"(y[5]), "=&v"(y[6]), "=&v"(y[7])
                 : "v"(abase), "v"(bbase) : "memory");
#pragma unroll
    for (int k = 0; k < 4; ++k) { A[k] = __builtin_shufflevector(x[2 * k], x[2 * k + 1], 0, 1, 2, 3, 4, 5, 6, 7); B[k] = __builtin_shufflevector(y[2 * k], y[2 * k + 1], 0, 1, 2, 3, 4, 5, 6, 7); }
}
__device__ __forceinline__ void scan_unit(Frame& F, int unit, unsigned char* ws) {
    const int bh = unit >> 2, es = unit & 3, b = bh >> 2, h = bh & 3, tid = F.tid, lane = F.lane, wave = F.wave;
    LAS unsigned char* L = F.lds + RING_OFF;
    LAS float* wkS = (LAS float*)(L + SC_WK); LAS float* scS = (LAS float*)(L + SC_SC); LAS float* bLS = (LAS float*)(L + SC_BL); LAS float* gmS = (LAS float*)(L + SC_GM); LAS float* mstS = (LAS float*)(L + SC_MST); LAS float* nvS = (LAS float*)(L + SC_NV);
    float* bcumG = (float*)(ws + WS_BCUM) + (size_t)bh * 2048; float* mstG = (float*)(ws + WS_MST) + (size_t)bh * 64; float* nstG = (float*)(ws + WS_NST) + (size_t)bh * 32 * 128;
    bf16* cstG = (bf16*)(ws + WS_CST) + (size_t)bh * 32 * 256 * 128;
    const size_t rowb = (size_t)b * SEQ;
    __syncthreads();
    for (int cc = 0; cc < 4; ++cc) {
        const int c = 4 * wave + cc; const size_t row = rowb + 64 * c + lane;
        const float li = F.gates[row * 8 + h], lf = F.gates[row * 8 + 4 + h];
        float bsum = lf;
#pragma unroll
        for (int o = 1; o < 64; o <<= 1) { const float t = __shfl_up(bsum, o); if (lane >= o) bsum += t; }
        const float bL = __shfl(bsum, 63);
        const float g = bL - bsum + li;
        float gm = g;
#pragma unroll
        for (int o = 1; o < 64; o <<= 1) gm = fmaxf(gm, __shfl_xor(gm, o));
        wkS[64 * c + lane] = g;
        if (es == 0) bcumG[64 * c + lane] = bsum;
        if (lane == 0) { bLS[c] = bL; gmS[c] = gm; }
    }
    __syncthreads();
    if (tid == 0) { float m = 0.f; mstS[0] = 0.f;
        for (int c = 0; c < 32; ++c) { const float mn = fmaxf(bLS[c] + m, gmS[c]); scS[c] = __expf(bLS[c] + m - mn); m = mn; mstS[c + 1] = mn; } }
    __syncthreads();
    for (int i = tid; i < 2048; i += NWAVES * 64) wkS[i] = __expf(wkS[i] - mstS[(i >> 6) + 1]);
    if (es == 0 && tid < 33) mstG[tid] = mstS[tid];
    if (tid < 128) nvS[tid] = 0.f;
    const int dt = wave & 3, et = wave >> 2, hh = lane >> 5;
    f32x16 acc;
#pragma unroll
    for (int i = 0; i < 16; ++i) acc[i] = 0.f;
    const int kr0 = tid >> 4, kc0 = tid & 15;
    const int vr = tid >> 3, vc = tid & 7;
    const bf16* zk = F.Z + rowb * NZ + ZC_K + h * DK; const bf16* zv = F.Z + rowb * NZ + ZC_V + h * DV + 64 * es;
    v4u rkA0, rkA1, rvA, rkB0, rkB1, rvB, rkC0, rkC1, rvC, rkD0, rkD1, rvD;
#define SC_LOAD(c, rk0, rk1, rv) do { rk0 = *(const GAS v4u*)(zk + (size_t)(64 * (c) + kr0) * NZ + 8 * kc0); rk1 = *(const GAS v4u*)(zk + (size_t)(64 * (c) + kr0 + 32) * NZ + 8 * kc0); \
                        rv = *(const GAS v4u*)(zv + (size_t)(64 * (c) + vr) * NZ + 8 * vc); } while (0)
#define SC_WRITE(c, rk0, rk1, rv) do { LAS unsigned char* kb = L + SC_KIMG + ((c) & 1) * 64 * SC_PK; LAS unsigned char* vb = L + SC_VIMG + ((c) & 1) * 64 * SC_PV; \
                         *(LAS v4u*)(kb + kr0 * SC_PK + 16 * kc0) = rk0; *(LAS v4u*)(kb + (kr0 + 32) * SC_PK + 16 * kc0) = rk1; \
                         float vf[8]; unpack8(rv, vf); const float w_ = wkS[64 * (c) + vr]; v4u o_; o_.x = pk2(vf[0] * w_, vf[1] * w_); o_.y = pk2(vf[2] * w_, vf[3] * w_); o_.z = pk2(vf[4] * w_, vf[5] * w_); o_.w = pk2(vf[6] * w_, vf[7] * w_); \
                         *(LAS v4u*)(vb + vr * SC_PV + 16 * vc) = o_; } while (0)
    const unsigned lbase = (unsigned)(size_t)L;
#define SC_STAGE(cn) do { LAS unsigned char* st_ = L + SC_CST + ((cn) & 1) * 64 * SC_PC + (32 * et + (lane & 31)) * SC_PC + (32 * dt + 4 * hh) * 2; \
        _Pragma("unroll") for (int g = 0; g < 4; ++g) *(LAS unsigned long long*)(st_ + 16 * g) = (unsigned long long)pk2(acc[4 * g], acc[4 * g + 1]) | ((unsigned long long)pk2(acc[4 * g + 2], acc[4 * g + 3]) << 32); } while (0)
#define SC_STEP(c) do { \
        {   \
          _Pragma("unroll") for (int i_ = 0; i_ < 2; ++i_) { const int p_ = tid + 512 * i_, e_ = p_ >> 4, c16 = p_ & 15; \
              *(GAS v4u*)(cstG + ((size_t)(c) * 256 + 64 * es + e_) * 128 + 8 * c16) = *(const LAS v4u*)(L + SC_CST + ((c) & 1) * 64 * SC_PC + e_ * SC_PC + 16 * c16); } } \
        const float sc = scS[c]; \
        _Pragma("unroll") for (int i = 0; i < 16; ++i) acc[i] *= sc; \
        const unsigned kimg = lbase + SC_KIMG + ((c) & 1) * 64 * SC_PK, vimg = lbase + SC_VIMG + ((c) & 1) * 64 * SC_PV; \
        bf16x8 Af[4], Bf[4]; sc_frags(tr_addr(kimg, SC_PK, 0, 32 * dt, lane), tr_addr(vimg, SC_PV, 0, 32 * et, lane), Af, Bf); \
        _Pragma("unroll") for (int ks = 0; ks < 4; ++ks) acc = MFMA32(Af[ks], Bf[ks], acc); \
        if (es == 0 && et == 0) {     \
            float part = 0.f; \
            _Pragma("unroll") for (int ks = 0; ks < 4; ++ks) { const f32x4 w0 = *(const LAS f32x4*)(wkS + 64 * (c) + 16 * ks + 8 * hh), w1 = *(const LAS f32x4*)(wkS + 64 * (c) + 16 * ks + 8 * hh + 4); \
                const v4u kk = __builtin_bit_cast(v4u, Af[ks]); \
                part += (bf2f(kk.x & 0xffffu) * w0.x + bf2f(kk.x >> 16) * w0.y) + (bf2f(kk.y & 0xffffu) * w0.z + bf2f(kk.y >> 16) * w0.w) \
                      + (bf2f(kk.z & 0xffffu) * w1.x + bf2f(kk.z >> 16) * w1.y) + (bf2f(kk.w & 0xffffu) * w1.z + bf2f(kk.w >> 16) * w1.w); } \
            part += __shfl_xor(part, 32); \
            if (hh == 0) { const int d = 32 * dt + (lane & 31); const float nn = nvS[d]; nstG[(c) * 128 + d] = nn; nvS[d] = nn * sc + part; } } \
        SC_STAGE((c) + 1); } while (0)
    SC_LOAD(0, rkA0, rkA1, rvA); SC_LOAD(1, rkB0, rkB1, rvB); SC_LOAD(2, rkC0, rkC1, rvC); SC_LOAD(3, rkD0, rkD1, rvD);
    SC_STAGE(0);
    __syncthreads();
    SC_WRITE(0, rkA0, rkA1, rvA);
#pragma unroll 1
    for (int c = 0; c < 32; c += 4) {
        if (c + 4 < 32) SC_LOAD(c + 4, rkA0, rkA1, rvA);
        __syncthreads();
        SC_STEP(c);
        SC_WRITE(c + 1, rkB0, rkB1, rvB);
        if (c + 5 < 32) SC_LOAD(c + 5, rkB0, rkB1, rvB);
        __syncthreads();
        SC_STEP(c + 1);
        SC_WRITE(c + 2, rkC0, rkC1, rvC);
        if (c + 6 < 32) SC_LOAD(c + 6, rkC0, rkC1, rvC);
        __syncthreads();
        SC_STEP(c + 2);
        SC_WRITE(c + 3, rkD0, rkD1, rvD);
        if (c + 7 < 32) SC_LOAD(c + 7, rkD0, rkD1, rvD);
        __syncthreads();
        SC_STEP(c + 3);
        if (c + 4 < 32) SC_WRITE(c + 4, rkA0, rkA1, rvA);
    }
#undef SC_STEP
#undef SC_STAGE
    __syncthreads();
#undef SC_LOAD
#undef SC_WRITE
    { float* dst = F.out + O_PC + ((size_t)bh * 128 + 32 * dt) * 256 + 64 * es + 32 * et + (lane & 31);
#pragma unroll
      for (int i = 0; i < 16; ++i) dst[(size_t)crow(i, hh) * 256] = acc[i]; }
    if (es == 0 && tid < 128) F.out[O_PN + (size_t)bh * 128 + tid] = nvS[tid];
    if (es == 0 && tid == 0) F.out[O_PM + bh] = mstS[32];
    asm volatile("s_waitcnt vmcnt(0)" ::: "memory");
    __syncthreads();
    if (tid == 0) { __builtin_amdgcn_fence(__ATOMIC_RELEASE, "agent"); asm volatile("s_waitcnt vmcnt(0)" ::: "memory");
        __hip_atomic_fetch_add((unsigned*)(F.ctl + CW_SCAN) + 64 * bh, 1u, __ATOMIC_RELAXED, __HIP_MEMORY_SCOPE_AGENT); }
}
constexpr int P3_PQ = 272, P3_PKK = 272, P3_PV = 576, P3_PP = 144, P3_PH = 1040;
constexpr int P3_Q = 0, P3_K = P3_Q + 64 * P3_PQ, P3_V = P3_K + 64 * P3_PKK, P3_P = P3_V + 64 * P3_PV, P3_H = 0;
constexpr int P3_SM = 81920;
static_assert(P3_P + 64 * P3_PP <= P3_SM && 64 * P3_PH <= P3_SM, "P3 LDS map");
__device__ __forceinline__ void p3_item(Frame& F, int item, unsigned char* ws) {
    const int bh = item >> 5, c = item & 31, b = bh >> 2, h = bh & 3, tid = F.tid, lane = F.lane, wave = F.wave, hh = lane >> 5, l31 = lane & 31;
    LAS unsigned char* L = F.lds + RING_OFF;
    LAS float* sm = (LAS float*)(L + P3_SM); LAS float* bmS = sm; LAS float* aS = sm + 64; LAS float* aiS = sm + 128; LAS float* ddS = sm + 192; LAS float* rsS = sm + 256; LAS float* qnS = sm + 320; LAS float* mtS = sm + 384; LAS float* nvS = sm + 448;
    const size_t row0 = (size_t)b * SEQ + 64 * c;
    const bf16* cst = (const bf16*)(ws + WS_CST) + ((size_t)bh * 32 + c) * 256 * 128;
    float mc = 0.f, bt = 0.f, li = 0.f, nv0 = 0.f, nv1 = 0.f;
    if (wave == 0) { mc = ((const float*)(ws + WS_MST))[(size_t)bh * 64 + c]; bt = ((const float*)(ws + WS_BCUM))[(size_t)bh * 2048 + 64 * c + lane]; li = F.gates[(row0 + lane) * 8 + h]; }
    if (wave == 1) { const float* np = (const float*)(ws + WS_NST) + ((size_t)bh * 32 + c) * 128; nv0 = np[lane]; nv1 = np[64 + lane]; }
    v4u qk[4], vr[4];
    { const bf16* zq = F.Z + row0 * NZ + ZC_Q + h * DK; const bf16* zk = F.Z + row0 * NZ + ZC_K + h * DK; const bf16* zv = F.Z + row0 * NZ + ZC_V + h * DV;
#pragma unroll
      for (int i = 0; i < 2; ++i) { const int r = (tid >> 4) + 32 * i, cc = tid & 15; qk[2 * i] = *(const GAS v4u*)(zq + (size_t)r * NZ + 8 * cc); qk[2 * i + 1] = *(const GAS v4u*)(zk + (size_t)r * NZ + 8 * cc); }
#pragma unroll
      for (int i = 0; i < 4; ++i) { const int r = (tid >> 5) + 16 * i, cc = tid & 31; vr[i] = *(const GAS v4u*)(zv + (size_t)r * NZ + 8 * cc); } }
    v4u og[4];
    { const bf16* zo = F.Z + (row0 + (tid >> 3)) * NZ + ZC_O + h * DV + 32 * (tid & 7);
#pragma unroll
      for (int q = 0; q < 4; ++q) og[q] = *(const GAS v4u*)(zo + 8 * q); }
    bf16x8 Cf[8];
    { const bf16* cp = cst + (size_t)(32 * wave + l31) * 128 + 8 * hh;
#pragma unroll
      for (int kd = 0; kd < 8; ++kd) Cf[kd] = *(const GAS bf16x8*)(cp + 16 * kd); }
    __syncthreads();
    {
#pragma unroll
      for (int i = 0; i < 2; ++i) { const int r = (tid >> 4) + 32 * i, cc = tid & 15;
          *(LAS v4u*)(L + P3_Q + r * P3_PQ + 16 * cc) = qk[2 * i]; *(LAS v4u*)(L + P3_K + r * P3_PKK + 16 * cc) = qk[2 * i + 1]; }
#pragma unroll
      for (int i = 0; i < 4; ++i) { const int r = (tid >> 5) + 16 * i, cc = tid & 31; *(LAS v4u*)(L + P3_V + r * P3_PV + 16 * cc) = vr[i]; } }
    if (wave == 0) {
        const float a = li - bt; float pm = a;
#pragma unroll
        for (int o = 1; o < 64; o <<= 1) { const float t = __shfl_up(pm, o); if (lane >= o) pm = fmaxf(pm, t); }
        const float mt = bt + fmaxf(mc, pm);
        bmS[lane] = bt - mt; aS[lane] = a; aiS[lane] = __expf(bt + mc - mt); mtS[lane] = mt; rsS[lane] = 0.f;
    }
    if (wave == 1) { nvS[lane] = nv0; nvS[64 + lane] = nv1; }
    __syncthreads();
    { const int t = tid >> 3, part = tid & 7; float s = 0.f;
      const LAS unsigned short* qr = (const LAS unsigned short*)(L + P3_Q + t * P3_PQ) + 16 * part;
#pragma unroll
      for (int j = 0; j < 16; ++j) s += bf2f(qr[j]) * nvS[16 * part + j];
      s += __shfl_xor(s, 1); s += __shfl_xor(s, 2); s += __shfl_xor(s, 4);
      if (part == 0) qnS[t] = s * QSCALE; }
    if (wave < 3) {
        const int si = wave == 2 ? 1 : 0, ti = wave == 0 ? 0 : 1;
        f32x16 x;
#pragma unroll
        for (int i = 0; i < 16; ++i) x[i] = 0.f;
#pragma unroll
        for (int kd = 0; kd < 8; ++kd) {
            const bf16x8 A = *(const LAS bf16x8*)(L + P3_K + (32 * si + l31) * P3_PKK + (16 * kd + 8 * hh) * 2);
            const bf16x8 B = *(const LAS bf16x8*)(L + P3_Q + (32 * ti + l31) * P3_PQ + (16 * kd + 8 * hh) * 2);
            x = MFMA32(A, B, x);
        }
        const int t = 32 * ti + l31; const float bm = bmS[t]; float rsum = 0.f;
#pragma unroll
        for (int g = 0; g < 4; ++g) {
            float p[4];
#pragma unroll
            for (int j = 0; j < 4; ++j) { const int s = 32 * si + 8 * g + 4 * hh + j; const float w = (s <= t) ? __expf(bm + aS[s]) : 0.f; p[j] = x[4 * g + j] * QSCALE * w; rsum += p[j]; }
            *(LAS unsigned long long*)(L + P3_P + t * P3_PP + (32 * si + 8 * g + 4 * hh) * 2) = (unsigned long long)pk2(p[0], p[1]) | ((unsigned long long)pk2(p[2], p[3]) << 32);
        }
        rsum += __shfl_xor(rsum, 32);
        if (hh == 0) atomicAdd((float*)(rsS + t), rsum);
    }
    __syncthreads();
    if (tid < 64) { const float den = aiS[tid] * qnS[tid] + rsS[tid]; ddS[tid] = 1.f / fmaxf(fabsf(den), __expf(-mtS[tid])); }
    bf16x8 Vf[4];
    { const unsigned vimg = (unsigned)(size_t)(L + P3_V);
#pragma unroll
      for (int ks = 0; ks < 4; ++ks) Vf[ks] = tr_frag(tr_addr(vimg, P3_PV, 16 * ks, 32 * wave, lane), tr_addr(vimg, P3_PV, 16 * ks + 4, 32 * wave, lane)); }
    f32x16 n1[2], n2[2];
#pragma unroll
    for (int ti = 0; ti < 2; ++ti) {
#pragma unroll
        for (int i = 0; i < 16; ++i) { n1[ti][i] = 0.f; n2[ti][i] = 0.f; }
#pragma unroll
        for (int kd = 0; kd < 8; ++kd) { const bf16x8 A = *(const LAS bf16x8*)(L + P3_Q + (32 * ti + l31) * P3_PQ + (16 * kd + 8 * hh) * 2); n1[ti] = MFMA32(A, Cf[kd], n1[ti]); }
#pragma unroll
        for (int ks = 0; ks < 2 * (ti + 1); ++ks) { const bf16x8 A = *(const LAS bf16x8*)(L + P3_P + (32 * ti + l31) * P3_PP + (16 * ks + 8 * hh) * 2); n2[ti] = MFMA32(A, Vf[ks], n2[ti]); }
    }
    __syncthreads();
#pragma unroll
    for (int ti = 0; ti < 2; ++ti)
#pragma unroll
        for (int i = 0; i < 16; ++i) { const int t = 32 * ti + crow(i, hh);
            *(LAS float*)(L + P3_H + t * P3_PH + (32 * wave + l31) * 4) = (aiS[t] * QSCALE * n1[ti][i] + n2[ti][i]) * ddS[t]; }
    __syncthreads();
    { const int t = tid >> 3, j = tid & 7; f32x4 hv4[8]; float s = 0.f;
#pragma unroll
      for (int q = 0; q < 8; ++q) { hv4[q] = *(const LAS f32x4*)(L + P3_H + t * P3_PH + (32 * j + 4 * q) * 4); s += (hv4[q].x * hv4[q].x + hv4[q].y * hv4[q].y) + (hv4[q].z * hv4[q].z + hv4[q].w * hv4[q].w); }
      s += __shfl_xor(s, 1); s += __shfl_xor(s, 2); s += __shfl_xor(s, 4);
      const float rr = rsqrtf(s * (1.f / DV) + EPS);
      bf16* yo = F.YC + (row0 + t) * D + DC + h * DV + 32 * j; const LAS float* gp = (const LAS float*)(F.lds + MLG_OFF) + h * DV + 32 * j;
#pragma unroll
      for (int q = 0; q < 4; ++q) { float o[8]; unpack8(og[q], o);
          const f32x4 g0 = *(const LAS f32x4*)(gp + 8 * q), g1 = *(const LAS f32x4*)(gp + 8 * q + 4); const f32x4 a = hv4[2 * q], bq = hv4[2 * q + 1];
          v4u w; w.x = pk2(sigmoidf_(o[0]) * a.x * rr * g0.x, sigmoidf_(o[1]) * a.y * rr * g0.y); w.y = pk2(sigmoidf_(o[2]) * a.z * rr * g0.z, sigmoidf_(o[3]) * a.w * rr * g0.w);
          w.z = pk2(sigmoidf_(o[4]) * bq.x * rr * g1.x, sigmoidf_(o[5]) * bq.y * rr * g1.y); w.w = pk2(sigmoidf_(o[6]) * bq.z * rr * g1.z, sigmoidf_(o[7]) * bq.w * rr * g1.w);
          *(GAS v4u*)(yo + 8 * q) = w; } }
}
__device__ __forceinline__ void p2_phase(Frame& F, unsigned char* ws, bool w23_later, bool merge_p3, bool defer_state) {
    constexpr int NS = DB * NH, NC = 1152 / NWAVES, NTI = TR_I2 + 2 * TR_I3, NT = NTI / (2 * NWAVES), NP = 512;
    static_assert(NTI % (2 * NWAVES) == 0, "transposition items per group");
    const int nT = w23_later ? NT : 0, nP = merge_p3 ? NP : 0, NQ = NS + NC + nT + nP;
    if (F.tid < NH * DV / 4) *(LAS f32x4*)(F.lds + MLG_OFF + 16 * F.tid) = *(const GAS f32x4*)(F.ml_g + 4 * F.tid);
    if (F.G >= 64 && F.vcu < 64) scan_unit(F, F.vcu, ws);
    else if (F.G < 64) { for (int it = F.vcu; it < 64; it += F.G) scan_unit(F, it, ws); }
    unsigned* qh = (unsigned*)(F.ctl + CW_QUEUE);
    volatile LAS unsigned* qs = F.MISC + 16;
    bool acquired = false;
    unsigned nxt = 0;
    if (F.tid == 0) nxt = __hip_atomic_fetch_add(qh, 1u, __ATOMIC_RELAXED, __HIP_MEMORY_SCOPE_AGENT);
    for (;;) {
        __syncthreads();
        if (F.tid == 0) qs[0] = nxt;
        __syncthreads();
        const int i = __builtin_amdgcn_readfirstlane((int)qs[0]);
        asm volatile("" ::: "memory");
        if (i >= NQ) break;
        if (F.tid == 0) nxt = __hip_atomic_fetch_add(qh, 1u, __ATOMIC_RELAXED, __HIP_MEMORY_SCOPE_AGENT);
        Frame G = F; asm volatile("" : "+v"(G.tid), "+v"(G.lane));
        if (i < NS) { if (defer_state) sample_item<false>(G, i); else sample_item<true>(G, i); }
        else if (i < NS + NC) conv_item(G, (i - NS) * NWAVES + F.wave);
        else if (i < NS + NC + nT) { const int g = i - NS - NC; tr_run(G, TR_I1 + g * 2 * NWAVES, TR_I1 + (g + 1) * 2 * NWAVES, F.wave, NWAVES, (LAS float*)(F.lds + RING_OFF + F.wave * 16640)); }
        else {
            if (!acquired) {
                if (F.tid < 16) { unsigned* cw = (unsigned*)(F.ctl + CW_SCAN) + 64 * F.tid; unsigned spins = 0;
                    while (__hip_atomic_load(cw, __ATOMIC_RELAXED, __HIP_MEMORY_SCOPE_AGENT) < 4u) { __builtin_amdgcn_s_sleep(4); if (++spins > (1u << 20)) break; } }
                if (F.wave == 0) { __builtin_amdgcn_fence(__ATOMIC_ACQUIRE, "agent"); asm volatile("s_waitcnt vmcnt(0)" ::: "memory"); }
                __syncthreads(); acquired = true; }
            p3_item(G, i - NS - NC - nT, ws);
        }
    }
    __syncthreads();
}
__device__ __forceinline__ void p3_phase(Frame& F, unsigned char* ws) {
    if (F.tid < NH * DV / 4) *(LAS f32x4*)(F.lds + MLG_OFF + 16 * F.tid) = *(const GAS f32x4*)(F.ml_g + 4 * F.tid);
    __syncthreads();
    for (int it = F.vcu; it < 512; it += F.G) p3_item(F, it, ws);
    __syncthreads();
}
struct Args { const float* in[19]; float* out; unsigned char* ws; int ph_lo, ph_hi, li, pad; };
__global__ void __launch_bounds__(NWAVES * 64, 2) mk_fwd(Args args) {
    extern __shared__ __attribute__((aligned(16))) unsigned char lds[];
    Frame F;
    F.lds = (LAS unsigned char*)lds;
    F.MISC = (volatile LAS unsigned*)(F.lds + MISC_OFF);
    F.tid = threadIdx.x; F.lane = F.tid & 63; F.wave = __builtin_amdgcn_readfirstlane(F.tid >> 6);
    F.G = gridDim.x; { const int bx = blockIdx.x; F.vcu = (F.G % 8 == 0) ? (bx % 8) * (F.G / 8) + bx / 8 : bx; }
    unsigned char* ws = args.ws;
    F.ctl = (gu32*)(ws + WS_CTL);
    F.x_p = args.in[0]; F.x_s = args.in[1]; F.st_conv = args.in[2]; F.st_C = args.in[3]; F.st_n = args.in[4]; F.st_m = args.in[5];
    F.g1 = args.in[6]; F.w_in = args.in[7]; F.b_i = args.in[8]; F.b_f = args.in[9]; F.conv_w = args.in[10]; F.conv_g = args.in[11]; F.ml_g = args.in[12];
    F.w_out = args.in[13]; F.g2 = args.in[14]; F.wg = args.in[15]; F.wu = args.in[16]; F.wd = args.in[17]; F.fg = args.in[18]; F.out = args.out;
    F.W1 = (bf16*)(ws + WS_W1); F.W2 = (bf16*)(ws + WS_W2); F.W3 = (bf16*)(ws + WS_W3); F.W4 = (bf16*)(ws + WS_W4);
    F.XN = (bf16*)(ws + WS_A); F.YC = (bf16*)(ws + WS_A); F.Z = (bf16*)(ws + WS_B); F.HB = (bf16*)(ws + WS_B); F.X1b = (bf16*)(ws + WS_C);
    F.gates = (float*)(ws + WS_GATES); F.ssq1 = (float*)(ws + WS_CTL) + CW_SSQ1; F.ssq2 = (float*)(ws + WS_CTL) + CW_SSQ2;
    for (int u = F.tid; u < (LDS_BYTES - LDSCTL_OFF) / 4; u += NWAVES * 64) ((LAS unsigned*)(F.lds + LDSCTL_OFF))[u] = 0u;
    __syncthreads();
    XcdBarrier bar = xcd_barrier_post((unsigned*)(F.ctl + CW_BAR) + args.li * XCD_BAR_WORDS, F.MISC + 8);
    const int lo = args.ph_lo, hi = args.ph_hi;
#define IN(k) (lo <= (k) && (k) < hi)
#ifndef PROBE_PHASE
#define PROBE_PHASE -1
#endif
#ifndef PROBE_MULT
#define PROBE_MULT 4
#endif
    unsigned long long pt0 = (PROBE_PHASE == 0) ? __builtin_amdgcn_s_memrealtime() : 0ull;
#define SEAM(k) do { if (IN(k) && IN((k) + 1)) xcd_barrier(bar); \
        if (PROBE_PHASE >= 0 && blockIdx.x == 0) { if ((k) + 1 == PROBE_PHASE) pt0 = __builtin_amdgcn_s_memrealtime(); \
            if ((k) == PROBE_PHASE) { const unsigned long long t1 = __builtin_amdgcn_s_memrealtime(); while (__builtin_amdgcn_s_memrealtime() - t1 < (unsigned long long)PROBE_MULT * (t1 - pt0)) __builtin_amdgcn_s_sleep(8); } __syncthreads(); } } while (0)

    constexpr bool use_fp8 = FFN2_FP8 != 0;
    const bool w4_later = (F.G == 256) && IN(0) && IN(5);
    const bool w23_later = w4_later && IN(2) && F.G >= 128;
    if (IN(0)) { p0_prologue(F, w4_later, w23_later); } SEAM(0);
    if (IN(1)) {
        pg8::Gemm g{F.XN, F.W1, M, NZ, D}; pg9::StaticOrder S; S.init(M, NZ, F.G, (int)blockIdx.x, 1);
        pg9::EpiZ E{F.Z, NZ};
        pg9::gemm_phase<pg9::EpiZ>(F.lds + RING_OFF, g, S, E);
    } SEAM(1);
    const bool merge_p3 = IN(2) && IN(3);
    const bool defer_state = w4_later && IN(2);
    if (IN(2)) { p2_phase(F, ws, w23_later && F.G >= 128, merge_p3, defer_state); }
    if (merge_p3) { xcd_barrier(bar);
        if (PROBE_PHASE >= 0 && blockIdx.x == 0) { if (PROBE_PHASE == 4) pt0 = __builtin_amdgcn_s_memrealtime();
            if (PROBE_PHASE == 2) { const unsigned long long t1 = __builtin_amdgcn_s_memrealtime(); while (__builtin_amdgcn_s_memrealtime() - t1 < (unsigned long long)PROBE_MULT * (t1 - pt0)) __builtin_amdgcn_s_sleep(8); } __syncthreads(); } }
    else { SEAM(2); if (IN(3)) { p3_phase(F, ws); } SEAM(3); }
    if (IN(4)) {
        pg8::Gemm g{F.YC, F.W2, M, D, D}; pg9::StaticOrder S; S.init(M, D, F.G, (int)blockIdx.x);
        const bool x1_bf16 = (F.G == (M / pg9::BMR) * (D / pg9::BN)) && IN(6);
        pg9::EpiRes E{F.x_p, F.x_s, MP, x1_bf16 ? nullptr : F.out, F.X1b, F.ssq1};
        pg9::gemm_phase<pg9::EpiRes>(F.lds + RING_OFF, g, S, E);
    } SEAM(4);
    if (IN(5)) {
        pg8::Gemm g{F.X1b, F.W3, M, N3, D}; pg9::StaticOrder S; S.init(M, N3, F.G, (int)blockIdx.x);
        if constexpr (use_fp8) { pg9::EpiH8 E{(unsigned char*)F.HB, F.ssq1, (float)(1 << H8_EXP)}; pg9::gemm_phase<pg9::EpiH8>(F.lds + RING_OFF, g, S, E); }
        else { pg9::EpiH E{F.HB, F.ssq1}; pg9::gemm_phase<pg9::EpiH>(F.lds + RING_OFF, g, S, E); }
        if (w4_later && blockIdx.x >= 128) {
            LAS float* scr = (LAS float*)(F.lds + RING_OFF + F.wave * 16640);
            for (int it = ((int)blockIdx.x - 128) * NWAVES + F.wave; it < (FF / 64) * (D / 64); it += 128 * NWAVES) {
                if constexpr (use_fp8) p0_transpose_item_fp8(F.wd, D, FF, D / 64, F.W4, scr, it, F.lane, (float)(1 << W8_EXP));
                else p0_transpose_item(F.wd, D, FF, D / 64, F.W4, 0, nullptr, scr, it, F.lane); }
            if (defer_state) { for (int it = (int)blockIdx.x - 128; it < DB * NH; it += 128) sample_state_item(F, it); }
        }
    } SEAM(5);
    if (IN(6)) {
        pg8::Gemm g{F.HB, F.W4, M, D, use_fp8 ? FF / 2 : FF}; pg9::StaticOrder S; S.init(M, D, F.G, (int)blockIdx.x);
        if (F.G == (M / pg9::BMR) * (D / pg9::BN)) {
            pg9::EpiFinal E{F.out, F.ssq2, (unsigned*)(F.ctl + CW_CNT4), F.fg, IN(4) ? F.X1b : nullptr};
            if constexpr (use_fp8) pg9::gemm_phase<pg9::EpiFinal, true, true, 127 - H8_EXP, 127 - W8_EXP>(F.lds + RING_OFF, g, S, E);
            else pg9::gemm_phase<pg9::EpiFinal>(F.lds + RING_OFF, g, S, E);
        } else if constexpr (!use_fp8) {
            pg9::EpiRes E{F.out, F.out, M, F.out, nullptr, F.ssq2};
            pg9::gemm_phase<pg9::EpiRes>(F.lds + RING_OFF, g, S, E);
        }
    }
    if (F.G != (M / pg9::BMR) * (D / pg9::BN)) { SEAM(6); if (IN(7)) { final_norm_phase(F); } }
    if (PROBE_PHASE == 6 && blockIdx.x == 0) { const unsigned long long t1 = __builtin_amdgcn_s_memrealtime(); while (__builtin_amdgcn_s_memrealtime() - t1 < (unsigned long long)PROBE_MULT * (t1 - pt0)) __builtin_amdgcn_s_sleep(8); }
    if (PROBE_PHASE == 7) { xcd_barrier(bar); SEAM(7); }
#undef IN
#undef SEAM
}

extern "C" void kernel_launch(void* const* d_in, const int* in_sizes, int n_in, void* d_out, int out_size, void* d_ws, size_t ws_size, hipStream_t stream) {
    static int grid = 0;
    if (grid == 0) {
        if (n_in != 19 || (size_t)out_size != O_END || ws_size < WS_END) { fprintf(stderr, "kernel_launch: unexpected shapes: n_in %d out %d ws %zu; nothing launched\n", n_in, out_size, ws_size); grid = -1; return; }
        int dev = 0, cus = 0;
        if (hipGetDevice(&dev) != hipSuccess || hipDeviceGetAttribute(&cus, hipDeviceAttributeMultiprocessorCount, dev) != hipSuccess) { grid = -1; return; }
        if (hipFuncSetAttribute((const void*)mk_fwd, hipFuncAttributeMaxDynamicSharedMemorySize, LDS_BYTES) != hipSuccess) { fprintf(stderr, "kernel_launch: hipFuncSetAttribute failed\n"); grid = -1; return; }
        grid = cus;
        if (FFN2_FP8 && cus != 256) { fprintf(stderr, "kernel_launch: this build needs a 256-CU device (got %d); nothing launched\n", cus); grid = -1; return; }
    }
    if (grid < 0) return;
    unsigned char* ws = (unsigned char*)d_ws; float* out = (float*)d_out;
    (void)hipMemsetAsync(ws + WS_CTL, 0, CTL_ZERO_BYTES, stream);
    Args a{};
    for (int i = 0; i < 19; ++i) a.in[i] = (const float*)d_in[i];
    a.out = out; a.ws = ws;
    a.ph_lo = 0; a.ph_hi = 8; a.li = 0;
    hipLaunchKernelGGL(mk_fwd, dim3(grid), dim3(NWAVES * 64), LDS_BYTES, stream, a);
}
```
